# Optimizing an MI355X kernel written in HIP

```python
import jax, jax.numpy as jnp
from jax import lax
import numpy as np

D_MODEL = 2048
BATCH = 1
SEQ = 8192
DEPTH = 4

N_MEM = 256
XA_HEADS = 4
XA_HEAD_DIM = D_MODEL // XA_HEADS
GLA_HEADS = 4
GLA_DK = 64
GLA_DV = 128
GLA_GATE_RANK = 16
GLA_GATE_TAU = 16.0
GLA_CHUNK = 64
SWA_Q_HEADS = 16
SWA_KV_HEADS = 2
SWA_HEAD_DIM = 64
SWA_WINDOW = 128
ROPE_THETA = 10000.0
SC_CH = 512
SC_WIDTH = 3
D_MIX = GLA_HEADS * GLA_DV + SWA_Q_HEADS * SWA_HEAD_DIM + SC_CH
IN_SIZES = (
    GLA_HEADS * GLA_DK, GLA_HEADS * GLA_DK, GLA_HEADS * GLA_DV, GLA_HEADS * GLA_DV, GLA_GATE_RANK,
    SWA_Q_HEADS * SWA_HEAD_DIM, SWA_KV_HEADS * SWA_HEAD_DIM, SWA_KV_HEADS * SWA_HEAD_DIM,
    SC_CH, SC_CH, SC_CH,
)
N_IN = sum(IN_SIZES)
D_FF = 5632
FFN_CONV_WIDTH = 3
EPS = 1e-6

kernel_name = "hybrid_gla_swa_shortconv_trunk"


def rms_norm(x, g):
    xf = x.astype(jnp.float32)
    y = xf * lax.rsqrt(jnp.mean(xf * xf, axis=-1, keepdims=True) + EPS)
    return (y * g.astype(jnp.float32)).astype(x.dtype)


def split_cols(z, sizes):
    return jnp.split(z, [int(i) for i in np.cumsum(sizes)[:-1]], axis=-1)


def rope_tables(positions, dim):
    inv = 1.0 / (ROPE_THETA ** (jnp.arange(0, dim, 2, dtype=jnp.float32) / dim))
    ang = positions.astype(jnp.float32)[..., None] * inv
    return jnp.cos(ang), jnp.sin(ang)


def apply_rope(x, cos, sin):
    xf = x.astype(jnp.float32)
    x1, x2 = jnp.split(xf, 2, axis=-1)
    c, s = cos[:, :, None, :], sin[:, :, None, :]
    return jnp.concatenate([x1 * c - x2 * s, x2 * c + x1 * s], axis=-1)


def causal_dwconv(u, w):
    K = w.shape[0]
    T = u.shape[1]
    up = jnp.pad(u, ((0, 0), (K - 1, 0), (0, 0)))
    y = up[:, 0:T] * w[0]
    for j in range(1, K):
        y = y + up[:, j:j + T] * w[j]
    return y


def gla_chunked(q, k, v, log_a):
    B, T, H, dk = q.shape
    dv = v.shape[-1]
    C = GLA_CHUNK
    NC = T // C

    def to_chunks(a):
        return a.astype(jnp.float32).reshape(B, NC, C, H, a.shape[-1]).transpose(1, 0, 3, 2, 4)

    qc, kc, vc, gc = to_chunks(q * (dk ** -0.5)), to_chunks(k), to_chunks(v), to_chunks(log_a)
    mask = jnp.tril(jnp.ones((C, C), dtype=bool))[:, :, None]

    def step(S, inp):
        qi, ki, vi, gi = inp
        b = jnp.cumsum(gi, axis=-2)
        b_last = b[..., -1:, :]
        o_inter = jnp.einsum('bhcd,bhde->bhce', qi * jnp.exp(b), S)
        diff = b[..., :, None, :] - b[..., None, :, :]
        decay = jnp.exp(jnp.where(mask, diff, -jnp.inf))
        att = jnp.einsum('bhtd,bhsd,bhtsd->bhts', qi, ki, decay)
        o_intra = jnp.einsum('bhts,bhse->bhte', att, vi)
        S_new = S * jnp.exp(b_last)[:, :, 0, :, None] + jnp.einsum(
            'bhsd,bhse->bhde', ki * jnp.exp(b_last - b), vi)
        return S_new, o_inter + o_intra

    S0 = jnp.zeros((B, H, dk, dv), jnp.float32)
    _, out = lax.scan(step, S0, (qc, kc, vc, gc))
    return out.transpose(1, 0, 3, 2, 4).reshape(B, T, H, dv)


def swa_with_sinks(q, k, v, sinks):
    B, T, Hq, hd = q.shape
    Hkv = k.shape[2]
    G = Hq // Hkv
    W = SWA_WINDOW
    NB = T // W
    vf = v.astype(jnp.float32)
    qb = q.reshape(B, NB, W, Hkv, G, hd)

    def with_prev(a):
        ab = a.reshape(B, NB, W, Hkv, hd)
        prev = jnp.concatenate([jnp.zeros_like(ab[:, :1]), ab[:, :-1]], axis=1)
        return jnp.concatenate([prev, ab], axis=2)

    kk, vv = with_prev(k), with_prev(vf)
    s = jnp.einsum('bnqhgd,bnkhd->bnhgqk', qb, kk) * (hd ** -0.5)
    qi = jnp.arange(W)[:, None] + W
    ki = jnp.arange(2 * W)[None, :]
    rel = qi - ki
    allowed = (rel >= 0) & (rel < W)
    blk = jnp.arange(NB)[:, None, None]
    valid = allowed[None] & ((blk > 0) | (ki[None] >= W))
    s = jnp.where(valid[None, :, None, None], s, -jnp.inf)
    sink = sinks.astype(jnp.float32).reshape(Hkv, G)[None, None, :, :, None, None]
    m = jnp.maximum(jnp.max(s, axis=-1, keepdims=True), sink)
    p = jnp.exp(s - m)
    denom = jnp.sum(p, axis=-1, keepdims=True) + jnp.exp(sink - m)
    o = jnp.einsum('bnhgqk,bnkhd->bnqhgd', p / denom, vv)
    return o.reshape(B, T, Hq * hd)


def hybrid_mixer(h, cos, sin, w_in, gla_w_gate, gla_b_gate, gla_norm, swa_sinks, sc_conv, w_out):
    B, T, _ = h.shape
    z = h @ w_in
    (g_q, g_k, g_v, g_r, g_lr, s_q, s_k, s_v, c_b, c_c, c_h) = split_cols(z, IN_SIZES)
    log_a = jax.nn.log_sigmoid((g_lr @ gla_w_gate + gla_b_gate).astype(jnp.float32)) / GLA_GATE_TAU
    o_a = gla_chunked(g_q.reshape(B, T, GLA_HEADS, GLA_DK), g_k.reshape(B, T, GLA_HEADS, GLA_DK),
                      g_v.reshape(B, T, GLA_HEADS, GLA_DV), log_a.reshape(B, T, GLA_HEADS, GLA_DK))
    o_a = rms_norm(o_a, gla_norm).reshape(B, T, GLA_HEADS * GLA_DV)
    o_a = (o_a * jax.nn.silu(g_r.astype(jnp.float32))).astype(h.dtype)
    q = apply_rope(s_q.reshape(B, T, SWA_Q_HEADS, SWA_HEAD_DIM), cos, sin)
    k = apply_rope(s_k.reshape(B, T, SWA_KV_HEADS, SWA_HEAD_DIM), cos, sin)
    o_b = swa_with_sinks(q, k, s_v.reshape(B, T, SWA_KV_HEADS, SWA_HEAD_DIM), swa_sinks).astype(h.dtype)
    o_c = c_b * causal_dwconv(c_c * c_h, sc_conv)
    return jnp.concatenate([o_a, o_b, o_c.astype(h.dtype)], axis=-1) @ w_out


def memory_cross_attention(h, m, wq, wk, wv, wo):
    B, T, _ = h.shape
    q = (h @ wq).reshape(B, T, XA_HEADS, XA_HEAD_DIM).astype(jnp.float32)
    k = (m @ wk).reshape(B, N_MEM, XA_HEADS, XA_HEAD_DIM).astype(jnp.float32)
    v = (m @ wv).reshape(B, N_MEM, XA_HEADS, XA_HEAD_DIM).astype(jnp.float32)
    p = jax.nn.softmax(jnp.einsum('bthd,bmhd->bhtm', q, k) * (XA_HEAD_DIM ** -0.5), axis=-1)
    o = jnp.einsum('bhtm,bmhd->bthd', p, v).reshape(B, T, D_MODEL).astype(h.dtype)
    return o @ wo


def conv_ffn(h, w_up, conv_w, conv_b, w_down):
    u = causal_dwconv(h @ w_up, conv_w) + conv_b
    g, val = jnp.split(u, 2, axis=-1)
    return (jax.nn.silu(g) * val) @ w_down


def setup_inputs(seed: int = 0) -> dict:
    key = jax.random.key(seed)
    ks = jax.random.split(key, 24)
    f32 = jnp.float32

    def nrm(k, shape, scale):
        return jax.random.normal(k, shape, f32) * scale

    def gain(k, shape):
        return 1.0 + 0.02 * jax.random.normal(k, shape, f32)

    offset = jax.random.randint(ks[2], (BATCH, 1), 0, 1024, dtype=jnp.int32)
    positions = offset + jnp.arange(SEQ, dtype=jnp.int32)[None, :]
    return {
        "x": nrm(ks[0], (BATCH, SEQ, D_MODEL), 1.0),
        "mem": nrm(ks[1], (BATCH, N_MEM, D_MODEL), 1.0),
        "positions": positions,
        "norm_mix": gain(ks[3], (DEPTH, D_MODEL)),
        "w_in": nrm(ks[4], (DEPTH, D_MODEL, N_IN), D_MODEL ** -0.5),
        "gla_w_gate": nrm(ks[5], (DEPTH, GLA_GATE_RANK, GLA_HEADS * GLA_DK), GLA_GATE_RANK ** -0.5),
        "gla_b_gate": nrm(ks[6], (DEPTH, GLA_HEADS * GLA_DK), 0.1),
        "gla_norm": gain(ks[7], (DEPTH, GLA_DV)),
        "swa_sinks": nrm(ks[8], (DEPTH, SWA_Q_HEADS), 0.5),
        "sc_conv": nrm(ks[9], (DEPTH, SC_WIDTH, SC_CH), SC_WIDTH ** -0.5),
        "w_out": nrm(ks[10], (DEPTH, D_MIX, D_MODEL), D_MIX ** -0.5),
        "norm_x": gain(ks[11], (DEPTH, D_MODEL)),
        "norm_mem": gain(ks[12], (DEPTH, D_MODEL)),
        "xa_wq": nrm(ks[13], (DEPTH, D_MODEL, D_MODEL), D_MODEL ** -0.5),
        "xa_wk": nrm(ks[14], (DEPTH, D_MODEL, D_MODEL), D_MODEL ** -0.5),
        "xa_wv": nrm(ks[15], (DEPTH, D_MODEL, D_MODEL), D_MODEL ** -0.5),
        "xa_wo": nrm(ks[16], (DEPTH, D_MODEL, D_MODEL), D_MODEL ** -0.5),
        "norm_ffn": gain(ks[17], (DEPTH, D_MODEL)),
        "ffn_w_up": nrm(ks[18], (DEPTH, D_MODEL, 2 * D_FF), D_MODEL ** -0.5),
        "ffn_conv": nrm(ks[19], (DEPTH, FFN_CONV_WIDTH, 2 * D_FF), FFN_CONV_WIDTH ** -0.5),
        "ffn_conv_b": nrm(ks[20], (DEPTH, 2 * D_FF), 0.01),
        "ffn_w_down": nrm(ks[21], (DEPTH, D_FF, D_MODEL), D_FF ** -0.5),
        "norm_final": gain(ks[22], (D_MODEL,)),
    }


def reference(x, mem, positions, norm_mix, w_in, gla_w_gate, gla_b_gate, gla_norm, swa_sinks, sc_conv,
              w_out, norm_x, norm_mem, xa_wq, xa_wk, xa_wv, xa_wo, norm_ffn, ffn_w_up, ffn_conv,
              ffn_conv_b, ffn_w_down, norm_final):
    cos, sin = rope_tables(positions, SWA_HEAD_DIM)
    h = x
    for l in range(DEPTH):
        h = h + hybrid_mixer(rms_norm(h, norm_mix[l]), cos, sin, w_in[l], gla_w_gate[l], gla_b_gate[l],
                             gla_norm[l], swa_sinks[l], sc_conv[l], w_out[l])
        h = h + memory_cross_attention(rms_norm(h, norm_x[l]), rms_norm(mem, norm_mem[l]),
                                       xa_wq[l], xa_wk[l], xa_wv[l], xa_wo[l])
        h = h + conv_ffn(rms_norm(h, norm_ffn[l]), ffn_w_up[l], ffn_conv[l], ffn_conv_b[l], ffn_w_down[l])
    return rms_norm(h, norm_final)
```

```cpp
#include <hip/hip_runtime.h>
#include <cstdio>
#include <cstdint>

#define LAS __attribute__((address_space(3)))
#define GAS __attribute__((address_space(1)))
typedef unsigned short bf16_t;
typedef short bf16x8 __attribute__((ext_vector_type(8)));
typedef float f32x4 __attribute__((ext_vector_type(4)));
typedef float f32x2 __attribute__((ext_vector_type(2)));
typedef unsigned u32x4 __attribute__((ext_vector_type(4)));
typedef unsigned u32x2 __attribute__((ext_vector_type(2)));

#ifndef MK_ONE_LAUNCH
#define MK_ONE_LAUNCH 1
#endif

constexpr int T = 8192, D = 2048, NL = 4, NMEM = 256, NZ = 4608, DFF = 5632, NUP = 11264, NSC = 1024, NIN = 4368;
constexpr float EPS = 1e-6f;
constexpr int ZQ = 0, ZK = 256, ZV = 512, ZR = 1024, ZG = 1536, ZSQ = 1792, ZSK = 2816, ZSV = 2944, ZCB = 3072, ZCC = 3584, ZCH = 4096;

constexpr size_t MiB = 1u << 20;
constexpr size_t WS_CTL = 0, CTL_BYTES = 2 * MiB;
constexpr size_t SZ_WIN = (size_t)NZ * D * 2, SZ_W22 = (size_t)D * D * 2, SZ_WUP = (size_t)NUP * D * 2, SZ_WDN = (size_t)D * DFF * 2;
constexpr size_t SZ_WS = (size_t)NSC * D * 2, SZ_MEM = (size_t)NMEM * D * 2;
constexpr size_t WS_WIN = WS_CTL + CTL_BYTES;
constexpr size_t WS_WOUT = WS_WIN + NL * SZ_WIN;
constexpr size_t WS_WQP = WS_WOUT + NL * SZ_W22;
constexpr size_t WS_WK = WS_WQP + NL * SZ_W22;
constexpr size_t WS_WV = WS_WK + NL * SZ_W22;
constexpr size_t WS_WO = WS_WV + NL * SZ_W22;
constexpr size_t WS_WUP = WS_WO + NL * SZ_W22;
constexpr size_t WS_WDN = WS_WUP + NL * SZ_WUP;
constexpr size_t WS_WST = WS_WDN + NL * SZ_WDN;
constexpr size_t WS_VWT = WS_WST + NL * SZ_WS;
constexpr size_t WS_MEMN = WS_VWT + NL * SZ_WS;
constexpr size_t WS_KMEM = WS_MEMN + NL * SZ_MEM;
constexpr size_t WS_VMEM = WS_KMEM + NL * SZ_MEM;
constexpr size_t WS_ROPE = WS_VMEM + NL * SZ_MEM;
constexpr size_t WS_H = WS_ROPE + 2 * MiB;
constexpr size_t WS_HB = WS_H + (size_t)T * D * 4;
constexpr size_t WS_Z = WS_HB + (size_t)T * D * 2;
constexpr size_t WS_LA = WS_Z + (size_t)T * NZ * 2;
constexpr size_t WS_MIX = WS_LA + (size_t)T * 256 * 4;
constexpr size_t WS_UB = WS_MIX + (size_t)T * D * 2;
constexpr size_t WS_DEC = WS_UB + (size_t)4 * 128 * 64 * 128 * 4;
constexpr size_t WS_SB = WS_DEC + 1 * MiB;
constexpr size_t WS_SC = WS_SB + (size_t)4 * 128 * 64 * 128 * 2;
constexpr size_t WS_PB = WS_SC + (size_t)T * NSC * 4;
constexpr size_t WS_U = WS_PB + (size_t)T * NSC * 2;
constexpr size_t WS_HT = WS_U;
constexpr size_t WS_AB = WS_U + (size_t)T * NUP * 2;
constexpr size_t WS_SSP = WS_AB + (size_t)T * DFF * 2;
constexpr size_t WS_END = WS_SSP + (size_t)13 * T * 32 * 4;
constexpr int CW_TMO = 0, CW_BAR = 4096;

constexpr int RING_BYTES = 131072, MISC_OFF = RING_BYTES, LDS_BYTES = 147456;

__device__ __forceinline__ float bf2f(unsigned b) { return __uint_as_float(b << 16); }
typedef __bf16 bf16x2_t __attribute__((ext_vector_type(2)));
__device__ __forceinline__ unsigned pk2(float lo, float hi) { const f32x2 v = {lo, hi}; return __builtin_bit_cast(unsigned, __builtin_convertvector(v, bf16x2_t)); }
__device__ __forceinline__ unsigned f2bf(float f) { return pk2(f, 0.f) & 0xffffu; }
__device__ __forceinline__ unsigned cvt_pk_bf16(float lo, float hi) { unsigned r; asm volatile("v_cvt_pk_bf16_f32 %0, %1, %2" : "=v"(r) : "v"(lo), "v"(hi)); return r; }
__device__ __forceinline__ float shx(float v, int m, int lane) { return __builtin_bit_cast(float, __builtin_amdgcn_ds_bpermute((lane ^ m) << 2, __builtin_bit_cast(int, v))); }
__device__ __forceinline__ float wave_sum(float v, int lane) {
#pragma unroll
    for (int o = 1; o < 64; o <<= 1) v += shx(v, o, lane);
    return v;
}
__device__ __forceinline__ float wave_max(float v, int lane) {
#pragma unroll
    for (int o = 1; o < 64; o <<= 1) v = fmaxf(v, shx(v, o, lane));
    return v;
}
__device__ __forceinline__ float siluf(float x) { return x / (1.f + __expf(-x)); }
__device__ __forceinline__ float logsigf(float x) { return fminf(x, 0.f) - __logf(1.f + __expf(-fabsf(x))); }
__device__ __forceinline__ void st16_wt(void* p, u32x4 v) { *(u32x4*)p = v; }
#define LDS_WAIT() asm volatile("s_waitcnt lgkmcnt(0)" ::: "memory")
#define VM_WAIT() asm volatile("s_waitcnt vmcnt(0)" ::: "memory")

namespace pg8 {
constexpr int BM = 256, BK = 64, HALF = 128, HTB = HALF * BK * 2, STAGE_BYTES = 8 * HTB, NXCD = 8, WGM = 4;
__host__ __device__ __forceinline__ int lds_byte(int r, int c) { const int st = (r >> 4) * 2 + (c >> 5), rr = r & 15, cc = c & 31, ob = rr * 64 + cc * 2; return st * 1024 + (ob ^ (((ob >> 9) & 1) << 5)); }
__host__ __device__ __forceinline__ void stage_rc(int b, int& R, int& C) { const int st = b / 1024, sb = b % 1024, swz = sb ^ (((sb >> 9) & 1) << 5); R = (st >> 1) * 16 + swz / 64; C = (st & 1) * 32 + (swz % 64) / 2; }
__host__ __device__ __forceinline__ int perm32(int rho) { const int n = rho >> 4, i = rho & 15; return 8 * (i >> 2) + 4 * n + (i & 3); }

struct Unit { int pm, pn; const char* a; const char* b; char* o; int ldc; float sc; };
struct Gemm { int K, lda, ldb; };

struct TileOrder {
    const char* A; const char* Bt; int nM, nN, nwg, G, c; size_t ta, tb;
    __device__ __forceinline__ void init(const void* A_, const void* Bt_, int M, int N, int lda, int ldb, int G_, int c_) {
        A = (const char*)A_; Bt = (const char*)Bt_; nM = M / BM; nN = N / BM; nwg = nM * nN; G = G_; c = c_; ta = (size_t)BM * lda * 2; tb = (size_t)BM * ldb * 2; }
    __device__ __forceinline__ bool next(int i, Unit& u) const {
        const long L = (long)i * G + c; if (L >= nwg) return false;
        int wgid = (int)L; { const int q = nwg / NXCD, r = nwg % NXCD, xcd = wgid % NXCD, off = wgid / NXCD; wgid = (xcd < r ? xcd * (q + 1) : r * (q + 1) + (xcd - r) * q) + off; }
        const int nig = WGM * nN, gid = wgid / nig, fm = gid * WGM, gsz = (nM - fm) < WGM ? (nM - fm) : WGM;
        u.pm = fm + ((wgid % nig) % gsz); u.pn = (wgid % nig) / gsz;
        u.a = A + (size_t)u.pm * ta; u.b = Bt + (size_t)u.pn * tb; u.o = nullptr; u.ldc = 0; u.sc = 1.f; return true;
    }
    __device__ __forceinline__ void a_ready(const Unit&) const {}
    __device__ __forceinline__ void done(const Unit&) const {}
};

template <class Epi, class Sched, bool ALIGN_EPI>
__device__ __forceinline__ void gemm_phase(LAS unsigned char* lds, const Gemm g, const Sched& S, const Epi& E, int tid_in) {
    int tid_ = tid_in; asm volatile("" : "+v"(tid_));
    const int tid = tid_, wid = __builtin_amdgcn_readfirstlane(tid >> 6), lane = tid & 63, wr = wid >> 2, wc = wid & 3, fr = lane & 15, fq = lane >> 4;
    const int K = g.K, nt = K / BK;
    unsigned voffA[2], voffB[2];
#pragma unroll
    for (int i = 0; i < 2; ++i) { int R, C; stage_rc(tid * 16 + i * 8192, R, C); const int Rb = Epi::PERM ? ((R & ~31) + perm32(R & 31)) : R;
        const int Ra = Epi::ROWPERM ? ((R & 64) | ((R & 15) << 2) | ((R >> 4) & 3)) : R;
        voffA[i] = (unsigned)(Ra * g.lda + C) * 2u; voffB[i] = (unsigned)(Rb * g.ldb + C) * 2u; }
    const size_t kstep = (size_t)(BK * 2);
    const size_t hstepA = (size_t)HALF * g.lda * 2, hstepB = (size_t)HALF * g.ldb * 2;
    const unsigned ldsw = (unsigned)wid * 1024u;
    const int aoff = lds_byte(wr * 64 + fr, fq * 8), boff = lds_byte(wc * 32 + fr, fq * 8);
#define PG8_SA(b, h) (((b) * 2 + (h)) * HTB)
#define PG8_SB(b, h) ((4 + (b) * 2 + (h)) * HTB)
#define PG8_STAGE(bufoff, gbase, voff) do { _Pragma("unroll") for (int _i = 0; _i < 2; ++_i) \
        __builtin_amdgcn_global_load_lds((const unsigned*)((const char*)(gbase) + (voff)[_i]), (LAS unsigned*)(lds + (bufoff) + ldsw + _i * 8192), 16, 0, 0); } while (0)
#define PG8_LDA(dst, b, h) do { _Pragma("unroll") for (int m = 0; m < 4; ++m) _Pragma("unroll") for (int k = 0; k < 2; ++k) dst[m][k] = *(const LAS bf16x8*)(lds + PG8_SA(b, h) + aoff + m * 2048 + k * 1024); } while (0)
#define PG8_LDB(dst, b, h) do { _Pragma("unroll") for (int n = 0; n < 2; ++n) _Pragma("unroll") for (int k = 0; k < 2; ++k) dst[n][k] = *(const LAS bf16x8*)(lds + PG8_SB(b, h) + boff + n * 2048 + k * 1024); } while (0)
#define PG8_MMA(ai, bj, At, Bt) do { __builtin_amdgcn_s_setprio(1); _Pragma("unroll") for (int m = 0; m < 4; ++m) _Pragma("unroll") for (int n = 0; n < 2; ++n) _Pragma("unroll") for (int k = 0; k < 2; ++k) \
        acc[ai][bj][m][n] = __builtin_amdgcn_mfma_f32_16x16x32_bf16(Bt[n][k], At[m][k], acc[ai][bj][m][n], 0, 0, 0); __builtin_amdgcn_s_setprio(0); } while (0)
#define PG8_WAIT_V(n) asm volatile("s_waitcnt vmcnt(" #n ")" ::: "memory")
#define PG8_WAIT_L(n) asm volatile("s_waitcnt lgkmcnt(" #n ")" ::: "memory")
#define PG8_BAR __builtin_amdgcn_s_barrier()
#define PG8_SCHED __builtin_amdgcn_sched_barrier(0)
    Unit cur, nxt; int ui = 0;
    if (!S.next(0, cur)) return;
    f32x4 acc[2][2][4][2];
#pragma unroll
    for (int a = 0; a < 2; ++a)
#pragma unroll
        for (int b = 0; b < 2; ++b)
#pragma unroll
            for (int m = 0; m < 4; ++m)
#pragma unroll
                for (int n = 0; n < 2; ++n) acc[a][b][m][n] = (f32x4){0.f, 0.f, 0.f, 0.f};
    bf16x8 At[4][2], B0[2][2], B1[2][2];
    const char* cA = cur.a; const char* cB = cur.b;
    S.a_ready(cur);
    PG8_STAGE(PG8_SB(0, 0), cB, voffB); PG8_STAGE(PG8_SB(0, 1), cB + hstepB, voffB); PG8_STAGE(PG8_SA(0, 0), cA, voffA); PG8_STAGE(PG8_SA(0, 1), cA + hstepA, voffA);
    PG8_STAGE(PG8_SB(1, 0), cB + kstep, voffB); PG8_STAGE(PG8_SA(1, 0), cA + kstep, voffA); PG8_STAGE(PG8_SB(1, 1), cB + hstepB + kstep, voffB);
    if constexpr (Epi::PREFILL) E.prefill(tid);
    if (wr == 1) PG8_BAR;
    PG8_WAIT_V(8); PG8_BAR;
    PG8_WAIT_V(6); PG8_BAR;
    for (;;) {
        const bool has_next = S.next(ui + 1, nxt);
        const char* nA = has_next ? nxt.a : cA; const char* nB = has_next ? nxt.b : cB;
        for (int t = 0; t < nt; t += 2) {
            const bool last = (t == nt - 2);
            const char* a1 = cA + (size_t)(t + 1) * kstep;
            const char* a2 = last ? nA : cA + (size_t)(t + 2) * kstep; const char* b2 = last ? nB : cB + (size_t)(t + 2) * kstep;
            const char* a3 = a2 + kstep; const char* b3 = b2 + kstep;
            if (last && has_next) S.a_ready(nxt);
            PG8_LDB(B0, 0, 0); PG8_LDB(B1, 0, 1); PG8_SCHED; PG8_LDA(At, 0, 0); PG8_STAGE(PG8_SA(1, 1), a1 + hstepA, voffA);
            PG8_WAIT_V(8); PG8_WAIT_L(0); PG8_BAR; PG8_MMA(0, 0, At, B0); PG8_MMA(0, 1, At, B1); PG8_BAR; PG8_SCHED;
            PG8_LDA(At, 0, 1); PG8_STAGE(PG8_SB(0, 0), b2, voffB); PG8_STAGE(PG8_SB(0, 1), b2 + hstepB, voffB); PG8_STAGE(PG8_SA(0, 0), a2, voffA);
            PG8_WAIT_V(8); PG8_WAIT_L(0); PG8_BAR; PG8_MMA(1, 0, At, B0); PG8_MMA(1, 1, At, B1); PG8_BAR; PG8_SCHED;
            PG8_LDB(B0, 1, 0); PG8_LDB(B1, 1, 1); PG8_SCHED; PG8_LDA(At, 1, 0); PG8_STAGE(PG8_SA(0, 1), a2 + hstepA, voffA);
            PG8_WAIT_V(8); PG8_WAIT_L(0); PG8_BAR; PG8_MMA(0, 0, At, B0); PG8_MMA(0, 1, At, B1); PG8_BAR; PG8_SCHED;
            PG8_LDA(At, 1, 1); PG8_STAGE(PG8_SB(1, 0), b3, voffB); PG8_STAGE(PG8_SB(1, 1), b3 + hstepB, voffB); PG8_STAGE(PG8_SA(1, 0), a3, voffA);
            PG8_WAIT_V(8); PG8_WAIT_L(0); PG8_BAR; PG8_MMA(1, 0, At, B0); PG8_MMA(1, 1, At, B1); PG8_BAR; PG8_SCHED;
        }
        if constexpr (ALIGN_EPI) { if (wr == 0) PG8_BAR; }
        if constexpr (!Epi::AFTER_DRAIN) { int le; asm volatile("v_mbcnt_lo_u32_b32 %0, -1, 0\n\tv_mbcnt_hi_u32_b32 %0, -1, %0" : "=v"(le));
            E(acc, cur, wr, wc, le & 15, le >> 4); S.done(cur); }
        if (!has_next) break;
#pragma unroll
        for (int a = 0; a < 2; ++a)
#pragma unroll
            for (int b = 0; b < 2; ++b)
#pragma unroll
                for (int m = 0; m < 4; ++m)
#pragma unroll
                    for (int n = 0; n < 2; ++n) acc[a][b][m][n] = (f32x4){0.f, 0.f, 0.f, 0.f};
        cur = nxt; cA = nA; cB = nB; ++ui;
        if constexpr (ALIGN_EPI) { if (wr == 1) PG8_BAR; }
    }
    PG8_WAIT_V(0);
    if constexpr (!ALIGN_EPI) { if (wr == 0) PG8_BAR; }
    PG8_BAR;
    if constexpr (Epi::AFTER_DRAIN) { int le; asm volatile("v_mbcnt_lo_u32_b32 %0, -1, 0\n\tv_mbcnt_hi_u32_b32 %0, -1, %0" : "=v"(le)); E.fused(acc, cur, wr, wc, le & 15, le >> 4, lds, wid, le); S.done(cur); }
#undef PG8_SA
#undef PG8_SB
#undef PG8_STAGE
#undef PG8_LDA
#undef PG8_LDB
#undef PG8_MMA
#undef PG8_WAIT_V
#undef PG8_WAIT_L
#undef PG8_BAR
#undef PG8_SCHED
}


__device__ __forceinline__ float row_rstd_l(const float* ssp, int row, int fq, int lane) {
    const f32x4* p = (const f32x4*)(ssp + (size_t)row * 32 + 8 * fq); const f32x4 a = p[0], b = p[1];
    float s = ((a[0] + a[1]) + (a[2] + a[3])) + ((b[0] + b[1]) + (b[2] + b[3]));
    s += shx(s, 16, lane); s += shx(s, 32, lane);
    return rsqrtf(s * (1.f / D) + EPS);
}
__device__ __forceinline__ float row_rstd(const float* ssp, int row, int fq) { return row_rstd_l(ssp, row, fq, (row & 15) + 16 * fq); }
__device__ __forceinline__ void rstd8(const float* ssp, int row0, int fq, float (&rs)[2][4]) {
    f32x4 a[2][4], b[2][4];
#pragma unroll
    for (int ai = 0; ai < 2; ++ai)
#pragma unroll
        for (int m = 0; m < 4; ++m) { const f32x4* p = (const f32x4*)(ssp + (size_t)(row0 + ai * HALF + m * 16) * 32 + 8 * fq); a[ai][m] = p[0]; b[ai][m] = p[1]; }
#pragma unroll
    for (int ai = 0; ai < 2; ++ai)
#pragma unroll
        for (int m = 0; m < 4; ++m) rs[ai][m] = ((a[ai][m][0] + a[ai][m][1]) + (a[ai][m][2] + a[ai][m][3])) + ((b[ai][m][0] + b[ai][m][1]) + (b[ai][m][2] + b[ai][m][3]));
#pragma unroll
    for (int ai = 0; ai < 2; ++ai)
#pragma unroll
        for (int m = 0; m < 4; ++m) rs[ai][m] += shx(rs[ai][m], 16, (row0 & 15) + 16 * fq);
#pragma unroll
    for (int ai = 0; ai < 2; ++ai)
#pragma unroll
        for (int m = 0; m < 4; ++m) rs[ai][m] += shx(rs[ai][m], 32, (row0 & 15) + 16 * fq);
#pragma unroll
    for (int ai = 0; ai < 2; ++ai)
#pragma unroll
        for (int m = 0; m < 4; ++m) rs[ai][m] = rsqrtf(rs[ai][m] * (1.f / D) + EPS);
}
__device__ __forceinline__ void rstd_table_fill(const float* ssp, int tid) {
    LAS float* rtab = (LAS float*)(__builtin_amdgcn_groupstaticsize() + MISC_OFF + 1024);
    const int pm = 4 * ((int)blockIdx.x & 7) + (((int)blockIdx.x >> 3) & 3), row = tid >> 1, hf = tid & 1; const f32x4* p = (const f32x4*)(ssp + ((size_t)pm * 256 + row) * 32 + 16 * hf);
    const f32x4 a = p[0], b = p[1], c = p[2], d = p[3];
    float sacc = (((a[0] + a[1]) + (a[2] + a[3])) + ((b[0] + b[1]) + (b[2] + b[3]))) + (((c[0] + c[1]) + (c[2] + c[3])) + ((d[0] + d[1]) + (d[2] + d[3])));
    sacc += shx(sacc, 1, tid & 63);
    if (hf == 0) rtab[row] = rsqrtf(sacc * (1.f / D) + EPS);
    __syncthreads();
}
__device__ __forceinline__ void rstd8_tab(const float* ssp, const Unit& u, int wr, int fr, int fq, float (&rs)[2][4]) {
    const LAS float* rtab = (const LAS float*)(__builtin_amdgcn_groupstaticsize() + MISC_OFF + 1024);
    const int tab_pm = 4 * ((int)blockIdx.x & 7) + (((int)blockIdx.x >> 3) & 3);
    if (u.pm == tab_pm) {
#pragma unroll
        for (int ai = 0; ai < 2; ++ai)
#pragma unroll
            for (int m = 0; m < 4; ++m) rs[ai][m] = rtab[wr * 64 + fr + ai * HALF + m * 16];
    } else {
#pragma unroll
        for (int ai = 0; ai < 2; ++ai)
#pragma unroll
            for (int m = 0; m < 4; ++m) { rs[ai][m] = row_rstd(ssp, u.pm * BM + wr * 64 + fr + ai * HALF + m * 16, fq); asm volatile("" ::: "memory"); }
    }
}
__device__ __forceinline__ void rstd8_tab4(const float* ssp, const Unit& u, int wr, int fr, int fq, float (&rs)[2][4]) {
    const LAS float* rtab = (const LAS float*)(__builtin_amdgcn_groupstaticsize() + MISC_OFF + 1024);
    const int tab_pm = 4 * ((int)blockIdx.x & 7) + (((int)blockIdx.x >> 3) & 3);
    if (u.pm == tab_pm) {
#pragma unroll
        for (int ai = 0; ai < 2; ++ai) { const f32x4 q = *(const LAS f32x4*)(rtab + wr * 64 + ai * HALF + 4 * fr); rs[ai][0] = q[0]; rs[ai][1] = q[1]; rs[ai][2] = q[2]; rs[ai][3] = q[3]; }
    } else {
#pragma unroll
        for (int ai = 0; ai < 2; ++ai)
#pragma unroll
            for (int m = 0; m < 4; ++m) { rs[ai][m] = row_rstd_l(ssp, u.pm * BM + wr * 64 + ai * HALF + 4 * fr + m, fq, fr + 16 * fq); asm volatile("" ::: "memory"); }
    }
}
struct EpiScaleBf16 {
    static constexpr bool PERM = true, AFTER_DRAIN = false, PREFILL = true, ROWPERM = false;
    __device__ __forceinline__ void prefill(int tid) const { rstd_table_fill(ss, tid); }
    bf16_t* O; int ldc; const float* ss; int gate_pn; float* la; const float* bg;
    __device__ __forceinline__ void operator()(const f32x4 (&acc)[2][2][4][2], const Unit& u, int wr, int wc, int fr, int fq) const {
        const int row0 = u.pm * BM + wr * 64 + fr, cl = wc * 32 + 8 * fq;
        float rs8[2][4]; rstd8_tab(ss, u, wr, fr, fq, rs8);
        if (u.pn == gate_pn) {
#pragma unroll
            for (int ai = 0; ai < 2; ++ai)
#pragma unroll
                for (int m = 0; m < 4; ++m) { const int row = row0 + ai * HALF + m * 16; const float rs = rs8[ai][m];
#pragma unroll
                    for (int bj = 0; bj < 2; ++bj) { const int c = bj * HALF + cl; const f32x4 b0 = *(const f32x4*)(bg + c), b1 = *(const f32x4*)(bg + c + 4);
                        f32x4 v0 = acc[ai][bj][m][0] * rs + b0, v1 = acc[ai][bj][m][1] * rs + b1;
#pragma unroll
                        for (int e = 0; e < 4; ++e) { v0[e] = logsigf(v0[e]) * (1.f / 16.f); v1[e] = logsigf(v1[e]) * (1.f / 16.f); }
                        *(f32x4*)(la + (size_t)row * 256 + c) = v0; *(f32x4*)(la + (size_t)row * 256 + c + 4) = v1; } }
        } else {
#pragma unroll
            for (int ai = 0; ai < 2; ++ai)
#pragma unroll
                for (int m = 0; m < 4; ++m) { const int row = row0 + ai * HALF + m * 16; const float rs = rs8[ai][m];
                    bf16_t* rowp = O + (size_t)row * ldc + u.pn * BM + cl;
#pragma unroll
                    for (int bj = 0; bj < 2; ++bj) { const f32x4 v0 = acc[ai][bj][m][0] * rs, v1 = acc[ai][bj][m][1] * rs;
                        u32x4 w; w.x = cvt_pk_bf16(v0[0], v0[1]); w.y = cvt_pk_bf16(v0[2], v0[3]); w.z = cvt_pk_bf16(v1[0], v1[1]); w.w = cvt_pk_bf16(v1[2], v1[3]);
                        st16_wt(rowp + bj * HALF, w); } }
        }
    }
};
struct EpiPlain {
    static constexpr bool PERM = true, AFTER_DRAIN = false, PREFILL = false, ROWPERM = false;
    __device__ __forceinline__ void operator()(const f32x4 (&acc)[2][2][4][2], const Unit& u, int wr, int wc, int fr, int fq) const {
        const int row0 = u.pm * BM + wr * 64 + fr, cl = u.pn * BM + wc * 32 + 8 * fq; const float sc = u.sc; bf16_t* O = (bf16_t*)u.o;
#pragma unroll
        for (int ai = 0; ai < 2; ++ai)
#pragma unroll
            for (int m = 0; m < 4; ++m) { bf16_t* rowp = O + (size_t)(row0 + ai * HALF + m * 16) * u.ldc + cl;
#pragma unroll
                for (int bj = 0; bj < 2; ++bj) { const f32x4 v0 = acc[ai][bj][m][0] * sc, v1 = acc[ai][bj][m][1] * sc;
                    u32x4 w; w.x = cvt_pk_bf16(v0[0], v0[1]); w.y = cvt_pk_bf16(v0[2], v0[3]); w.z = cvt_pk_bf16(v1[0], v1[1]); w.w = cvt_pk_bf16(v1[2], v1[3]);
                    st16_wt(rowp + bj * HALF, w); } }
    }
};
struct EpiScaleF32 {
    static constexpr bool PERM = false, AFTER_DRAIN = false, PREFILL = false, ROWPERM = false;
    float* O; int ldc; const float* ss;
    __device__ __forceinline__ void operator()(const f32x4 (&acc)[2][2][4][2], const Unit& u, int wr, int wc, int fr, int fq) const {
        const int row0 = u.pm * BM + wr * 64 + fr, c0 = u.pn * BM + wc * 32 + 4 * fq;
#pragma unroll
        for (int ai = 0; ai < 2; ++ai)
#pragma unroll
            for (int m = 0; m < 4; ++m) { const int row = row0 + ai * HALF + m * 16; const float rs = row_rstd(ss, row, fq);
#pragma unroll
                for (int bj = 0; bj < 2; ++bj)
#pragma unroll
                    for (int n = 0; n < 2; ++n) *(f32x4*)(O + (size_t)row * ldc + c0 + bj * HALF + n * 16) = acc[ai][bj][m][n] * rs; }
    }
};
struct EpiRes {
    static constexpr bool PERM = true, AFTER_DRAIN = false, PREFILL = false, ROWPERM = false;
    bf16_t* hb; float* ssn;
    __device__ __forceinline__ void operator()(const f32x4 (&acc)[2][2][4][2], const Unit& u, int wr, int wc, int fr, int fq) const {
        const int row0 = u.pm * BM + wr * 64 + fr, c0 = u.pn * BM + wc * 32 + 8 * fq;
        u32x4 pre[2][4][2];
#pragma unroll
        for (int ai = 0; ai < 2; ++ai)
#pragma unroll
            for (int m = 0; m < 4; ++m)
#pragma unroll
                for (int bj = 0; bj < 2; ++bj) pre[ai][m][bj] = *(const u32x4*)(hb + (size_t)(row0 + ai * HALF + m * 16) * D + c0 + bj * HALF);
#pragma unroll
        for (int ai = 0; ai < 2; ++ai)
#pragma unroll
            for (int m = 0; m < 4; ++m) { const int row = row0 + ai * HALF + m * 16; const size_t off = (size_t)row * D + c0; float s = 0.f;
#pragma unroll
                for (int bj = 0; bj < 2; ++bj) { const u32x4 b = pre[ai][m][bj]; const f32x4 a0 = acc[ai][bj][m][0], a1 = acc[ai][bj][m][1];
                    const float o0 = bf2f(b.x & 0xffffu) + a0[0], o1 = bf2f(b.x >> 16) + a0[1], o2 = bf2f(b.y & 0xffffu) + a0[2], o3 = bf2f(b.y >> 16) + a0[3];
                    const float o4 = bf2f(b.z & 0xffffu) + a1[0], o5 = bf2f(b.z >> 16) + a1[1], o6 = bf2f(b.w & 0xffffu) + a1[2], o7 = bf2f(b.w >> 16) + a1[3];
                    u32x4 w; w.x = cvt_pk_bf16(o0, o1); w.y = cvt_pk_bf16(o2, o3); w.z = cvt_pk_bf16(o4, o5); w.w = cvt_pk_bf16(o6, o7); st16_wt(hb + off + bj * HALF, w);
                    s += ((o0 * o0 + o1 * o1) + (o2 * o2 + o3 * o3)) + ((o4 * o4 + o5 * o5) + (o6 * o6 + o7 * o7)); }
                s += shx(s, 16, fr + 16 * fq); s += shx(s, 32, fr + 16 * fq);
                if (fq == 0) ssn[(size_t)row * 32 + u.pn * 4 + wc] = s; }
    }
};
__device__ __forceinline__ void conv_wrap(f32x4& G0, f32x4& G1, const f32x4& u2, const f32x4& u3, const f32x4& w1, const f32x4& w0) {
    asm("s_nop 1\n\t"
        "v_fmac_f32_dpp %0, %12, %16 row_shr:1 row_mask:0xf bank_mask:0xf\n\t"
        "v_fmac_f32_dpp %1, %13, %17 row_shr:1 row_mask:0xf bank_mask:0xf\n\t"
        "v_fmac_f32_dpp %2, %14, %18 row_shr:1 row_mask:0xf bank_mask:0xf\n\t"
        "v_fmac_f32_dpp %3, %15, %19 row_shr:1 row_mask:0xf bank_mask:0xf\n\t"
        "v_fmac_f32_dpp %0, %8, %20 row_shr:1 row_mask:0xf bank_mask:0xf\n\t"
        "v_fmac_f32_dpp %1, %9, %21 row_shr:1 row_mask:0xf bank_mask:0xf\n\t"
        "v_fmac_f32_dpp %2, %10, %22 row_shr:1 row_mask:0xf bank_mask:0xf\n\t"
        "v_fmac_f32_dpp %3, %11, %23 row_shr:1 row_mask:0xf bank_mask:0xf\n\t"
        "v_fmac_f32_dpp %4, %12, %20 row_shr:1 row_mask:0xf bank_mask:0xf\n\t"
        "v_fmac_f32_dpp %5, %13, %21 row_shr:1 row_mask:0xf bank_mask:0xf\n\t"
        "v_fmac_f32_dpp %6, %14, %22 row_shr:1 row_mask:0xf bank_mask:0xf\n\t"
        "v_fmac_f32_dpp %7, %15, %23 row_shr:1 row_mask:0xf bank_mask:0xf"
        : "+v"(G0[0]), "+v"(G0[1]), "+v"(G0[2]), "+v"(G0[3]), "+v"(G1[0]), "+v"(G1[1]), "+v"(G1[2]), "+v"(G1[3])
        : "v"(u2[0]), "v"(u2[1]), "v"(u2[2]), "v"(u2[3]), "v"(u3[0]), "v"(u3[1]), "v"(u3[2]), "v"(u3[3]), "v"(w1[0]), "v"(w1[1]), "v"(w1[2]), "v"(w1[3]), "v"(w0[0]), "v"(w0[1]), "v"(w0[2]), "v"(w0[3]));
}
__device__ __forceinline__ float exp_sub(float x, float mL) { return __builtin_amdgcn_exp2f(__builtin_fmaf(x, 1.44269504088896341f, -mL)); }
__device__ __forceinline__ float silu_fast(float x) { return x * __builtin_amdgcn_rcpf(1.f + __expf(-x)); }
struct EpiUpConv {
    static constexpr bool PERM = true, AFTER_DRAIN = false, PREFILL = true, ROWPERM = true;
    __device__ __forceinline__ void prefill(int tid) const { rstd_table_fill(ss, tid); }
    bf16_t* AB; bf16_t* HT; const float* ss; const float* wcv; const float* bcv;
    __device__ __forceinline__ void operator()(const f32x4 (&acc)[2][2][4][2], const Unit& u, int wr, int wc, int fr, int fq) const {
        const int row0 = u.pm * BM + wr * 64 + 4 * fr, chl = wc * 32 + 8 * fq, ch0 = u.pn * 128 + chl;
        float rs8[2][4]; rstd8_tab4(ss, u, wr, fr, fq, rs8);
        u32x2 keep[2][4];
        u32x2 hk[2][4];
#pragma unroll
        for (int n = 0; n < 2; ++n) {
            const int ch = ch0 + 4 * n;
            const f32x4 wg0 = *(const f32x4*)(wcv + ch), wg1 = *(const f32x4*)(wcv + NUP + ch), wg2 = *(const f32x4*)(wcv + 2 * NUP + ch), bg = *(const f32x4*)(bcv + ch);
            const f32x4 wv0 = *(const f32x4*)(wcv + DFF + ch), wv1 = *(const f32x4*)(wcv + NUP + DFF + ch), wv2 = *(const f32x4*)(wcv + 2 * NUP + DFF + ch), bv = *(const f32x4*)(bcv + DFF + ch);
#pragma unroll
            for (int ai = 0; ai < 2; ++ai) {
                const int kb = u.pm * 4 + ai * 2 + wr;
                f32x4 ug[4], uv[4];
#pragma unroll
                for (int m = 0; m < 4; ++m) { ug[m] = acc[ai][0][m][n] * rs8[ai][m]; uv[m] = acc[ai][1][m][n] * rs8[ai][m]; }
                {   const bool tail = (fr == 15);
                    const f32x4 g0 = tail ? ug[2] : ug[0], g1 = tail ? ug[3] : ug[1], v0 = tail ? uv[2] : uv[0], v1 = tail ? uv[3] : uv[1];
                    u32x2 q[4]; q[0].x = cvt_pk_bf16(g0[0], g0[1]); q[0].y = cvt_pk_bf16(g0[2], g0[3]); q[1].x = cvt_pk_bf16(g1[0], g1[1]); q[1].y = cvt_pk_bf16(g1[2], g1[3]);
                    q[2].x = cvt_pk_bf16(v0[0], v0[1]); q[2].y = cvt_pk_bf16(v0[2], v0[3]); q[3].x = cvt_pk_bf16(v1[0], v1[1]); q[3].y = cvt_pk_bf16(v1[2], v1[3]);
                    if (n == 0) {
#pragma unroll
                        for (int k = 0; k < 4; ++k) hk[ai][k] = q[k];
                    } else if (fr == 0 || tail) { bf16_t* hb2 = HT + ((size_t)kb * 4 + (tail ? 2 : 0)) * NUP + u.pn * 256 + chl;
                        *(u32x4*)hb2 = (u32x4){hk[ai][0].x, hk[ai][0].y, q[0].x, q[0].y}; *(u32x4*)(hb2 + NUP) = (u32x4){hk[ai][1].x, hk[ai][1].y, q[1].x, q[1].y};
                        *(u32x4*)(hb2 + 128) = (u32x4){hk[ai][2].x, hk[ai][2].y, q[2].x, q[2].y}; *(u32x4*)(hb2 + NUP + 128) = (u32x4){hk[ai][3].x, hk[ai][3].y, q[3].x, q[3].y}; } }
                f32x4 G[4], V[4];
                G[0] = bg + wg2 * ug[0];                               V[0] = bv + wv2 * uv[0];
                G[1] = bg + wg2 * ug[1] + wg1 * ug[0];                 V[1] = bv + wv2 * uv[1] + wv1 * uv[0];
                G[2] = bg + wg2 * ug[2] + wg1 * ug[1] + wg0 * ug[0];   V[2] = bv + wv2 * uv[2] + wv1 * uv[1] + wv0 * uv[0];
                G[3] = bg + wg2 * ug[3] + wg1 * ug[2] + wg0 * ug[1];   V[3] = bv + wv2 * uv[3] + wv1 * uv[2] + wv0 * uv[1];
                conv_wrap(G[0], G[1], ug[2], ug[3], wg1, wg0); conv_wrap(V[0], V[1], uv[2], uv[3], wv1, wv0);
#pragma unroll
                for (int m = 0; m < 4; ++m) { float o[4];
#pragma unroll
                    for (int e = 0; e < 4; ++e) o[e] = silu_fast(G[m][e]) * V[m][e];
                    u32x2 w; w.x = cvt_pk_bf16(o[0], o[1]); w.y = cvt_pk_bf16(o[2], o[3]);
                    if (n == 0) keep[ai][m] = w; else st16_wt(AB + (size_t)(row0 + ai * HALF + m) * DFF + ch0, (u32x4){keep[ai][m].x, keep[ai][m].y, w.x, w.y}); }
            }
        }
    }
};
struct EpiSoftmax {
    static constexpr bool PERM = true, AFTER_DRAIN = true, PREFILL = true, ROWPERM = false;
    __device__ __forceinline__ void prefill(int tid) const { rstd_table_fill(ss, tid); }
    bf16_t* P; const float* ss;
    __device__ __forceinline__ void fused(f32x4 (&acc)[2][2][4][2], const Unit& u, int wr, int wc, int fr, int fq, LAS unsigned char* lds, int wid, int lane) const {
        LAS float* MX = (LAS float*)lds; LAS float* SM = MX + 1024;
        const int rl0 = wr * 64 + fr, row0 = u.pm * BM + rl0;
        float rs8[2][4]; rstd8_tab(ss, u, wr, fr, fq, rs8);
#pragma unroll
        for (int ai = 0; ai < 2; ++ai)
#pragma unroll
            for (int m = 0; m < 4; ++m) { const float rs = rs8[ai][m]; float mx = -INFINITY;
#pragma unroll
                for (int bj = 0; bj < 2; ++bj)
#pragma unroll
                    for (int n = 0; n < 2; ++n) { f32x4 v = acc[ai][bj][m][n] * rs; acc[ai][bj][m][n] = v; mx = fmaxf(fmaxf(mx, fmaxf(v[0], v[1])), fmaxf(v[2], v[3])); }
                mx = fmaxf(mx, shx(mx, 16, lane)); mx = fmaxf(mx, shx(mx, 32, lane));
                if (fq == 0) MX[(rl0 + ai * HALF + m * 16) * 4 + wc] = mx; }
        asm volatile("s_waitcnt lgkmcnt(0)" ::: "memory"); __builtin_amdgcn_s_barrier(); asm volatile("" ::: "memory");
#pragma unroll
        for (int ai = 0; ai < 2; ++ai)
#pragma unroll
            for (int m = 0; m < 4; ++m) { const f32x4 q = *(const LAS f32x4*)(MX + (rl0 + ai * HALF + m * 16) * 4); const float mx = fmaxf(fmaxf(q[0], q[1]), fmaxf(q[2], q[3])), mxL = mx * 1.44269504088896341f; float sm = 0.f;
#pragma unroll
                for (int bj = 0; bj < 2; ++bj)
#pragma unroll
                    for (int n = 0; n < 2; ++n) { f32x4 v = acc[ai][bj][m][n];
#pragma unroll
                        for (int e = 0; e < 4; ++e) { v[e] = exp_sub(v[e], mxL); sm += v[e]; }
                        acc[ai][bj][m][n] = v; }
                sm += shx(sm, 16, lane); sm += shx(sm, 32, lane);
                if (fq == 0) SM[(rl0 + ai * HALF + m * 16) * 4 + wc] = sm; }
        asm volatile("s_waitcnt lgkmcnt(0)" ::: "memory"); __builtin_amdgcn_s_barrier(); asm volatile("" ::: "memory");
        const int cl = u.pn * BM + wc * 32 + 8 * fq;
#pragma unroll
        for (int ai = 0; ai < 2; ++ai)
#pragma unroll
            for (int m = 0; m < 4; ++m) { const f32x4 q = *(const LAS f32x4*)(SM + (rl0 + ai * HALF + m * 16) * 4); const float inv = 1.f / ((q[0] + q[1]) + (q[2] + q[3]));
                bf16_t* rowp = P + (size_t)(row0 + ai * HALF + m * 16) * NSC + cl;
#pragma unroll
                for (int bj = 0; bj < 2; ++bj) { const f32x4 v0 = acc[ai][bj][m][0] * inv, v1 = acc[ai][bj][m][1] * inv;
                    u32x4 w; w.x = cvt_pk_bf16(v0[0], v0[1]); w.y = cvt_pk_bf16(v0[2], v0[3]); w.z = cvt_pk_bf16(v1[0], v1[1]); w.w = cvt_pk_bf16(v1[2], v1[3]);
                    st16_wt(rowp + bj * HALF, w); } }
    }
};
}

#define XB_TMO      128
#define XB_XCNT(j)  (256  + 64 * (j))
#define XB_XSUB(j)  (1280 + 64 * (j))
#define XB_XGEN(j)  (2304 + 64 * (j))
#define XB_TOP      3328
#define XB_TOPGEN   3392
#define XCD_BAR_WORDS 3456
#define XB_SPIN_CAP (1u << 18)
__device__ __forceinline__ unsigned xb_ld(unsigned* p)              { return __hip_atomic_load(p, __ATOMIC_RELAXED, __HIP_MEMORY_SCOPE_AGENT); }
__device__ __forceinline__ unsigned xb_add(unsigned* p, unsigned v) { return __hip_atomic_fetch_add(p, v, __ATOMIC_RELAXED, __HIP_MEMORY_SCOPE_AGENT); }
__device__ __forceinline__ unsigned xb_xcc_id() { return (unsigned)__builtin_amdgcn_s_getreg((3 << 11) | 20) & 0xFu; }
#define XB_SPIN(cond, bar) do { unsigned _sp = 0; while (cond) { __builtin_amdgcn_s_sleep(1); \
    if ((++_sp & 255u) == 0u) { if (xb_ld(&(bar)[XB_TMO])) break; if (_sp > XB_SPIN_CAP) { atomicAdd(&(bar)[XB_TMO], 1u); break; } } } } while (0)
struct XcdBarrier { unsigned* bar; unsigned x; volatile LAS unsigned* st; };
__device__ __forceinline__ XcdBarrier xcd_barrier_post(unsigned* bar, volatile LAS unsigned* st) {
    XcdBarrier b; b.bar = bar; b.x = xb_xcc_id(); b.st = st;
    if (threadIdx.x == 0) (void)xb_add(&bar[XB_XCNT(b.x)], 1u);
    return b;
}
__device__ __forceinline__ void xcd_barrier_complete(unsigned* bar, unsigned x, unsigned& nloc, unsigned& nx) {
    const unsigned G = gridDim.x * gridDim.y * gridDim.z;
    unsigned sum, cnt, mine, sp = 0u;
    for (;;) {
        sum = 0u; cnt = 0u; mine = 0u;
#pragma unroll
        for (unsigned j = 0; j < 16; ++j) { const unsigned c = xb_ld(&bar[XB_XCNT(j)]); sum += c; cnt += (c > 0u) ? 1u : 0u; mine = (j == x) ? c : mine; }
        if (sum == G) break;
        __builtin_amdgcn_s_sleep(1);
        if ((++sp & 255u) == 0u) { if (xb_ld(&bar[XB_TMO])) break; if (sp > XB_SPIN_CAP) { atomicAdd(&bar[XB_TMO], 1u); break; } }
    }
    nloc = mine > 0u ? mine : 1u; nx = cnt > 0u ? cnt : 1u;
}
__device__ __forceinline__ void xcd_barrier(const XcdBarrier& b) {
    asm volatile("s_waitcnt vmcnt(0)" ::: "memory");
    __syncthreads();
    if (threadIdx.x == 0) {
        unsigned* bar = b.bar;
        __builtin_amdgcn_s_waitcnt(0);
        unsigned nloc = b.st[0], nx = b.st[1];
        if (nloc == 0u) { xcd_barrier_complete(bar, b.x, nloc, nx); b.st[0] = nloc; b.st[1] = nx; }
        const unsigned old = xb_add(&bar[XB_XSUB(b.x)], 1u);
        const unsigned gen = old / nloc;
        if (old + 1u == (gen + 1u) * nloc) {
            __builtin_amdgcn_fence(__ATOMIC_RELEASE, "agent");
            asm volatile("s_waitcnt vmcnt(0)" ::: "memory");
            const unsigned og = xb_add(&bar[XB_TOP], 1u);
            const unsigned tg = og / nx;
            if (og + 1u == (tg + 1u) * nx) xb_add(&bar[XB_TOPGEN], 1u);
            else XB_SPIN(xb_ld(&bar[XB_TOPGEN]) == tg, bar);
            __builtin_amdgcn_fence(__ATOMIC_ACQUIRE, "agent");
            xb_add(&bar[XB_XGEN(b.x)], 1u);
            asm volatile("s_waitcnt vmcnt(0)" ::: "memory");
        } else {
            XB_SPIN(xb_ld(&bar[XB_XGEN(b.x)]) == gen, bar);
            __builtin_amdgcn_fence(__ATOMIC_ACQUIRE, "agent");
            asm volatile("s_waitcnt vmcnt(0)" ::: "memory");
        }
    }
    __syncthreads();
}

struct Args { const void* in[23]; float* out; unsigned char* ws; int ph_lo, ph_hi; };
struct Frame {
    LAS unsigned char* lds; unsigned char* ws;
    int tid, lane, wave, G, bid;
};
__device__ __forceinline__ const void* in_ptr(int k) {
    const __attribute__((address_space(4))) char* kp = (const __attribute__((address_space(4))) char*)__builtin_amdgcn_kernarg_segment_ptr();
    asm volatile("" : "+s"(kp));
    return *(const void* const __attribute__((address_space(4)))*)(kp + 8 * k);
}
__device__ __forceinline__ unsigned char* ws_ptr() {
    const __attribute__((address_space(4))) char* kp = (const __attribute__((address_space(4))) char*)__builtin_amdgcn_kernarg_segment_ptr();
    asm volatile("" : "+s"(kp));
    return *(unsigned char* const __attribute__((address_space(4)))*)(kp + 8 * 24);
}
template <class Tp> __device__ __forceinline__ Tp* wsp(const Frame& F, size_t off) { return (Tp*)(F.ws + off); }
__device__ __forceinline__ float* ss_ptr(const Frame& F, int idx) { return (float*)(F.ws + WS_SSP) + (size_t)idx * T * 32; }

struct BlkDesc { const float* src; bf16_t* dst; const float* g; int ldw, K; };
constexpr int NA_IN = 32 * 68, NA_22 = 32 * 32, NA_UP = 32 * 176, NA_DN = 88 * 32, NA = NA_IN + NA_22 + NA_UP + NA_DN, NB = 3 * NA_22;
constexpr int NA_HEAD = NA_IN + NA_22, CV_T = NA_HEAD + 5100;
__device__ __forceinline__ BlkDesc desc_a(const Frame& F, int l, int r) {
    BlkDesc d;
    if (r < NA_IN) {
        const int kb = r / 68, nb = r % 68, sc0 = nb < 24 ? 64 * nb : 1552 + 64 * (nb - 24), dr0 = nb < 24 ? 64 * nb : 1792 + 64 * (nb - 24);
        d.src = (const float*)in_ptr(4) + (size_t)l * D * NIN + (size_t)(64 * kb) * NIN + sc0; d.dst = wsp<bf16_t>(F, WS_WIN + l * SZ_WIN) + (size_t)dr0 * D + 64 * kb; d.g = (const float*)in_ptr(3) + l * D + 64 * kb; d.ldw = NIN; d.K = D; return d; }
    r -= NA_IN;
    if (r < NA_22) { const int kb = r / 32, nb = r % 32;
        d.src = (const float*)in_ptr(10) + (size_t)l * D * D + (size_t)(64 * kb) * D + 64 * nb; d.dst = wsp<bf16_t>(F, WS_WOUT + l * SZ_W22) + (size_t)(64 * nb) * D + 64 * kb; d.g = nullptr; d.ldw = D; d.K = D; return d; }
    r -= NA_22;
    if (r < NA_UP) { const int kb = r / 176, nb = r % 176, c = 64 * nb, bj = c >= DFF ? 1 : 0, ch = c - DFF * bj, dr0 = 256 * (ch >> 7) + 128 * bj + (ch & 127);
        d.src = (const float*)in_ptr(18) + (size_t)l * D * NUP + (size_t)(64 * kb) * NUP + c; d.dst = wsp<bf16_t>(F, WS_WUP + l * SZ_WUP) + (size_t)dr0 * D + 64 * kb; d.g = (const float*)in_ptr(17) + l * D + 64 * kb; d.ldw = NUP; d.K = D; return d; }
    r -= NA_UP;
    { const int kb = r / 32, nb = r % 32;
        d.src = (const float*)in_ptr(21) + (size_t)l * DFF * D + (size_t)(64 * kb) * D + 64 * nb; d.dst = wsp<bf16_t>(F, WS_WDN + l * SZ_WDN) + (size_t)(64 * nb) * DFF + 64 * kb; d.g = nullptr; d.ldw = D; d.K = DFF; return d; }
}
__device__ __forceinline__ BlkDesc desc_b(const Frame& F, int l, int r) {
    BlkDesc d; const int w = r / NA_22, q = r % NA_22, kb = q / 32, nb = q % 32;
    d.src = (const float*)(w == 0 ? in_ptr(14) : w == 1 ? in_ptr(15) : in_ptr(16)) + (size_t)l * D * D + (size_t)(64 * kb) * D + 64 * nb;
    d.dst = wsp<bf16_t>(F, (w == 0 ? WS_WK : w == 1 ? WS_WV : WS_WO) + l * SZ_W22) + (size_t)(64 * nb) * D + 64 * kb; d.g = nullptr; d.ldw = D; d.K = D; return d;
}
__device__ __forceinline__ void blk_load(const BlkDesc& d, f32x4 (&v)[16], int lane) {
    const float* p = d.src + (size_t)(lane >> 4) * d.ldw + 4 * (lane & 15);
#pragma unroll
    for (int i = 0; i < 16; ++i) v[i] = __builtin_nontemporal_load((const f32x4*)(p + (size_t)(4 * i) * d.ldw));
}
__device__ __forceinline__ void blk_to_lds(const BlkDesc& d, const f32x4 (&v)[16], LAS float* scr, int lane) {
    const int kr = lane >> 4, cg = lane & 15;
#pragma unroll
    for (int i = 0; i < 16; ++i) { const int k = 4 * i + kr; f32x4 x = v[i]; if (d.g) x = x * d.g[k]; *(LAS f32x4*)(scr + k * 64 + ((cg ^ (k >> 3)) << 2)) = x; }
    LDS_WAIT(); asm volatile("" ::: "memory");
}
template <bool NTS> __device__ __forceinline__ void blk_store(const BlkDesc& d, LAS float* scr, int lane) {
    const int n0 = lane >> 3, c = lane & 7;
#pragma unroll
    for (int j = 0; j < 8; ++j) { const int n = n0 + 8 * j; const LAS float* sp = scr + (8 * c) * 64 + ((((n >> 2) ^ c) << 2) | (n & 3));
        u32x4 o; o.x = pk2(sp[0 * 64], sp[1 * 64]); o.y = pk2(sp[2 * 64], sp[3 * 64]); o.z = pk2(sp[4 * 64], sp[5 * 64]); o.w = pk2(sp[6 * 64], sp[7 * 64]);
        if constexpr (NTS) __builtin_nontemporal_store(o, (u32x4*)(d.dst + (size_t)n * d.K + 8 * c)); else *(u32x4*)(d.dst + (size_t)n * d.K + 8 * c) = o; }
    LDS_WAIT(); asm volatile("" ::: "memory");
}
template <bool TYPE_B, bool NTS = false> __device__ __forceinline__ void convert_blocks(const Frame& F, int l, int lo, int hi, int wv, int nw) {
    LAS float* scr = (LAS float*)(F.lds + F.wave * 16384); const int lane = F.lane;
    int it = lo + wv; if (it >= hi) return;
    f32x4 v[16]; BlkDesc d = TYPE_B ? desc_b(F, l, it) : desc_a(F, l, it); blk_load(d, v, lane);
    for (;;) {
        blk_to_lds(d, v, scr, lane);
        const int itn = it + nw; const bool hn = itn < hi; BlkDesc dn = d;
        if (hn) { dn = TYPE_B ? desc_b(F, l, itn) : desc_a(F, l, itn); blk_load(dn, v, lane); }
        blk_store<NTS>(d, scr, lane);
        if (!hn) break;
        it = itn; d = dn;
    }
}
__device__ __forceinline__ void fold_gate_item(const Frame& F, int l, int item) {
    LAS float* scr = (LAS float*)(F.lds + F.wave * 16384);
    const int kb = item >> 2, cq = item & 3, lane = F.lane, k = 64 * kb + lane; const float* wrow = (const float*)in_ptr(4) + ((size_t)l * D + k) * NIN + 1536;
    {   const float* wg = (const float*)in_ptr(5) + (size_t)l * 16 * 256 + (lane >> 2) * 256 + 64 * cq + 16 * (lane & 3); LAS float* dp = scr + (lane >> 2) * 64 + 16 * (lane & 3);
#pragma unroll
        for (int q = 0; q < 4; ++q) *(LAS f32x4*)(dp + 4 * q) = *(const f32x4*)(wg + 4 * q); }
    const f32x4 l0 = *(const f32x4*)wrow, l1 = *(const f32x4*)(wrow + 4), l2 = *(const f32x4*)(wrow + 8), l3 = *(const f32x4*)(wrow + 12);
    const float lr[16] = {l0[0], l0[1], l0[2], l0[3], l1[0], l1[1], l1[2], l1[3], l2[0], l2[1], l2[2], l2[3], l3[0], l3[1], l3[2], l3[3]};
    const float gk = ((const float*)in_ptr(3))[l * D + k]; bf16_t* WT = wsp<bf16_t>(F, WS_WIN + l * SZ_WIN) + (size_t)(1536 + 64 * cq) * D + k;
    LDS_WAIT(); asm volatile("" ::: "memory");
#pragma unroll 1
    for (int cc = 0; cc < 4; ++cc) { float a[16];
#pragma unroll
        for (int j = 0; j < 16; ++j) a[j] = 0.f;
#pragma unroll
        for (int r = 0; r < 16; ++r) { const LAS f32x4* wp = (const LAS f32x4*)(scr + r * 64 + 16 * cc); const f32x4 w0 = wp[0], w1 = wp[1], w2 = wp[2], w3 = wp[3];
            a[0] += lr[r] * w0[0]; a[1] += lr[r] * w0[1]; a[2] += lr[r] * w0[2]; a[3] += lr[r] * w0[3]; a[4] += lr[r] * w1[0]; a[5] += lr[r] * w1[1]; a[6] += lr[r] * w1[2]; a[7] += lr[r] * w1[3];
            a[8] += lr[r] * w2[0]; a[9] += lr[r] * w2[1]; a[10] += lr[r] * w2[2]; a[11] += lr[r] * w2[3]; a[12] += lr[r] * w3[0]; a[13] += lr[r] * w3[1]; a[14] += lr[r] * w3[2]; a[15] += lr[r] * w3[3];
            asm volatile("" ::: "memory"); }
#pragma unroll
        for (int j = 0; j < 16; ++j) WT[(size_t)(16 * cc + j) * D] = (bf16_t)f2bf(a[j] * gk); }
    LDS_WAIT(); asm volatile("" ::: "memory");
}
__device__ __forceinline__ void convert_slot(const Frame& F, int l, int lo, int hi, bool fold, int rank, int nr) {
    if (rank < 0 || rank >= nr) return;
    convert_blocks<false>(F, l, lo, hi, rank * 8 + F.wave, nr * 8);
    if (fold) for (int it = rank * 8 + F.wave; it < 128; it += nr * 8) fold_gate_item(F, l, it);
}
__device__ __forceinline__ void sincos_acc(float ang, float& c, float& s) {
    const double a = (double)ang; const double k = rint(a * 0.63661977236758134308);
    double r = fma(-k, 1.57079632679489655800, a); r = fma(-k, 6.12323399573676603587e-17, r);
    const float x = (float)r, x2 = x * x;
    const float sp = x + x * x2 * (-1.6666654611e-1f + x2 * (8.3321608736e-3f + x2 * (-1.9515295891e-4f)));
    const float cp = 1.f - 0.5f * x2 + x2 * x2 * (4.166664568298827e-2f + x2 * (-1.388731625493765e-3f + x2 * 2.443315711809948e-5f));
    const int q = ((int)k) & 3;
    c = (q == 0) ? cp : (q == 1) ? -sp : (q == 2) ? -cp : sp;
    s = (q == 0) ? sp : (q == 1) ? cp : (q == 2) ? -sp : -cp;
}
__device__ __forceinline__ void p_prologue(Frame& F, const Args& A) {
    const int gw = F.bid * 8 + F.wave, NGW = F.G * 8, lane = F.lane;
    const float* x = (const float*)in_ptr(0); const float* mem = (const float*)in_ptr(1); const int* pos = (const int*)in_ptr(2);
    convert_blocks<false, false>(F, 0, 0, NA_HEAD, gw, NGW);
    for (int l = 0; l < NL; ++l) convert_blocks<true, true>(F, l, 0, NB, gw, NGW);
    for (int it = gw; it < NL * D; it += NGW) { const int l = it / D, k = it % D; const float g = ((const float*)in_ptr(11))[l * D + k];
        const f32x4* src = (const f32x4*)((const float*)in_ptr(13) + ((size_t)l * D + k) * D) + lane; u32x2* dst = (u32x2*)(wsp<bf16_t>(F, WS_WQP + l * SZ_W22) + (size_t)k * D) + lane;
#pragma unroll
        for (int j = 0; j < 8; ++j) { const f32x4 v = __builtin_nontemporal_load(src + 64 * j) * g; u32x2 o; o.x = pk2(v[0], v[1]); o.y = pk2(v[2], v[3]); __builtin_nontemporal_store(o, dst + 64 * j); } }
    for (int it = gw; it < 128; it += NGW) fold_gate_item(F, 0, it);
    { float* ss0 = ss_ptr(F, 0); bf16_t* hb = wsp<bf16_t>(F, WS_HB);
      for (int m = gw; m < T; m += NGW) { const f32x4* xr = (const f32x4*)(x + (size_t)m * D) + lane; u32x2* o = (u32x2*)(hb + (size_t)m * D) + lane; float s = 0.f;
#pragma unroll
          for (int j = 0; j < 8; ++j) { const f32x4 v = __builtin_nontemporal_load(xr + 64 * j); s += (v[0] * v[0] + v[1] * v[1]) + (v[2] * v[2] + v[3] * v[3]); u32x2 w; w.x = pk2(v[0], v[1]); w.y = pk2(v[2], v[3]); o[64 * j] = w; }
          s = wave_sum(s, lane); if (lane < 32) ss0[(size_t)m * 32 + lane] = (lane == 0) ? s : 0.f; } }
    for (int it = gw; it < NL * NMEM; it += NGW) { const int l = it / NMEM, m = it % NMEM; const f32x4* xr = (const f32x4*)(mem + (size_t)m * D) + lane; const f32x4* gr = (const f32x4*)((const float*)in_ptr(12) + l * D) + lane;
        f32x4 v[8]; float s = 0.f;
#pragma unroll
        for (int j = 0; j < 8; ++j) { v[j] = xr[64 * j]; s += (v[j][0] * v[j][0] + v[j][1] * v[j][1]) + (v[j][2] * v[j][2] + v[j][3] * v[j][3]); }
        const float rs = rsqrtf(wave_sum(s, lane) * (1.f / D) + EPS); u32x2* o = (u32x2*)(wsp<bf16_t>(F, WS_MEMN + l * SZ_MEM) + (size_t)m * D) + lane;
#pragma unroll
        for (int j = 0; j < 8; ++j) { const f32x4 g = gr[64 * j]; u32x2 w; w.x = pk2(v[j][0] * rs * g[0], v[j][1] * rs * g[1]); w.y = pk2(v[j][2] * rs * g[2], v[j][3] * rs * g[3]); o[64 * j] = w; } }
    { float* ct = wsp<float>(F, WS_ROPE); float* st = ct + T * 32;
      for (int i = F.bid * 512 + F.tid; i < T * 32; i += F.G * 512) { const int t = i >> 5, j = i & 31; const float inv = 1.0f / powf(10000.0f, (float)(2 * j) / 64.0f); const float ang = (float)pos[t] * inv;
          float c, s; sincos_acc(ang, c, s); ct[i] = c; st[i] = s; } }
}

struct KVOrder {
    unsigned char* ws; int G, c;
    __device__ __forceinline__ bool next(int i, pg8::Unit& u) const {
        const int L = i * G + c; if (L >= 64) return false;
        const int b = L >> 3, pn = L & 7, l = b >> 1, kv = b & 1;
        u.pm = 0; u.pn = pn; u.a = (const char*)(ws + WS_MEMN + l * SZ_MEM); u.b = (const char*)(ws + (kv ? WS_WV : WS_WK) + l * SZ_W22 + (size_t)pn * 256 * D * 2);
        u.o = (char*)(ws + (kv ? WS_VMEM : WS_KMEM) + l * SZ_MEM); u.ldc = D; u.sc = 1.f; return true; }
    __device__ __forceinline__ void a_ready(const pg8::Unit&) const {}
    __device__ __forceinline__ void done(const pg8::Unit&) const {}
};
struct FoldOrder {
    unsigned char* ws; int G, c;
    __device__ __forceinline__ bool next(int i, pg8::Unit& u) const {
        int L = i * G + c; if (L >= 256) return false;
        if (L < 128) { const int b = L >> 3, pn = L & 7, l = b >> 2, hd = b & 3;
            u.pm = 0; u.pn = pn; u.a = (const char*)(ws + WS_KMEM + l * SZ_MEM + 512 * hd * 2); u.b = (const char*)(ws + WS_WQP + l * SZ_W22 + 512 * hd * 2 + (size_t)pn * 256 * D * 2);
            u.o = (char*)(ws + WS_WST + l * SZ_WS + (size_t)256 * hd * D * 2); u.ldc = D; u.sc = 0.044194173824159216f; }
        else { L -= 128; const int b = L >> 3, pm = L & 7, l = b >> 2, hd = b & 3;
            u.pm = pm; u.pn = 0; u.a = (const char*)(ws + WS_WO + l * SZ_W22 + 512 * hd * 2 + (size_t)pm * 256 * D * 2); u.b = (const char*)(ws + WS_VMEM + l * SZ_MEM + 512 * hd * 2);
            u.o = (char*)(ws + WS_VWT + l * SZ_WS + 256 * hd * 2); u.ldc = NSC; u.sc = 1.f; }
        return true; }
    __device__ __forceinline__ void a_ready(const pg8::Unit&) const {}
    __device__ __forceinline__ void done(const pg8::Unit&) const {}
};

__device__ __forceinline__ void gla_cumsum(const Frame& F, const float* la, int t0, int h, LAS float* tot, float (&c)[8]) {
    const int w = F.wave, d = F.lane; float run = 0.f;
#pragma unroll
    for (int i = 0; i < 8; ++i) { run += la[(size_t)(t0 + 8 * w + i) * 256 + h * 64 + d]; c[i] = run; }
    tot[w * 64 + d] = run;
    __syncthreads();
    float off = 0.f;
#pragma unroll
    for (int j = 0; j < 8; ++j) off += (j < w) ? tot[j * 64 + d] : 0.f;
#pragma unroll
    for (int i = 0; i < 8; ++i) c[i] += off;
}
__device__ __forceinline__ void gla_local(Frame& F, int unit) {
    const int h = unit >> 7, ck = unit & 127, t0 = ck * 64, w = F.wave, lane = F.lane, tid = F.tid;
    const bf16_t* z = wsp<bf16_t>(F, WS_Z); const float* la = wsp<float>(F, WS_LA);
    LAS float* tot = (LAS float*)F.lds; LAS float* khat = tot + 512; LAS float* vt = khat + 64 * 64;
    float c[8]; gla_cumsum(F, la, t0, h, tot, c);
    float total = 0.f;
#pragma unroll
    for (int j = 0; j < 8; ++j) total += tot[j * 64 + lane];
#pragma unroll
    for (int i = 0; i < 8; ++i) { const int t = 8 * w + i; const float k = bf2f(z[(size_t)(t0 + t) * NZ + ZK + h * 64 + lane]); khat[t * 64 + lane] = k * __expf(total - c[i]); }
#pragma unroll
    for (int j = 0; j < 2; ++j) { const int idx = tid + 512 * j, t = idx >> 4, ch = idx & 15; const u32x4 r = *(const u32x4*)(z + (size_t)(t0 + t) * NZ + ZV + h * 128 + ch * 8);
        LAS float* p = vt + t * 128 + ch * 8;
        p[0] = bf2f(r.x & 0xffffu); p[1] = bf2f(r.x >> 16); p[2] = bf2f(r.y & 0xffffu); p[3] = bf2f(r.y >> 16); p[4] = bf2f(r.z & 0xffffu); p[5] = bf2f(r.z >> 16); p[6] = bf2f(r.w & 0xffffu); p[7] = bf2f(r.w >> 16); }
    if (w == 0) wsp<float>(F, WS_DEC)[(size_t)unit * 64 + lane] = __expf(total);
    __syncthreads();
    const int e = tid & 127, dg = tid >> 7;
    float acc[16];
#pragma unroll
    for (int j = 0; j < 16; ++j) acc[j] = 0.f;
    for (int t = 0; t < 64; ++t) { const float v = vt[t * 128 + e];
#pragma unroll
        for (int j = 0; j < 16; ++j) acc[j] += v * khat[t * 64 + 16 * dg + j]; }
    float* U = wsp<float>(F, WS_UB) + (size_t)unit * 8192;
#pragma unroll
    for (int j = 0; j < 16; ++j) U[(16 * dg + j) * 128 + e] = acc[j];
    __syncthreads();
}
__device__ __forceinline__ void gla_scan4(Frame& F) {
    LAS f32x2* AB = (LAS f32x2*)F.lds;
    const int per = (4 * 8192 + F.G - 1) / F.G, seg = F.wave >> 1, el = ((F.wave & 1) << 6) | F.lane;
    for (int e0 = 0; e0 < per; e0 += 128) {
        const int e = e0 + el, gid = F.bid * per + e; const bool act = (e < per) && (gid < 4 * 8192);
        const int gidc = act ? gid : 0, h = gidc >> 13, rem = gidc & 8191, d = rem >> 7;
        const float* __restrict__ U = wsp<float>(F, WS_UB) + (size_t)h * 128 * 8192 + rem + (size_t)(32 * seg) * 8192; const float* __restrict__ dec = wsp<float>(F, WS_DEC) + (size_t)h * 128 * 64 + d + (32 * seg) * 64;
        bf16_t* __restrict__ Sb = wsp<bf16_t>(F, WS_SB) + (size_t)h * 128 * 8192 + rem + (size_t)(32 * seg) * 8192;
        float u[32], dd[32];
#pragma unroll
        for (int i = 0; i < 32; ++i) { u[i] = U[(size_t)i * 8192]; dd[i] = dec[i * 64]; }
        float S = 0.f, P = 1.f;
#pragma unroll
        for (int i = 0; i < 32; ++i) { const float un = u[i], dn = dd[i]; u[i] = S; dd[i] = P; S = S * dn + un; P = P * dn; }
        AB[seg * 128 + el] = (f32x2){P, S};
        __syncthreads();
        float Sin = 0.f;
#pragma unroll
        for (int j = 0; j < 3; ++j) { if (j < seg) { const f32x2 ab = AB[j * 128 + el]; Sin = Sin * ab.x + ab.y; } }
        if ((e0 + el < per) && (F.bid * per + e0 + el < 4 * 8192)) {
#pragma unroll
            for (int i = 0; i < 32; ++i) Sb[(size_t)i * 8192] = (bf16_t)f2bf(u[i] + dd[i] * Sin); }
        __syncthreads();
    }
}
__device__ __forceinline__ void gla_scan(Frame& F) {
    const int per = (4 * 8192 + F.G - 1) / F.G;
    for (int e = F.tid; e < per; e += 128) { const int gid = F.bid * per + e; if (gid >= 4 * 8192) break;
        const int h = gid >> 13, rem = gid & 8191, d = rem >> 7;
        const float* __restrict__ U = wsp<float>(F, WS_UB) + (size_t)h * 128 * 8192 + rem; const float* __restrict__ dec = wsp<float>(F, WS_DEC) + (size_t)h * 128 * 64 + d; bf16_t* __restrict__ Sb = wsp<bf16_t>(F, WS_SB) + (size_t)h * 128 * 8192 + rem;
        float S = 0.f;
#pragma unroll 1
        for (int b = 0; b < 4; ++b) { float u[32], dd[32];
#pragma unroll
            for (int i = 0; i < 32; ++i) { u[i] = U[(size_t)(32 * b + i) * 8192]; dd[i] = dec[(32 * b + i) * 64]; }
#pragma unroll
            for (int i = 0; i < 32; ++i) { Sb[(size_t)(32 * b + i) * 8192] = (bf16_t)f2bf(S); S = S * dd[i] + u[i]; } }
    }
}
__device__ __forceinline__ void gla_out(Frame& F, const Args& A, int unit, int layer) {
    const int h = unit >> 7, ck = unit & 127, t0 = ck * 64, w = F.wave, lane = F.lane, tid = F.tid;
    const bf16_t* z = wsp<bf16_t>(F, WS_Z); const float* la = wsp<float>(F, WS_LA);
    LAS float* tot = (LAS float*)F.lds; LAS float* qtT = tot + 512; LAS float* qeT = qtT + 64 * 65; LAS float* attT = qeT + 64 * 65; LAS float* ktl = attT + 64 * 65;
    LAS float* red = ktl + 64 * 64; LAS bf16_t* vs = (LAS bf16_t*)(red + 512); LAS bf16_t* Ss = vs + 64 * 128;
    float c[8]; gla_cumsum(F, la, t0, h, tot, c);
    const float ref = tot[lane] + tot[64 + lane] + tot[128 + lane] + tot[192 + lane];
#pragma unroll
    for (int i = 0; i < 8; ++i) { const int t = 8 * w + i; const size_t zo = (size_t)(t0 + t) * NZ + h * 64 + lane;
        const float q = bf2f(z[zo + ZQ]) * 0.125f, k = bf2f(z[zo + ZK]);
        qtT[lane * 65 + t] = q * __expf(c[i] - ref); qeT[lane * 65 + t] = q * __expf(c[i]); ktl[t * 64 + lane] = k * __expf(ref - c[i]); }
#pragma unroll
    for (int j = 0; j < 2; ++j) { const int idx = tid + 512 * j, t = idx >> 4, ch = idx & 15;
        *(LAS u32x4*)(vs + t * 128 + ch * 8) = *(const u32x4*)(z + (size_t)(t0 + t) * NZ + ZV + h * 128 + ch * 8);
        *(LAS u32x4*)(Ss + t * 128 + ch * 8) = *(const u32x4*)(wsp<bf16_t>(F, WS_SB) + (size_t)unit * 8192 + t * 128 + ch * 8); }
    __syncthreads();
    {
        float a[8];
#pragma unroll
        for (int j = 0; j < 8; ++j) a[j] = 0.f;
        for (int d = 0; d < 64; ++d) { const float q = qtT[d * 65 + lane];
#pragma unroll
            for (int j = 0; j < 8; ++j) a[j] += q * ktl[(8 * w + j) * 64 + d]; }
#pragma unroll
        for (int j = 0; j < 8; ++j) attT[(8 * w + j) * 65 + lane] = (8 * w + j <= lane) ? a[j] : 0.f;
    }
    __syncthreads();
    float o[16];
#pragma unroll
    for (int j = 0; j < 16; ++j) o[j] = 0.f;
    for (int s = 0; s < 64; ++s) { const float a = attT[s * 65 + lane]; const u32x4 v0 = *(const LAS u32x4*)(vs + s * 128 + 16 * w), v1 = *(const LAS u32x4*)(vs + s * 128 + 16 * w + 8);
        o[0] += a * bf2f(v0.x & 0xffffu); o[1] += a * bf2f(v0.x >> 16); o[2] += a * bf2f(v0.y & 0xffffu); o[3] += a * bf2f(v0.y >> 16);
        o[4] += a * bf2f(v0.z & 0xffffu); o[5] += a * bf2f(v0.z >> 16); o[6] += a * bf2f(v0.w & 0xffffu); o[7] += a * bf2f(v0.w >> 16);
        o[8] += a * bf2f(v1.x & 0xffffu); o[9] += a * bf2f(v1.x >> 16); o[10] += a * bf2f(v1.y & 0xffffu); o[11] += a * bf2f(v1.y >> 16);
        o[12] += a * bf2f(v1.z & 0xffffu); o[13] += a * bf2f(v1.z >> 16); o[14] += a * bf2f(v1.w & 0xffffu); o[15] += a * bf2f(v1.w >> 16); }
    for (int d = 0; d < 64; ++d) { const float a = qeT[d * 65 + lane]; const u32x4 v0 = *(const LAS u32x4*)(Ss + d * 128 + 16 * w), v1 = *(const LAS u32x4*)(Ss + d * 128 + 16 * w + 8);
        o[0] += a * bf2f(v0.x & 0xffffu); o[1] += a * bf2f(v0.x >> 16); o[2] += a * bf2f(v0.y & 0xffffu); o[3] += a * bf2f(v0.y >> 16);
        o[4] += a * bf2f(v0.z & 0xffffu); o[5] += a * bf2f(v0.z >> 16); o[6] += a * bf2f(v0.w & 0xffffu); o[7] += a * bf2f(v0.w >> 16);
        o[8] += a * bf2f(v1.x & 0xffffu); o[9] += a * bf2f(v1.x >> 16); o[10] += a * bf2f(v1.y & 0xffffu); o[11] += a * bf2f(v1.y >> 16);
        o[12] += a * bf2f(v1.z & 0xffffu); o[13] += a * bf2f(v1.z >> 16); o[14] += a * bf2f(v1.w & 0xffffu); o[15] += a * bf2f(v1.w >> 16); }
    float p = 0.f;
#pragma unroll
    for (int j = 0; j < 16; ++j) p += o[j] * o[j];
    red[w * 64 + lane] = p;
    __syncthreads();
    float sq = 0.f;
#pragma unroll
    for (int j = 0; j < 8; ++j) sq += red[j * 64 + lane];
    const float rs = rsqrtf(sq * (1.f / 128.f) + EPS);
    const float* gn = (const float*)in_ptr(7) + layer * 128 + 16 * w; const size_t zr = (size_t)(t0 + lane) * NZ + ZR + h * 128 + 16 * w;
    const u32x4 r0 = *(const u32x4*)(z + zr), r1 = *(const u32x4*)(z + zr + 8);
    const unsigned rr[8] = {r0.x, r0.y, r0.z, r0.w, r1.x, r1.y, r1.z, r1.w};
    unsigned ow[8];
#pragma unroll
    for (int j = 0; j < 8; ++j) { const float g0 = bf2f(rr[j] & 0xffffu), g1 = bf2f(rr[j] >> 16);
        ow[j] = pk2(o[2 * j] * rs * gn[2 * j] * siluf(g0), o[2 * j + 1] * rs * gn[2 * j + 1] * siluf(g1)); }
    bf16_t* mx = wsp<bf16_t>(F, WS_MIX) + (size_t)(t0 + lane) * D + h * 128 + 16 * w;
    *(u32x4*)mx = (u32x4){ow[0], ow[1], ow[2], ow[3]}; *(u32x4*)(mx + 8) = (u32x4){ow[4], ow[5], ow[6], ow[7]};
    __syncthreads();
}

__device__ __forceinline__ void swa_unit(Frame& F, const Args& A, int unit, int layer) {
    const int g = unit & 7, n = (unit >> 3) & 63, j = unit >> 9, hq = 8 * j + g, tid = F.tid;
    const bf16_t* z = wsp<bf16_t>(F, WS_Z); const float* ct = wsp<float>(F, WS_ROPE); const float* st = ct + T * 32;
    LAS bf16_t* Ks = (LAS bf16_t*)F.lds; LAS bf16_t* Vs = Ks + 256 * 66; LAS float* red = (LAS float*)(Vs + 256 * 66);
    LAS float* ob = (LAS float*)F.lds;
    {
        const int row = tid >> 1, hf = tid & 1, tk = 128 * n - 128 + row;
        if (tk >= 0) {
            const bf16_t* kp = z + (size_t)tk * NZ + ZSK + j * 64; const bf16_t* vp = z + (size_t)tk * NZ + ZSV + j * 64;
            const u32x4 a0 = *(const u32x4*)(kp + 16 * hf), a1 = *(const u32x4*)(kp + 16 * hf + 8), b0 = *(const u32x4*)(kp + 32 + 16 * hf), b1 = *(const u32x4*)(kp + 32 + 16 * hf + 8);
            const unsigned x1[8] = {a0.x, a0.y, a0.z, a0.w, a1.x, a1.y, a1.z, a1.w}, x2[8] = {b0.x, b0.y, b0.z, b0.w, b1.x, b1.y, b1.z, b1.w};
#pragma unroll
            for (int q = 0; q < 8; ++q) { const int i0 = 16 * hf + 2 * q; const float c0 = ct[tk * 32 + i0], s0 = st[tk * 32 + i0], c1 = ct[tk * 32 + i0 + 1], s1 = st[tk * 32 + i0 + 1];
                const float u0 = bf2f(x1[q] & 0xffffu), u1 = bf2f(x1[q] >> 16), w0 = bf2f(x2[q] & 0xffffu), w1 = bf2f(x2[q] >> 16);
                *(LAS unsigned*)(Ks + row * 66 + i0) = pk2(u0 * c0 - w0 * s0, u1 * c1 - w1 * s1);
                *(LAS unsigned*)(Ks + row * 66 + 32 + i0) = pk2(w0 * c0 + u0 * s0, w1 * c1 + u1 * s1); }
            const u32x4 v0 = *(const u32x4*)(vp + 32 * hf), v1 = *(const u32x4*)(vp + 32 * hf + 8), v2 = *(const u32x4*)(vp + 32 * hf + 16), v3 = *(const u32x4*)(vp + 32 * hf + 24);
            const unsigned vv[16] = {v0.x, v0.y, v0.z, v0.w, v1.x, v1.y, v1.z, v1.w, v2.x, v2.y, v2.z, v2.w, v3.x, v3.y, v3.z, v3.w};
#pragma unroll
            for (int q = 0; q < 16; ++q) *(LAS unsigned*)(Vs + row * 66 + 32 * hf + 2 * q) = vv[q];
        } else {
#pragma unroll
            for (int q = 0; q < 16; ++q) { *(LAS unsigned*)(Ks + row * 66 + 32 * hf + 2 * q) = 0u; *(LAS unsigned*)(Vs + row * 66 + 32 * hf + 2 * q) = 0u; }
        }
    }
    const int r = tid & 127, part = tid >> 7, tq = 128 * n + r;
    float q[64];
    {   const bf16_t* qp = z + (size_t)tq * NZ + ZSQ + hq * 64;
#pragma unroll
        for (int c8 = 0; c8 < 4; ++c8) { const u32x4 a = *(const u32x4*)(qp + 8 * c8), b = *(const u32x4*)(qp + 32 + 8 * c8); const unsigned x1[4] = {a.x, a.y, a.z, a.w}, x2[4] = {b.x, b.y, b.z, b.w};
#pragma unroll
            for (int p = 0; p < 4; ++p) { const int i0 = 8 * c8 + 2 * p; const float c0 = ct[tq * 32 + i0], s0 = st[tq * 32 + i0], c1 = ct[tq * 32 + i0 + 1], s1 = st[tq * 32 + i0 + 1];
                const float u0 = bf2f(x1[p] & 0xffffu), u1 = bf2f(x1[p] >> 16), w0 = bf2f(x2[p] & 0xffffu), w1 = bf2f(x2[p] >> 16);
                q[i0] = (u0 * c0 - w0 * s0) * 0.125f; q[i0 + 1] = (u1 * c1 - w1 * s1) * 0.125f; q[32 + i0] = (w0 * c0 + u0 * s0) * 0.125f; q[32 + i0 + 1] = (w1 * c1 + u1 * s1) * 0.125f; } }
    }
    __syncthreads();
    float s[32]; float mx = -INFINITY;
#pragma unroll
    for (int kk = 0; kk < 32; ++kk) { const int ki = r + 1 + 32 * part + kk; const LAS unsigned* kr = (const LAS unsigned*)(Ks + ki * 66); float a = 0.f;
#pragma unroll
        for (int d2 = 0; d2 < 32; ++d2) { const unsigned kw = kr[d2]; a += q[2 * d2] * bf2f(kw & 0xffffu) + q[2 * d2 + 1] * bf2f(kw >> 16); }
        const bool valid = (n > 0) || (ki >= 128); s[kk] = valid ? a : -INFINITY; mx = fmaxf(mx, s[kk]); }
    red[part * 128 + r] = mx;
    __syncthreads();
    const float sink = ((const float*)in_ptr(8))[layer * 16 + hq];
    const float m = fmaxf(fmaxf(fmaxf(red[r], red[128 + r]), fmaxf(red[256 + r], red[384 + r])), sink);
    float sum = 0.f;
#pragma unroll
    for (int kk = 0; kk < 32; ++kk) { s[kk] = __expf(s[kk] - m); sum += s[kk]; }
    red[512 + part * 128 + r] = sum;
    __syncthreads();
    const float den = red[512 + r] + red[640 + r] + red[768 + r] + red[896 + r] + __expf(sink - m), inv = 1.f / den;
    float o[64];
#pragma unroll
    for (int e = 0; e < 64; ++e) o[e] = 0.f;
#pragma unroll 4
    for (int kk = 0; kk < 32; ++kk) { const int ki = r + 1 + 32 * part + kk; const LAS unsigned* vr = (const LAS unsigned*)(Vs + ki * 66); const float p = s[kk] * inv;
#pragma unroll
        for (int d2 = 0; d2 < 32; ++d2) { const unsigned vw = vr[d2]; o[2 * d2] += p * bf2f(vw & 0xffffu); o[2 * d2 + 1] += p * bf2f(vw >> 16); } }
    for (int pp = 0; pp < 4; ++pp) {
        if (part == pp) {
#pragma unroll
            for (int e = 0; e < 64; ++e) { if (pp == 0) ob[r * 65 + e] = o[e]; else ob[r * 65 + e] += o[e]; }
        }
        __syncthreads();
    }
    {   const int row = tid >> 2, e0 = 16 * (tid & 3); unsigned ow[8];
#pragma unroll
        for (int p = 0; p < 8; ++p) ow[p] = pk2(ob[row * 65 + e0 + 2 * p], ob[row * 65 + e0 + 2 * p + 1]);
        bf16_t* mxp = wsp<bf16_t>(F, WS_MIX) + (size_t)(128 * n + row) * D + 512 + hq * 64 + e0;
        *(u32x4*)mxp = (u32x4){ow[0], ow[1], ow[2], ow[3]}; *(u32x4*)(mxp + 8) = (u32x4){ow[4], ow[5], ow[6], ow[7]}; }
    __syncthreads();
}


typedef float f32x16 __attribute__((ext_vector_type(16)));
typedef short s16x4 __attribute__((ext_vector_type(4)));
typedef short v4i16_t __attribute__((ext_vector_type(4)));
#define MFMA32(a, b, c) __builtin_amdgcn_mfma_f32_32x32x16_bf16((a), (b), (c), 0, 0, 0)
__device__ __forceinline__ s16x4 tr_read(const LAS bf16_t* p) { return __builtin_bit_cast(s16x4, __builtin_amdgcn_ds_read_tr16_b64_v4i16((LAS v4i16_t*)p)); }
__device__ __forceinline__ void swa_unit_mfma(Frame& F, int unit, int layer) {
    constexpr int KST = 72, VST = 96;
    const int hf = unit & 1, n = (unit >> 1) & 63, j = unit >> 7, tid = F.tid, lane = F.lane, w = F.wave, r = lane & 31, hh = lane >> 5;
    const bf16_t* z = wsp<bf16_t>(F, WS_Z); const float* ct = wsp<float>(F, WS_ROPE); const float* st = ct + T * 32;
    LAS bf16_t* Ks = (LAS bf16_t*)F.lds; LAS bf16_t* Vs = Ks + 256 * KST;
    const int hq = 8 * j + 4 * hf + (w & 3);
    bf16x8 qf[2][4]; u32x4 qxa[2][2], qxb[2][2]; f32x4 qc[2][2][2], qs[2][2][2];
#pragma unroll
        for (int pi = 0; pi < 2; ++pi) { const int tq = 128 * n + 32 * (2 * (w >> 2) + pi) + r; const bf16_t* qp = z + (size_t)tq * NZ + ZSQ + hq * 64;
#pragma unroll
            for (int s2 = 0; s2 < 2; ++s2) { qxa[pi][s2] = *(const u32x4*)(qp + 16 * s2 + 8 * hh); qxb[pi][s2] = *(const u32x4*)(qp + 32 + 16 * s2 + 8 * hh);
                qc[pi][s2][0] = *(const f32x4*)(ct + tq * 32 + 16 * s2 + 8 * hh); qc[pi][s2][1] = *(const f32x4*)(ct + tq * 32 + 16 * s2 + 8 * hh + 4);
                qs[pi][s2][0] = *(const f32x4*)(st + tq * 32 + 16 * s2 + 8 * hh); qs[pi][s2][1] = *(const f32x4*)(st + tq * 32 + 16 * s2 + 8 * hh + 4); } }
    {
        const int row = tid >> 1, hp = tid & 1, tk = 128 * n - 128 + row;
        if (tk >= 0) {
            const bf16_t* kp = z + (size_t)tk * NZ + ZSK + j * 64; const bf16_t* vp = z + (size_t)tk * NZ + ZSV + j * 64;
            const u32x4 a0 = *(const u32x4*)(kp + 16 * hp), a1 = *(const u32x4*)(kp + 16 * hp + 8), b0 = *(const u32x4*)(kp + 32 + 16 * hp), b1 = *(const u32x4*)(kp + 32 + 16 * hp + 8);
            const unsigned x1[8] = {a0.x, a0.y, a0.z, a0.w, a1.x, a1.y, a1.z, a1.w}, x2[8] = {b0.x, b0.y, b0.z, b0.w, b1.x, b1.y, b1.z, b1.w};
            unsigned o1[8], o2[8];
            const f32x4* cp4 = (const f32x4*)(ct + tk * 32 + 16 * hp); const f32x4* sp4 = (const f32x4*)(st + tk * 32 + 16 * hp);
            const f32x4 cA = cp4[0], cB = cp4[1], cC = cp4[2], cD = cp4[3], sA = sp4[0], sB = sp4[1], sC = sp4[2], sD = sp4[3];
            const float cc[16] = {cA[0], cA[1], cA[2], cA[3], cB[0], cB[1], cB[2], cB[3], cC[0], cC[1], cC[2], cC[3], cD[0], cD[1], cD[2], cD[3]};
            const float sn[16] = {sA[0], sA[1], sA[2], sA[3], sB[0], sB[1], sB[2], sB[3], sC[0], sC[1], sC[2], sC[3], sD[0], sD[1], sD[2], sD[3]};
#pragma unroll
            for (int q = 0; q < 8; ++q) { const float c0 = cc[2 * q], s0 = sn[2 * q], c1 = cc[2 * q + 1], s1 = sn[2 * q + 1];
                const float u0 = bf2f(x1[q] & 0xffffu), u1 = bf2f(x1[q] >> 16), w0 = bf2f(x2[q] & 0xffffu), w1 = bf2f(x2[q] >> 16);
                o1[q] = pk2(u0 * c0 - w0 * s0, u1 * c1 - w1 * s1); o2[q] = pk2(w0 * c0 + u0 * s0, w1 * c1 + u1 * s1); }
            *(LAS u32x4*)(Ks + row * KST + 16 * hp) = (u32x4){o1[0], o1[1], o1[2], o1[3]}; *(LAS u32x4*)(Ks + row * KST + 16 * hp + 8) = (u32x4){o1[4], o1[5], o1[6], o1[7]};
            *(LAS u32x4*)(Ks + row * KST + 32 + 16 * hp) = (u32x4){o2[0], o2[1], o2[2], o2[3]}; *(LAS u32x4*)(Ks + row * KST + 32 + 16 * hp + 8) = (u32x4){o2[4], o2[5], o2[6], o2[7]};
#pragma unroll
            for (int q = 0; q < 4; ++q) *(LAS u32x4*)(Vs + row * VST + 32 * hp + 8 * q) = *(const u32x4*)(vp + 32 * hp + 8 * q);
        } else {
            const u32x4 zz = (u32x4){0u, 0u, 0u, 0u};
#pragma unroll
            for (int q = 0; q < 4; ++q) { *(LAS u32x4*)(Ks + row * KST + 32 * hp + 8 * q) = zz; *(LAS u32x4*)(Vs + row * VST + 32 * hp + 8 * q) = zz; }
        }
    }
#pragma unroll
    for (int pi = 0; pi < 2; ++pi)
#pragma unroll
        for (int s2 = 0; s2 < 2; ++s2) { const u32x4 xa = qxa[pi][s2], xb = qxb[pi][s2]; const f32x4 c0 = qc[pi][s2][0], c1 = qc[pi][s2][1], s0 = qs[pi][s2][0], s1 = qs[pi][s2][1];
            const unsigned x1[4] = {xa.x, xa.y, xa.z, xa.w}, x2[4] = {xb.x, xb.y, xb.z, xb.w}; const float cc[8] = {c0[0], c0[1], c0[2], c0[3], c1[0], c1[1], c1[2], c1[3]}, sn[8] = {s0[0], s0[1], s0[2], s0[3], s1[0], s1[1], s1[2], s1[3]};
            unsigned o1[4], o2[4];
#pragma unroll
            for (int q = 0; q < 4; ++q) { const float u0 = bf2f(x1[q] & 0xffffu), u1 = bf2f(x1[q] >> 16), w0 = bf2f(x2[q] & 0xffffu), w1 = bf2f(x2[q] >> 16);
                o1[q] = pk2((u0 * cc[2 * q] - w0 * sn[2 * q]) * 0.125f, (u1 * cc[2 * q + 1] - w1 * sn[2 * q + 1]) * 0.125f);
                o2[q] = pk2((w0 * cc[2 * q] + u0 * sn[2 * q]) * 0.125f, (w1 * cc[2 * q + 1] + u1 * sn[2 * q + 1]) * 0.125f); }
            qf[pi][s2] = __builtin_bit_cast(bf16x8, (u32x4){o1[0], o1[1], o1[2], o1[3]}); qf[pi][s2 + 2] = __builtin_bit_cast(bf16x8, (u32x4){o2[0], o2[1], o2[2], o2[3]}); }
    __syncthreads();
    const float sink = ((const float*)in_ptr(8))[layer * 16 + hq];
    const int i16 = lane & 15, q4 = i16 >> 2, p4 = i16 & 3, blk = (lane >> 4) & 1;
    const LAS bf16_t* vbase = Vs + (4 * hh + q4) * VST + 16 * blk + 4 * p4;
#pragma unroll
    for (int pi = 0; pi < 2; ++pi) {
        const int p = 2 * (w >> 2) + pi, tq = 128 * n + 32 * p + r;
        f32x16 X[5];
#pragma unroll
        for (int b = 0; b < 5; ++b) {
#pragma unroll
            for (int i = 0; i < 16; ++i) X[b][i] = 0.f;
#pragma unroll
            for (int s = 0; s < 4; ++s) { const bf16x8 kf = *(const LAS bf16x8*)(Ks + (32 * (p + b) + r) * KST + 16 * s + 8 * hh); X[b] = MFMA32(kf, qf[pi][s], X[b]); } }
        float mx = -INFINITY;
#pragma unroll
        for (int b = 0; b < 5; ++b)
#pragma unroll
            for (int i = 0; i < 16; ++i) { const int cr = (i & 3) + 8 * (i >> 2) + 4 * hh; bool valid = (b == 0) ? (cr > r) : (b == 4) ? (cr <= r) : true; if (n == 0) valid = valid && (p + b >= 4);
                const float v = valid ? X[b][i] : -INFINITY; X[b][i] = v; mx = fmaxf(mx, v); }
        mx = fmaxf(mx, shx(mx, 32, lane));
        const float m = fmaxf(mx, sink), mL = m * 1.44269504088896341f;
        float sum = 0.f;
#pragma unroll
        for (int b = 0; b < 5; ++b)
#pragma unroll
            for (int i = 0; i < 16; ++i) { const float e = pg8::exp_sub(X[b][i], mL); X[b][i] = e; sum += e; }
        sum += shx(sum, 32, lane);
        const float inv = 1.f / (sum + __expf(sink - m));
        f32x16 Z[2];
#pragma unroll
        for (int et = 0; et < 2; ++et)
#pragma unroll
            for (int i = 0; i < 16; ++i) Z[et][i] = 0.f;
#pragma unroll
        for (int b = 0; b < 5; ++b)
#pragma unroll
            for (int s2 = 0; s2 < 2; ++s2) {
                u32x4 pw;
                pw.x = pk2(X[b][8 * s2 + 0] * inv, X[b][8 * s2 + 1] * inv); pw.y = pk2(X[b][8 * s2 + 2] * inv, X[b][8 * s2 + 3] * inv);
                pw.z = pk2(X[b][8 * s2 + 4] * inv, X[b][8 * s2 + 5] * inv); pw.w = pk2(X[b][8 * s2 + 6] * inv, X[b][8 * s2 + 7] * inv);
                const bf16x8 pa = __builtin_bit_cast(bf16x8, pw);
                const LAS bf16_t* vp = vbase + (32 * (p + b) + 16 * s2) * VST;
#pragma unroll
                for (int et = 0; et < 2; ++et) { const s16x4 lo = tr_read(vp + 32 * et), hi = tr_read(vp + 8 * VST + 32 * et);
                    const bf16x8 vb = (bf16x8){lo[0], lo[1], lo[2], lo[3], hi[0], hi[1], hi[2], hi[3]};
                    Z[et] = MFMA32(pa, vb, Z[et]); } }
        LAS bf16_t* stg = Vs + 256 * VST + w * (32 * 72);
#pragma unroll
        for (int et = 0; et < 2; ++et)
#pragma unroll
            for (int i = 0; i < 16; ++i) { const int cr = (i & 3) + 8 * (i >> 2) + 4 * hh; stg[cr * 72 + 32 * et + r] = (bf16_t)f2bf(Z[et][i]); }
        LDS_WAIT(); asm volatile("" ::: "memory");
        bf16_t* mxp = wsp<bf16_t>(F, WS_MIX) + (size_t)(128 * n + 32 * p) * D + 512 + hq * 64;
#pragma unroll
        for (int jq = 0; jq < 4; ++jq) { const int id = lane + 64 * jq, row = id >> 3, c16 = id & 7; *(u32x4*)(mxp + (size_t)row * D + 8 * c16) = *(const LAS u32x4*)(stg + row * 72 + 8 * c16); }
        LDS_WAIT(); asm volatile("" ::: "memory");
    }
    __syncthreads();
}


__device__ __forceinline__ void gla_local_mfma(Frame& F, int unit) {
    constexpr int KS = 96, VS = 160;
    const int h = unit >> 7, ck = unit & 127, t0 = ck * 64, w = F.wave, lane = F.lane, tid = F.tid;
    const bf16_t* z = wsp<bf16_t>(F, WS_Z); const float* la = wsp<float>(F, WS_LA);
    LAS float* tot = (LAS float*)F.lds; LAS bf16_t* kh = (LAS bf16_t*)(tot + 512); LAS bf16_t* vs = kh + 64 * KS;
    bf16_t kraw[8]; u32x4 vraw[2];
#pragma unroll
    for (int i = 0; i < 8; ++i) kraw[i] = z[(size_t)(t0 + 8 * w + i) * NZ + ZK + h * 64 + lane];
#pragma unroll
    for (int j = 0; j < 2; ++j) { const int idx = tid + 512 * j, t = idx >> 4, ch = idx & 15; vraw[j] = *(const u32x4*)(z + (size_t)(t0 + t) * NZ + ZV + h * 128 + ch * 8); }
    float c[8]; gla_cumsum(F, la, t0, h, tot, c);
    float total = 0.f;
#pragma unroll
    for (int j = 0; j < 8; ++j) total += tot[j * 64 + lane];
#pragma unroll
    for (int i = 0; i < 8; ++i) { const int t = 8 * w + i; kh[t * KS + lane] = (bf16_t)f2bf(bf2f(kraw[i]) * __expf(total - c[i])); }
#pragma unroll
    for (int j = 0; j < 2; ++j) { const int idx = tid + 512 * j, t = idx >> 4, ch = idx & 15; *(LAS u32x4*)(vs + t * VS + ch * 8) = vraw[j]; }
    if (w == 0) wsp<float>(F, WS_DEC)[(size_t)unit * 64 + lane] = __expf(total);
    __syncthreads();
    const int r = lane & 31, hh = lane >> 5, i16 = lane & 15, q4 = i16 >> 2, p4 = i16 & 3, blk = (lane >> 4) & 1, dt = w & 1, et = w >> 1;
    const LAS bf16_t* ka = kh + (8 * hh + q4) * KS + 32 * dt + 16 * blk + 4 * p4;
    const LAS bf16_t* va = vs + (8 * hh + q4) * VS + 32 * et + 16 * blk + 4 * p4;
    f32x16 acc;
#pragma unroll
    for (int i = 0; i < 16; ++i) acc[i] = 0.f;
#pragma unroll
    for (int s4 = 0; s4 < 4; ++s4) {
        const s16x4 al = tr_read(ka + 16 * s4 * KS), ah = tr_read(ka + (16 * s4 + 4) * KS), bl = tr_read(va + 16 * s4 * VS), bh = tr_read(va + (16 * s4 + 4) * VS);
        acc = MFMA32(((bf16x8){al[0], al[1], al[2], al[3], ah[0], ah[1], ah[2], ah[3]}), ((bf16x8){bl[0], bl[1], bl[2], bl[3], bh[0], bh[1], bh[2], bh[3]}), acc); }
    float* U = wsp<float>(F, WS_UB) + (size_t)unit * 8192 + 32 * et + r;
#pragma unroll
    for (int i = 0; i < 16; ++i) U[(32 * dt + (i & 3) + 8 * (i >> 2) + 4 * hh) * 128] = acc[i];
    __syncthreads();
}
__device__ __forceinline__ void gla_out_mfma(Frame& F, int unit, int layer) {
    constexpr int QS = 72, VS = 160;
    const int h = unit >> 7, ck = unit & 127, t0 = ck * 64, w = F.wave, lane = F.lane, tid = F.tid;
    const bf16_t* z = wsp<bf16_t>(F, WS_Z); const float* la = wsp<float>(F, WS_LA);
    LAS float* tot = (LAS float*)F.lds; LAS float* red = tot + 512;
    LAS bf16_t* qt = (LAS bf16_t*)(red + 256); LAS bf16_t* kt = qt + 64 * QS; LAS bf16_t* qe = kt + 64 * QS; LAS bf16_t* vs = qe + 64 * QS; LAS bf16_t* Ss = vs + 64 * VS;
    bf16_t qraw[8], kraw[8]; u32x4 vraw[2], sraw[2];
#pragma unroll
    for (int i = 0; i < 8; ++i) { const size_t zo = (size_t)(t0 + 8 * w + i) * NZ + h * 64 + lane; qraw[i] = z[zo + ZQ]; kraw[i] = z[zo + ZK]; }
#pragma unroll
    for (int j = 0; j < 2; ++j) { const int idx = tid + 512 * j, t = idx >> 4, ch = idx & 15;
        vraw[j] = *(const u32x4*)(z + (size_t)(t0 + t) * NZ + ZV + h * 128 + ch * 8); sraw[j] = *(const u32x4*)(wsp<bf16_t>(F, WS_SB) + (size_t)unit * 8192 + t * 128 + ch * 8); }
    const int r_ = lane & 31, hh_ = lane >> 5, tt_ = w & 1, et_ = w >> 1, tl_ = 32 * tt_ + r_;
    u32x2 grv[4]; f32x4 gnv[4];
    {   const bf16_t* zr = z + (size_t)(t0 + tl_) * NZ + ZR + h * 128 + 32 * et_ + 4 * hh_; const float* gn = (const float*)in_ptr(7) + layer * 128 + 32 * et_ + 4 * hh_;
#pragma unroll
        for (int g4 = 0; g4 < 4; ++g4) { grv[g4] = *(const u32x2*)(zr + 8 * g4); gnv[g4] = *(const f32x4*)(gn + 8 * g4); } }
    float c[8]; gla_cumsum(F, la, t0, h, tot, c);
    const float ref = tot[lane] + tot[64 + lane] + tot[128 + lane] + tot[192 + lane];
#pragma unroll
    for (int i = 0; i < 8; ++i) { const int t = 8 * w + i; const float q = bf2f(qraw[i]) * 0.125f, k = bf2f(kraw[i]);
        qt[t * QS + lane] = (bf16_t)f2bf(q * __expf(c[i] - ref)); qe[t * QS + lane] = (bf16_t)f2bf(q * __expf(c[i])); kt[t * QS + lane] = (bf16_t)f2bf(k * __expf(ref - c[i])); }
#pragma unroll
    for (int j = 0; j < 2; ++j) { const int idx = tid + 512 * j, t = idx >> 4, ch = idx & 15; *(LAS u32x4*)(vs + t * VS + ch * 8) = vraw[j]; *(LAS u32x4*)(Ss + t * VS + ch * 8) = sraw[j]; }
    __syncthreads();
    const int r = lane & 31, hh = lane >> 5, i16 = lane & 15, q4 = i16 >> 2, p4 = i16 & 3, blk = (lane >> 4) & 1, tt = w & 1, et = w >> 1;
    f32x16 Y;
#pragma unroll
    for (int i = 0; i < 16; ++i) Y[i] = 0.f;
    {   const LAS bf16_t* sa = Ss + (8 * hh + q4) * VS + 32 * et + 16 * blk + 4 * p4; const LAS bf16_t* qb = qe + (32 * tt + r) * QS + 8 * hh;
#pragma unroll
        for (int s4 = 0; s4 < 4; ++s4) { const s16x4 al = tr_read(sa + 16 * s4 * VS), ah = tr_read(sa + (16 * s4 + 4) * VS); const bf16x8 bq = *(const LAS bf16x8*)(qb + 16 * s4);
            Y = MFMA32(((bf16x8){al[0], al[1], al[2], al[3], ah[0], ah[1], ah[2], ah[3]}), bq, Y); } }
    const LAS bf16_t* va = vs + (4 * hh + q4) * VS + 32 * et + 16 * blk + 4 * p4;
#pragma unroll
    for (int st = 0; st < 2; ++st) {
        if (st <= tt) {
            f32x16 X;
#pragma unroll
            for (int i = 0; i < 16; ++i) X[i] = 0.f;
            const LAS bf16_t* ka = kt + (32 * st + r) * QS + 8 * hh; const LAS bf16_t* qb = qt + (32 * tt + r) * QS + 8 * hh;
#pragma unroll
            for (int s4 = 0; s4 < 4; ++s4) X = MFMA32(*(const LAS bf16x8*)(ka + 16 * s4), *(const LAS bf16x8*)(qb + 16 * s4), X);
            if (st == tt) {
#pragma unroll
                for (int i = 0; i < 16; ++i) { const int cr = (i & 3) + 8 * (i >> 2) + 4 * hh; X[i] = (cr <= r) ? X[i] : 0.f; } }
#pragma unroll
            for (int s2 = 0; s2 < 2; ++s2) {
                u32x4 pw; pw.x = pk2(X[8 * s2 + 0], X[8 * s2 + 1]); pw.y = pk2(X[8 * s2 + 2], X[8 * s2 + 3]); pw.z = pk2(X[8 * s2 + 4], X[8 * s2 + 5]); pw.w = pk2(X[8 * s2 + 6], X[8 * s2 + 7]);
                const LAS bf16_t* vp = va + (32 * st + 16 * s2) * VS;
                const s16x4 lo = tr_read(vp), hi = tr_read(vp + 8 * VS);
                Y = MFMA32(((bf16x8){lo[0], lo[1], lo[2], lo[3], hi[0], hi[1], hi[2], hi[3]}), __builtin_bit_cast(bf16x8, pw), Y); }
        }
    }
    float p = 0.f;
#pragma unroll
    for (int i = 0; i < 16; ++i) p += Y[i] * Y[i];
    p += shx(p, 32, lane);
    if (hh == 0) red[et * 64 + 32 * tt + r] = p;
    __syncthreads();
    const int tl = 32 * tt + r;
    const float rs = rsqrtf(((red[tl] + red[64 + tl]) + (red[128 + tl] + red[192 + tl])) * (1.f / 128.f) + EPS);
    bf16_t* mx = wsp<bf16_t>(F, WS_MIX) + (size_t)(t0 + tl) * D + h * 128 + 32 * et;
    u32x2 ov[4];
#pragma unroll
    for (int g4 = 0; g4 < 4; ++g4) { const u32x2 rr = grv[g4]; const f32x4 g = gnv[g4];
        ov[g4].x = pk2(Y[4 * g4 + 0] * rs * g[0] * siluf(bf2f(rr.x & 0xffffu)), Y[4 * g4 + 1] * rs * g[1] * siluf(bf2f(rr.x >> 16)));
        ov[g4].y = pk2(Y[4 * g4 + 2] * rs * g[2] * siluf(bf2f(rr.y & 0xffffu)), Y[4 * g4 + 3] * rs * g[3] * siluf(bf2f(rr.y >> 16))); }
#pragma unroll
    for (int k = 0; k < 4; k += 2) { const auto rx = __builtin_amdgcn_permlane32_swap(ov[k].x, ov[k + 1].x, false, false); const auto ry = __builtin_amdgcn_permlane32_swap(ov[k].y, ov[k + 1].y, false, false);
        *(u32x4*)(mx + 8 * (k + hh)) = (u32x4){rx[0], ry[0], rx[1], ry[1]}; }
    __syncthreads();
}

struct SCIn { u32x4 a[6], b[6], cb[4]; f32x4 w[3][2]; };
__device__ __forceinline__ void sconv_load(const Frame& F, int it, int layer, SCIn& g) {
    const bf16_t* __restrict__ z = wsp<bf16_t>(F, WS_Z); const float* wc = (const float*)in_ptr(9) + layer * 3 * 512; const int c0 = (F.tid & 63) * 8, t0 = 4 * (it >> 6);
#pragma unroll
    for (int jj = 0; jj < 3; ++jj) { g.w[jj][0] = *(const f32x4*)(wc + jj * 512 + c0); g.w[jj][1] = *(const f32x4*)(wc + jj * 512 + c0 + 4); }
#pragma unroll
    for (int r = 0; r < 6; ++r) { const int ts = t0 - 2 + r, tc = ts < 0 ? 0 : ts; g.a[r] = *(const u32x4*)(z + (size_t)tc * NZ + ZCC + c0); g.b[r] = *(const u32x4*)(z + (size_t)tc * NZ + ZCH + c0); }
#pragma unroll
    for (int k = 0; k < 4; ++k) g.cb[k] = *(const u32x4*)(z + (size_t)(t0 + k) * NZ + ZCB + c0);
}
__device__ __forceinline__ void sconv_compute(const Frame& F, int it, const SCIn& g) {
    bf16_t* __restrict__ mix = wsp<bf16_t>(F, WS_MIX); const int c0 = (F.tid & 63) * 8, t0 = 4 * (it >> 6);
    float p[6][8];
#pragma unroll
    for (int r = 0; r < 6; ++r) { const unsigned aa[4] = {g.a[r].x, g.a[r].y, g.a[r].z, g.a[r].w}, bb[4] = {g.b[r].x, g.b[r].y, g.b[r].z, g.b[r].w}; const bool ok = (t0 - 2 + r) >= 0;
#pragma unroll
        for (int q = 0; q < 4; ++q) { p[r][2 * q] = ok ? bf2f(aa[q] & 0xffffu) * bf2f(bb[q] & 0xffffu) : 0.f; p[r][2 * q + 1] = ok ? bf2f(aa[q] >> 16) * bf2f(bb[q] >> 16) : 0.f; } }
#pragma unroll
    for (int k = 0; k < 4; ++k) { float acc[8];
#pragma unroll
        for (int e = 0; e < 8; ++e) { acc[e] = g.w[0][e >> 2][e & 3] * p[k][e]; acc[e] += g.w[1][e >> 2][e & 3] * p[k + 1][e]; acc[e] += g.w[2][e >> 2][e & 3] * p[k + 2][e]; }
        const unsigned cc[4] = {g.cb[k].x, g.cb[k].y, g.cb[k].z, g.cb[k].w}; unsigned ow[4];
#pragma unroll
        for (int q = 0; q < 4; ++q) ow[q] = pk2(acc[2 * q] * bf2f(cc[q] & 0xffffu), acc[2 * q + 1] * bf2f(cc[q] >> 16));
        *(u32x4*)(mix + (size_t)(t0 + k) * D + 1536 + c0) = (u32x4){ow[0], ow[1], ow[2], ow[3]}; }
}
__device__ __forceinline__ void scan_sconv_phase(Frame& F, int layer) {
    constexpr int NIT = (T / 4) * 64; const int it0 = F.bid * 512 + F.tid, stride = F.G * 512;
    SCIn g; sconv_load(F, it0 < NIT ? it0 : 0, layer, g);
    gla_scan4(F);
    if (it0 < NIT) sconv_compute(F, it0, g);
    for (int it = it0 + stride; it < NIT; it += stride) { SCIn h; sconv_load(F, it, layer, h); sconv_compute(F, it, h); }
}
__device__ __forceinline__ void xsoftmax_phase(Frame& F) {
    const float* sc = wsp<float>(F, WS_SC); bf16_t* pb = wsp<bf16_t>(F, WS_PB);
    for (int it = F.bid * 8 + F.wave; it < T * 4; it += F.G * 8) { const f32x4 v = *((const f32x4*)(sc + (size_t)it * 256) + F.lane);
        const float m = wave_max(fmaxf(fmaxf(v[0], v[1]), fmaxf(v[2], v[3])), F.lane);
        const float e0 = __expf(v[0] - m), e1 = __expf(v[1] - m), e2 = __expf(v[2] - m), e3 = __expf(v[3] - m); const float inv = 1.f / wave_sum((e0 + e1) + (e2 + e3), F.lane);
        u32x2 o; o.x = pk2(e0 * inv, e1 * inv); o.y = pk2(e2 * inv, e3 * inv); *((u32x2*)(pb + (size_t)it * 256) + F.lane) = o; }
}
__device__ __forceinline__ void fconv_phase(Frame& F, const Args& A, int layer) {
    const bf16_t* u = wsp<bf16_t>(F, WS_U); bf16_t* ab = wsp<bf16_t>(F, WS_AB); const float* wc = (const float*)in_ptr(19) + (size_t)layer * 3 * NUP; const float* bc = (const float*)in_ptr(20) + (size_t)layer * NUP;
    for (int it = F.bid * 512 + F.tid; it < T * 704; it += F.G * 512) { const int t = it / 704, c0 = (it % 704) * 8; float g[8], v[8];
#pragma unroll
        for (int e = 0; e < 8; ++e) { g[e] = bc[c0 + e]; v[e] = bc[DFF + c0 + e]; }
#pragma unroll
        for (int jj = 0; jj < 3; ++jj) { const int ts = t - 2 + jj; if (ts < 0) continue;
            const u32x4 a = *(const u32x4*)(u + (size_t)ts * NUP + c0), b = *(const u32x4*)(u + (size_t)ts * NUP + DFF + c0); const unsigned aa[4] = {a.x, a.y, a.z, a.w}, bb[4] = {b.x, b.y, b.z, b.w};
#pragma unroll
            for (int p = 0; p < 4; ++p) { g[2 * p] += wc[jj * NUP + c0 + 2 * p] * bf2f(aa[p] & 0xffffu); g[2 * p + 1] += wc[jj * NUP + c0 + 2 * p + 1] * bf2f(aa[p] >> 16);
                v[2 * p] += wc[jj * NUP + DFF + c0 + 2 * p] * bf2f(bb[p] & 0xffffu); v[2 * p + 1] += wc[jj * NUP + DFF + c0 + 2 * p + 1] * bf2f(bb[p] >> 16); } }
        unsigned ow[4];
#pragma unroll
        for (int p = 0; p < 4; ++p) ow[p] = pk2(siluf(g[2 * p]) * v[2 * p], siluf(g[2 * p + 1]) * v[2 * p + 1]);
        *(u32x4*)(ab + (size_t)t * DFF + c0) = (u32x4){ow[0], ow[1], ow[2], ow[3]}; }
}
__device__ __forceinline__ void final_phase(Frame& F, const Args& A, float* out) {
    const bf16_t* hb = wsp<bf16_t>(F, WS_HB); const float* ss = ss_ptr(F, 12); const f32x4* gr = (const f32x4*)in_ptr(22) + F.lane;
    for (int m = F.bid * 8 + F.wave; m < T; m += F.G * 8) { const float rs = rsqrtf(wave_sum(F.lane < 32 ? ss[(size_t)m * 32 + F.lane] : 0.f, F.lane) * (1.f / D) + EPS);
        const u32x2* hr = (const u32x2*)(hb + (size_t)m * D) + F.lane; f32x4* o = (f32x4*)(out + (size_t)m * D) + F.lane;
#pragma unroll
        for (int j = 0; j < 8; ++j) { const u32x2 b = hr[64 * j]; const f32x4 g = gr[64 * j];
            __builtin_nontemporal_store((f32x4){bf2f(b.x & 0xffffu) * rs * g[0], bf2f(b.x >> 16) * rs * g[1], bf2f(b.y & 0xffffu) * rs * g[2], bf2f(b.y >> 16) * rs * g[3]}, o + 64 * j); } }
}
__device__ __forceinline__ void ffn_fixup(Frame& F, int pm, int layer) {
    const bf16_t* HT = wsp<bf16_t>(F, WS_HT); bf16_t* ab = wsp<bf16_t>(F, WS_AB);
    const float* wcv = (const float*)in_ptr(19) + (size_t)layer * 3 * NUP; const float* bcv = (const float*)in_ptr(20) + (size_t)layer * NUP;
    for (int chunk = F.tid; chunk < 704; chunk += 512) {
        const int ch = 8 * chunk, col = 256 * (ch >> 7) + (ch & 127);
        f32x4 wg[3][2], wv[3][2], bg[2], bv[2];
#pragma unroll
        for (int jj = 0; jj < 3; ++jj)
#pragma unroll
            for (int hh = 0; hh < 2; ++hh) { wg[jj][hh] = *(const f32x4*)(wcv + jj * NUP + ch + 4 * hh); wv[jj][hh] = *(const f32x4*)(wcv + jj * NUP + DFF + ch + 4 * hh); }
#pragma unroll
        for (int hh = 0; hh < 2; ++hh) { bg[hh] = *(const f32x4*)(bcv + ch + 4 * hh); bv[hh] = *(const f32x4*)(bcv + DFF + ch + 4 * hh); }
        u32x4 xg[4][4], xv[4][4];
#pragma unroll
        for (int q = 0; q < 4; ++q) { const int kb = 4 * pm + q;
#pragma unroll
            for (int rr = 0; rr < 4; ++rr) { const bool z = (rr < 2) && (kb == 0); const bf16_t* rp = HT + (size_t)(rr < 2 ? (z ? 0 : kb - 1) * 4 + 2 + rr : kb * 4 + (rr - 2)) * NUP + col;
                const u32x4 zz = (u32x4){0u, 0u, 0u, 0u}; xg[q][rr] = z ? zz : *(const u32x4*)rp; xv[q][rr] = z ? zz : *(const u32x4*)(rp + 128); } }
#pragma unroll
        for (int q = 0; q < 4; ++q) { const int kb = 4 * pm + q;
            f32x4 rg[4][2], rv[4][2];
#pragma unroll
            for (int rr = 0; rr < 4; ++rr) { const u32x4 a = xg[q][rr], b = xv[q][rr];
                rg[rr][0] = (f32x4){bf2f(a.x & 0xffffu), bf2f(a.x >> 16), bf2f(a.y & 0xffffu), bf2f(a.y >> 16)}; rg[rr][1] = (f32x4){bf2f(a.z & 0xffffu), bf2f(a.z >> 16), bf2f(a.w & 0xffffu), bf2f(a.w >> 16)};
                rv[rr][0] = (f32x4){bf2f(b.x & 0xffffu), bf2f(b.x >> 16), bf2f(b.y & 0xffffu), bf2f(b.y >> 16)}; rv[rr][1] = (f32x4){bf2f(b.z & 0xffffu), bf2f(b.z >> 16), bf2f(b.w & 0xffffu), bf2f(b.w >> 16)}; }
#pragma unroll
            for (int i = 0; i < 2; ++i) {
                unsigned ow[4];
#pragma unroll
                for (int hh = 0; hh < 2; ++hh) { const f32x4 G = bg[hh] + wg[0][hh] * rg[i][hh] + wg[1][hh] * rg[i + 1][hh] + wg[2][hh] * rg[i + 2][hh];
                    const f32x4 V = bv[hh] + wv[0][hh] * rv[i][hh] + wv[1][hh] * rv[i + 1][hh] + wv[2][hh] * rv[i + 2][hh];
                    ow[2 * hh] = pk2(pg8::silu_fast(G[0]) * V[0], pg8::silu_fast(G[1]) * V[1]); ow[2 * hh + 1] = pk2(pg8::silu_fast(G[2]) * V[2], pg8::silu_fast(G[3]) * V[3]); }
                *(u32x4*)(ab + (size_t)(64 * kb + i) * DFF + ch) = (u32x4){ow[0], ow[1], ow[2], ow[3]}; } }
    }
}
__device__ __forceinline__ void fill_rstd_table(Frame& F, const float* ssp, int pm) {
    LAS float* rtab = (LAS float*)(__builtin_amdgcn_groupstaticsize() + MISC_OFF + 1024);
    if (pm >= 0) { const int row = F.tid >> 1, hf = F.tid & 1; const f32x4* p = (const f32x4*)(ssp + ((size_t)pm * 256 + row) * 32 + 16 * hf);
        const f32x4 a = p[0], b = p[1], c = p[2], d = p[3];
        float sacc = (((a[0] + a[1]) + (a[2] + a[3])) + ((b[0] + b[1]) + (b[2] + b[3]))) + (((c[0] + c[1]) + (c[2] + c[3])) + ((d[0] + d[1]) + (d[2] + d[3])));
        sacc += shx(sacc, 1, F.lane);
        if (hf == 0) rtab[row] = rsqrtf(sacc * (1.f / D) + EPS); }
    __syncthreads();
}
__device__ __forceinline__ void frame_refresh(Frame& F) {
    int ln; asm volatile("v_mbcnt_lo_u32_b32 %0, -1, 0\n\tv_mbcnt_hi_u32_b32 %0, -1, %0" : "=v"(ln)); F.lane = ln; F.tid = (F.wave << 6) | ln; F.ws = ws_ptr();
}
constexpr int PH_PER_LAYER = 9, N_PHASES = 1 + NL * PH_PER_LAYER + 1;
__global__ void __launch_bounds__(512, 2) fwd(Args args) {
    extern __shared__ __attribute__((aligned(16))) unsigned char lds_raw[];
    Frame F; F.lds = (LAS unsigned char*)lds_raw; F.ws = args.ws;
    F.tid = threadIdx.x; F.lane = F.tid & 63; F.wave = __builtin_amdgcn_readfirstlane(F.tid >> 6); F.G = gridDim.x; F.bid = blockIdx.x;
    volatile LAS unsigned* MISC = (volatile LAS unsigned*)(F.lds + MISC_OFF);
    if (F.tid < 64) MISC[F.tid] = 0u;
    __syncthreads();
    XcdBarrier bar; bar.bar = (unsigned*)(args.ws + WS_CTL) + CW_BAR; bar.x = 0; bar.st = nullptr;
#if MK_ONE_LAUNCH
    bar = xcd_barrier_post((unsigned*)(args.ws + WS_CTL) + CW_BAR, MISC + 8);
#define SEAM() xcd_barrier(bar)
#else
#define SEAM() do {} while (0)
#endif
    const int lo = args.ph_lo, hi = args.ph_hi;
#define IN(k) (lo <= (k) && (k) < hi && (frame_refresh(F), true))
    const int cid = (int)blockIdx.x;

    if (IN(0)) { p_prologue(F, args); SEAM(); }
    for (int l = 0; l < NL; ++l) {
        const int p0 = 1 + l * PH_PER_LAYER;
        if (IN(p0 + 0)) {
            pg8::TileOrder S; S.init(wsp<bf16_t>(F, WS_HB), wsp<bf16_t>(F, WS_WIN + l * SZ_WIN), T, NZ, D, D, F.G, cid);
            pg8::EpiScaleBf16 E{wsp<bf16_t>(F, WS_Z), NZ, ss_ptr(F, 3 * l + 0), ZG / 256, wsp<float>(F, WS_LA), (const float*)in_ptr(6) + l * 256};
            pg8::gemm_phase<pg8::EpiScaleBf16, pg8::TileOrder, true>(F.lds, pg8::Gemm{D, D, D}, S, E, F.tid);
            if (l == 0) { KVOrder S2{F.ws, F.G, (cid + F.G - 64) % F.G}; pg8::EpiPlain E2; pg8::gemm_phase<pg8::EpiPlain, KVOrder, true>(F.lds, pg8::Gemm{D, D, D}, S2, E2, F.tid); }
            { const int first = (l == 0) ? 128 : 64; convert_slot(F, l, NA_HEAD, CV_T, false, cid - first, F.G - first); }
            SEAM(); }
        if (IN(p0 + 1)) {
            for (int u = cid; u < 512; u += F.G) gla_local_mfma(F, u);
            if (l == 0) { FoldOrder S2{F.ws, F.G, cid}; pg8::EpiPlain E2; pg8::gemm_phase<pg8::EpiPlain, FoldOrder, true>(F.lds, pg8::Gemm{512, D, D}, S2, E2, F.tid); }
            SEAM(); }
        if (IN(p0 + 2)) {
            scan_sconv_phase(F, l);
            for (int u = cid; u < 256; u += F.G) swa_unit_mfma(F, u, l);
            SEAM(); }
        if (IN(p0 + 3)) { for (int u = cid; u < 512; u += F.G) gla_out_mfma(F, u, l); SEAM(); }
        if (IN(p0 + 4)) {
            pg8::TileOrder S; S.init(wsp<bf16_t>(F, WS_MIX), wsp<bf16_t>(F, WS_WOUT + l * SZ_W22), T, D, D, D, F.G, cid);
            pg8::EpiRes E{wsp<bf16_t>(F, WS_HB), ss_ptr(F, 3 * l + 1)};
            pg8::gemm_phase<pg8::EpiRes, pg8::TileOrder, true>(F.lds, pg8::Gemm{D, D, D}, S, E, F.tid); SEAM(); }
        if (IN(p0 + 5)) {
            pg8::TileOrder S; S.init(wsp<bf16_t>(F, WS_HB), wsp<bf16_t>(F, WS_WST + l * SZ_WS), T, NSC, D, D, F.G, cid);
            pg8::EpiSoftmax E{wsp<bf16_t>(F, WS_PB), ss_ptr(F, 3 * l + 1)};
            pg8::gemm_phase<pg8::EpiSoftmax, pg8::TileOrder, false>(F.lds, pg8::Gemm{D, D, D}, S, E, F.tid);
            convert_slot(F, l, CV_T, NA, false, cid - 128, F.G - 128);
            SEAM(); }
        if (IN(p0 + 6)) {
            pg8::TileOrder S; S.init(wsp<bf16_t>(F, WS_PB), wsp<bf16_t>(F, WS_VWT + l * SZ_WS), T, D, NSC, NSC, F.G, cid);
            pg8::EpiRes E{wsp<bf16_t>(F, WS_HB), ss_ptr(F, 3 * l + 2)};
            pg8::gemm_phase<pg8::EpiRes, pg8::TileOrder, true>(F.lds, pg8::Gemm{NSC, NSC, NSC}, S, E, F.tid); SEAM(); }
        if (IN(p0 + 7)) {
            pg8::TileOrder S; S.init(wsp<bf16_t>(F, WS_HB), wsp<bf16_t>(F, WS_WUP + l * SZ_WUP), T, NUP, D, D, F.G, cid);
            pg8::EpiUpConv E{wsp<bf16_t>(F, WS_AB), wsp<bf16_t>(F, WS_HT), ss_ptr(F, 3 * l + 2), (const float*)in_ptr(19) + (size_t)l * 3 * NUP, (const float*)in_ptr(20) + (size_t)l * NUP};
            pg8::gemm_phase<pg8::EpiUpConv, pg8::TileOrder, true>(F.lds, pg8::Gemm{D, D, D}, S, E, F.tid);
            if (l + 1 < NL) convert_slot(F, l + 1, 0, NA_HEAD, true, cid - 128, F.G - 128);
            SEAM(); }
        if (IN(p0 + 8)) {
            pg8::TileOrder S; S.init(wsp<bf16_t>(F, WS_AB), wsp<bf16_t>(F, WS_WDN + l * SZ_WDN), T, D, DFF, DFF, F.G, cid);
            { pg8::Unit u0; for (int i = 0; S.next(i, u0); ++i) ffn_fixup(F, u0.pm, l); VM_WAIT(); __syncthreads(); }
            pg8::EpiRes E{wsp<bf16_t>(F, WS_HB), ss_ptr(F, 3 * l + 3)};
            pg8::gemm_phase<pg8::EpiRes, pg8::TileOrder, true>(F.lds, pg8::Gemm{DFF, DFF, DFF}, S, E, F.tid); SEAM(); }
    }
    if (IN(N_PHASES - 1)) final_phase(F, args, args.out);
#undef IN
#undef SEAM
}

extern "C" void kernel_launch(void* const* d_in, const int* in_sizes, int n_in, void* d_out, int out_size, void* d_ws, size_t ws_size, hipStream_t stream) {
    static int grid = 0;
    if (grid == 0) {
        if (n_in != 23 || ws_size < WS_END) { fprintf(stderr, "kernel_launch: expected 23 inputs and >= %zu bytes of workspace (got %d, %zu)\n", (size_t)WS_END, n_in, ws_size); grid = -1; return; }
        int dev = 0, cus = 0, per_cu = 0;
        if (hipGetDevice(&dev) != hipSuccess || hipDeviceGetAttribute(&cus, hipDeviceAttributeMultiprocessorCount, dev) != hipSuccess) { grid = -1; return; }
        if (hipFuncSetAttribute((const void*)fwd, hipFuncAttributeMaxDynamicSharedMemorySize, LDS_BYTES) != hipSuccess) { fprintf(stderr, "kernel_launch: hipFuncSetAttribute failed\n"); grid = -1; return; }
        if (hipOccupancyMaxActiveBlocksPerMultiprocessor(&per_cu, (const void*)fwd, 512, LDS_BYTES) != hipSuccess || per_cu < 1) { fprintf(stderr, "kernel_launch: occupancy query says %d\n", per_cu); }
        (void)hipGetLastError();
        grid = cus;
    }
    if (grid < 0) return;
    (void)hipMemsetAsync((char*)d_ws + WS_CTL, 0, 65536, stream);
    Args a{};
    for (int i = 0; i < 23; ++i) a.in[i] = d_in[i];
    a.out = (float*)d_out; a.ws = (unsigned char*)d_ws;
#if MK_ONE_LAUNCH
    a.ph_lo = 0; a.ph_hi = N_PHASES;
    hipLaunchKernelGGL(fwd, dim3(grid), dim3(512), LDS_BYTES, stream, a);
#else
    for (int p = 0; p < N_PHASES; ++p) { a.ph_lo = p; a.ph_hi = p + 1; hipLaunchKernelGGL(fwd, dim3(grid), dim3(512), LDS_BYTES, stream, a); }
#endif
}
```

```cpp
#include <hip/hip_runtime.h>
#include <cstdio>
#include <cstdint>

#define LAS __attribute__((address_space(3)))
#define GAS __attribute__((address_space(1)))
typedef unsigned short bf16_t;
typedef short bf16x8 __attribute__((ext_vector_type(8)));
typedef float f32x4 __attribute__((ext_vector_type(4)));
typedef float f32x2 __attribute__((ext_vector_type(2)));
typedef unsigned u32x4 __attribute__((ext_vector_type(4)));
typedef unsigned u32x2 __attribute__((ext_vector_type(2)));

#ifndef MK_ONE_LAUNCH
#define MK_ONE_LAUNCH 1
#endif

constexpr int T = 8192, D = 2048, NL = 4, NMEM = 256, NZ = 4608, DFF = 5632, NUP = 11264, NSC = 1024, NIN = 4368;
constexpr float EPS = 1e-6f;
constexpr int ZQ = 0, ZK = 256, ZV = 512, ZR = 1024, ZG = 1536, ZSQ = 1792, ZSK = 2816, ZSV = 2944, ZCB = 3072, ZCC = 3584, ZCH = 4096;

constexpr size_t MiB = 1u << 20;
constexpr size_t WS_CTL = 0, CTL_BYTES = 2 * MiB;
constexpr size_t SZ_WIN = (size_t)NZ * D * 2, SZ_W22 = (size_t)D * D * 2, SZ_WUP = (size_t)NUP * D * 2, SZ_WDN = (size_t)D * DFF * 2;
constexpr size_t SZ_WS = (size_t)NSC * D * 2, SZ_MEM = (size_t)NMEM * D * 2;
constexpr size_t WS_WIN = WS_CTL + CTL_BYTES;
constexpr size_t WS_WOUT = WS_WIN + NL * SZ_WIN;
constexpr size_t WS_WQP = WS_WOUT + NL * SZ_W22;
constexpr size_t WS_WK = WS_WQP + NL * SZ_W22;
constexpr size_t WS_WV = WS_WK + NL * SZ_W22;
constexpr size_t WS_WO = WS_WV + NL * SZ_W22;
constexpr size_t WS_WUP = WS_WO + NL * SZ_W22;
constexpr size_t WS_WDN = WS_WUP + NL * SZ_WUP;
constexpr size_t WS_WST = WS_WDN + NL * SZ_WDN;
constexpr size_t WS_VWT = WS_WST + NL * SZ_WS;
constexpr size_t WS_MEMN = WS_VWT + NL * SZ_WS;
constexpr size_t WS_KMEM = WS_MEMN + NL * SZ_MEM;
constexpr size_t WS_VMEM = WS_KMEM + NL * SZ_MEM;
constexpr size_t WS_ROPE = WS_VMEM + NL * SZ_MEM;
constexpr size_t WS_H = WS_ROPE + 2 * MiB;
constexpr size_t WS_HB = WS_H + (size_t)T * D * 4;
constexpr size_t WS_Z = WS_HB + (size_t)T * D * 2;
constexpr size_t WS_LA = WS_Z + (size_t)T * NZ * 2;
constexpr size_t WS_MIX = WS_LA + (size_t)T * 256 * 4;
constexpr size_t WS_UB = WS_MIX + (size_t)T * D * 2;
constexpr size_t WS_DEC = WS_UB + (size_t)4 * 128 * 64 * 128 * 4;
constexpr size_t WS_SB = WS_DEC + 1 * MiB;
constexpr size_t WS_SC = WS_SB + (size_t)4 * 128 * 64 * 128 * 2;
constexpr size_t WS_PB = WS_SC + (size_t)T * NSC * 4;
constexpr size_t WS_U = WS_PB + (size_t)T * NSC * 2;
constexpr size_t WS_HT = WS_U;
constexpr size_t WS_AB = WS_U + (size_t)T * NUP * 2;
constexpr size_t WS_SSP = WS_AB + (size_t)T * DFF * 2;
constexpr size_t WS_END = WS_SSP + (size_t)13 * T * 32 * 4;
constexpr int CW_TMO = 0, CW_BAR = 4096;

constexpr int RING_BYTES = 131072, MISC_OFF = RING_BYTES, LDS_BYTES = 147456;

__device__ __forceinline__ float bf2f(unsigned b) { return __uint_as_float(b << 16); }
typedef __bf16 bf16x2_t __attribute__((ext_vector_type(2)));
__device__ __forceinline__ unsigned pk2(float lo, float hi) { const f32x2 v = {lo, hi}; return __builtin_bit_cast(unsigned, __builtin_convertvector(v, bf16x2_t)); }
__device__ __forceinline__ unsigned f2bf(float f) { return pk2(f, 0.f) & 0xffffu; }
__device__ __forceinline__ unsigned cvt_pk_bf16(float lo, float hi) { unsigned r; asm volatile("v_cvt_pk_bf16_f32 %0, %1, %2" : "=v"(r) : "v"(lo), "v"(hi)); return r; }
__device__ __forceinline__ float shx(float v, int m, int lane) { return __builtin_bit_cast(float, __builtin_amdgcn_ds_bpermute((lane ^ m) << 2, __builtin_bit_cast(int, v))); }
__device__ __forceinline__ float wave_sum(float v, int lane) {
#pragma unroll
    for (int o = 1; o < 64; o <<= 1) v += shx(v, o, lane);
    return v;
}
__device__ __forceinline__ float wave_max(float v, int lane) {
#pragma unroll
    for (int o = 1; o < 64; o <<= 1) v = fmaxf(v, shx(v, o, lane));
    return v;
}
__device__ __forceinline__ float siluf(float x) { return x / (1.f + __expf(-x)); }
__device__ __forceinline__ float logsigf(float x) { return fminf(x, 0.f) - __logf(1.f + __expf(-fabsf(x))); }
__device__ __forceinline__ void st16_wt(void* p, u32x4 v) { *(u32x4*)p = v; }
#define LDS_WAIT() asm volatile("s_waitcnt lgkmcnt(0)" ::: "memory")
#define VM_WAIT() asm volatile("s_waitcnt vmcnt(0)" ::: "memory")

namespace pg8 {
constexpr int BM = 256, BK = 64, HALF = 128, HTB = HALF * BK * 2, STAGE_BYTES = 8 * HTB, NXCD = 8, WGM = 4;
__host__ __device__ __forceinline__ int lds_byte(int r, int c) { const int st = (r >> 4) * 2 + (c >> 5), rr = r & 15, cc = c & 31, ob = rr * 64 + cc * 2; return st * 1024 + (ob ^ (((ob >> 9) & 1) << 5)); }
__host__ __device__ __forceinline__ void stage_rc(int b, int& R, int& C) { const int st = b / 1024, sb = b % 1024, swz = sb ^ (((sb >> 9) & 1) << 5); R = (st >> 1) * 16 + swz / 64; C = (st & 1) * 32 + (swz % 64) / 2; }
__host__ __device__ __forceinline__ int perm32(int rho) { const int n = rho >> 4, i = rho & 15; return 8 * (i >> 2) + 4 * n + (i & 3); }

struct Unit { int pm, pn; const char* a; const char* b; char* o; int ldc; float sc; };
struct Gemm { int K, lda, ldb; };

struct TileOrder {
    const char* A; const char* Bt; int nM, nN, nwg, G, c; size_t ta, tb;
    __device__ __forceinline__ void init(const void* A_, const void* Bt_, int M, int N, int lda, int ldb, int G_, int c_) {
        A = (const char*)A_; Bt = (const char*)Bt_; nM = M / BM; nN = N / BM; nwg = nM * nN; G = G_; c = c_; ta = (size_t)BM * lda * 2; tb = (size_t)BM * ldb * 2; }
    __device__ __forceinline__ bool next(int i, Unit& u) const {
        const long L = (long)i * G + c; if (L >= nwg) return false;
        int wgid = (int)L; { const int q = nwg / NXCD, r = nwg % NXCD, xcd = wgid % NXCD, off = wgid / NXCD; wgid = (xcd < r ? xcd * (q + 1) : r * (q + 1) + (xcd - r) * q) + off; }
        const int nig = WGM * nN, gid = wgid / nig, fm = gid * WGM, gsz = (nM - fm) < WGM ? (nM - fm) : WGM;
        u.pm = fm + ((wgid % nig) % gsz); u.pn = (wgid % nig) / gsz;
        u.a = A + (size_t)u.pm * ta; u.b = Bt + (size_t)u.pn * tb; u.o = nullptr; u.ldc = 0; u.sc = 1.f; return true;
    }
    __device__ __forceinline__ void a_ready(const Unit&) const {}
    __device__ __forceinline__ void done(const Unit&) const {}
};

template <class Epi, class Sched, bool ALIGN_EPI>
__device__ __forceinline__ void gemm_phase(LAS unsigned char* lds, const Gemm g, const Sched& S, const Epi& E, int tid_in) {
    int tid_ = tid_in; asm volatile("" : "+v"(tid_));
    const int tid = tid_, wid = __builtin_amdgcn_readfirstlane(tid >> 6), lane = tid & 63, wr = wid >> 2, wc = wid & 3, fr = lane & 15, fq = lane >> 4;
    const int K = g.K, nt = K / BK;
    unsigned voffA[2], voffB[2];
#pragma unroll
    for (int i = 0; i < 2; ++i) { int R, C; stage_rc(tid * 16 + i * 8192, R, C); const int Rb = Epi::PERM ? ((R & ~31) + perm32(R & 31)) : R;
        const int Ra = Epi::ROWPERM ? ((R & 64) | ((R & 15) << 2) | ((R >> 4) & 3)) : R;
        voffA[i] = (unsigned)(Ra * g.lda + C) * 2u; voffB[i] = (unsigned)(Rb * g.ldb + C) * 2u; }
    const size_t kstep = (size_t)(BK * 2);
    const size_t hstepA = (size_t)HALF * g.lda * 2, hstepB = (size_t)HALF * g.ldb * 2;
    const unsigned ldsw = (unsigned)wid * 1024u;
    const int aoff = lds_byte(wr * 64 + fr, fq * 8), boff = lds_byte(wc * 32 + fr, fq * 8);
#define PG8_SA(b, h) (((b) * 2 + (h)) * HTB)
#define PG8_SB(b, h) ((4 + (b) * 2 + (h)) * HTB)
#define PG8_STAGE(bufoff, gbase, voff) do { _Pragma("unroll") for (int _i = 0; _i < 2; ++_i) \
        __builtin_amdgcn_global_load_lds((const unsigned*)((const char*)(gbase) + (voff)[_i]), (LAS unsigned*)(lds + (bufoff) + ldsw + _i * 8192), 16, 0, 0); } while (0)
#define PG8_LDA(dst, b, h) do { _Pragma("unroll") for (int m = 0; m < 4; ++m) _Pragma("unroll") for (int k = 0; k < 2; ++k) dst[m][k] = *(const LAS bf16x8*)(lds + PG8_SA(b, h) + aoff + m * 2048 + k * 1024); } while (0)
#define PG8_LDB(dst, b, h) do { _Pragma("unroll") for (int n = 0; n < 2; ++n) _Pragma("unroll") for (int k = 0; k < 2; ++k) dst[n][k] = *(const LAS bf16x8*)(lds + PG8_SB(b, h) + boff + n * 2048 + k * 1024); } while (0)
#define PG8_MMA(ai, bj, At, Bt) do { __builtin_amdgcn_s_setprio(1); _Pragma("unroll") for (int m = 0; m < 4; ++m) _Pragma("unroll") for (int n = 0; n < 2; ++n) _Pragma("unroll") for (int k = 0; k < 2; ++k) \
        acc[ai][bj][m][n] = __builtin_amdgcn_mfma_f32_16x16x32_bf16(Bt[n][k], At[m][k], acc[ai][bj][m][n], 0, 0, 0); __builtin_amdgcn_s_setprio(0); } while (0)
#define PG8_WAIT_V(n) asm volatile("s_waitcnt vmcnt(" #n ")" ::: "memory")
#define PG8_WAIT_L(n) asm volatile("s_waitcnt lgkmcnt(" #n ")" ::: "memory")
#define PG8_BAR __builtin_amdgcn_s_barrier()
#define PG8_SCHED __builtin_amdgcn_sched_barrier(0)
    Unit cur, nxt; int ui = 0;
    if (!S.next(0, cur)) return;
    f32x4 acc[2][2][4][2];
#pragma unroll
    for (int a = 0; a < 2; ++a)
#pragma unroll
        for (int b = 0; b < 2; ++b)
#pragma unroll
            for (int m = 0; m < 4; ++m)
#pragma unroll
                for (int n = 0; n < 2; ++n) acc[a][b][m][n] = (f32x4){0.f, 0.f, 0.f, 0.f};
    bf16x8 At[4][2], B0[2][2], B1[2][2];
    const char* cA = cur.a; const char* cB = cur.b;
    S.a_ready(cur);
    PG8_STAGE(PG8_SB(0, 0), cB, voffB); PG8_STAGE(PG8_SB(0, 1), cB + hstepB, voffB); PG8_STAGE(PG8_SA(0, 0), cA, voffA); PG8_STAGE(PG8_SA(0, 1), cA + hstepA, voffA);
    PG8_STAGE(PG8_SB(1, 0), cB + kstep, voffB); PG8_STAGE(PG8_SA(1, 0), cA + kstep, voffA); PG8_STAGE(PG8_SB(1, 1), cB + hstepB + kstep, voffB);
    if constexpr (Epi::PREFILL) E.prefill(tid);
    if (wr == 1) PG8_BAR;
    PG8_WAIT_V(8); PG8_BAR;
    PG8_WAIT_V(6); PG8_BAR;
    for (;;) {
        const bool has_next = S.next(ui + 1, nxt);
        const char* nA = has_next ? nxt.a : cA; const char* nB = has_next ? nxt.b : cB;
        for (int t = 0; t < nt; t += 2) {
            const bool last = (t == nt - 2);
            const char* a1 = cA + (size_t)(t + 1) * kstep;
            const char* a2 = last ? nA : cA + (size_t)(t + 2) * kstep; const char* b2 = last ? nB : cB + (size_t)(t + 2) * kstep;
            const char* a3 = a2 + kstep; const char* b3 = b2 + kstep;
            if (last && has_next) S.a_ready(nxt);
            const int relax = __builtin_amdgcn_readfirstlane(((Epi::NST > 0) && (ui > 0) && (t == 0)) ? 1 : 0);
            PG8_LDB(B0, 0, 0); PG8_LDB(B1, 0, 1); PG8_SCHED; PG8_LDA(At, 0, 0); PG8_STAGE(PG8_SA(1, 1), a1 + hstepA, voffA);
            asm volatile("s_cmp_lg_u32 %0, 0\n\ts_cbranch_scc1 .Lrx%=\n\ts_waitcnt vmcnt(8)\n\ts_branch .Lry%=\n.Lrx%=:\n\ts_waitcnt vmcnt(24)\n.Lry%=:" :: "s"(relax) : "scc", "memory"); PG8_WAIT_L(0); PG8_BAR; PG8_MMA(0, 0, At, B0); PG8_MMA(0, 1, At, B1); PG8_BAR; PG8_SCHED;
            PG8_LDA(At, 0, 1); PG8_STAGE(PG8_SB(0, 0), b2, voffB); PG8_STAGE(PG8_SB(0, 1), b2 + hstepB, voffB); PG8_STAGE(PG8_SA(0, 0), a2, voffA);
            asm volatile("s_cmp_lg_u32 %0, 0\n\ts_cbranch_scc1 .Lrx%=\n\ts_waitcnt vmcnt(8)\n\ts_branch .Lry%=\n.Lrx%=:\n\ts_waitcnt vmcnt(24)\n.Lry%=:" :: "s"(relax) : "scc", "memory"); PG8_WAIT_L(0); PG8_BAR; PG8_MMA(1, 0, At, B0); PG8_MMA(1, 1, At, B1); PG8_BAR; PG8_SCHED;
            PG8_LDB(B0, 1, 0); PG8_LDB(B1, 1, 1); PG8_SCHED; PG8_LDA(At, 1, 0); PG8_STAGE(PG8_SA(0, 1), a2 + hstepA, voffA);
            PG8_WAIT_V(8); PG8_WAIT_L(0); PG8_BAR; PG8_MMA(0, 0, At, B0); PG8_MMA(0, 1, At, B1); PG8_BAR; PG8_SCHED;
            PG8_LDA(At, 1, 1); PG8_STAGE(PG8_SB(1, 0), b3, voffB); PG8_STAGE(PG8_SB(1, 1), b3 + hstepB, voffB); PG8_STAGE(PG8_SA(1, 0), a3, voffA);
            PG8_WAIT_V(8); PG8_WAIT_L(0); PG8_BAR; PG8_MMA(1, 0, At, B0); PG8_MMA(1, 1, At, B1); PG8_BAR; PG8_SCHED;
        }
        if constexpr (ALIGN_EPI) { if (wr == 0) PG8_BAR; }
        if constexpr (!Epi::AFTER_DRAIN) { int le; asm volatile("v_mbcnt_lo_u32_b32 %0, -1, 0\n\tv_mbcnt_hi_u32_b32 %0, -1, %0" : "=v"(le));
            E(acc, cur, wr, wc, le & 15, le >> 4); S.done(cur); }
        if (!has_next) break;
#pragma unroll
        for (int a = 0; a < 2; ++a)
#pragma unroll
            for (int b = 0; b < 2; ++b)
#pragma unroll
                for (int m = 0; m < 4; ++m)
#pragma unroll
                    for (int n = 0; n < 2; ++n) acc[a][b][m][n] = (f32x4){0.f, 0.f, 0.f, 0.f};
        cur = nxt; cA = nA; cB = nB; ++ui;
        if constexpr (ALIGN_EPI) { if (wr == 1) PG8_BAR; }
    }
    PG8_WAIT_V(0);
    if constexpr (!ALIGN_EPI) { if (wr == 0) PG8_BAR; }
    PG8_BAR;
    if constexpr (Epi::AFTER_DRAIN) { int le; asm volatile("v_mbcnt_lo_u32_b32 %0, -1, 0\n\tv_mbcnt_hi_u32_b32 %0, -1, %0" : "=v"(le)); E.fused(acc, cur, wr, wc, le & 15, le >> 4, lds, wid, le); S.done(cur); }
#undef PG8_SA
#undef PG8_SB
#undef PG8_STAGE
#undef PG8_LDA
#undef PG8_LDB
#undef PG8_MMA
#undef PG8_WAIT_V
#undef PG8_WAIT_L
#undef PG8_BAR
#undef PG8_SCHED
}


__device__ __forceinline__ float row_rstd_l(const float* ssp, int row, int fq, int lane) {
    const f32x4* p = (const f32x4*)(ssp + (size_t)row * 32 + 8 * fq); const f32x4 a = p[0], b = p[1];
    float s = ((a[0] + a[1]) + (a[2] + a[3])) + ((b[0] + b[1]) + (b[2] + b[3]));
    s += shx(s, 16, lane); s += shx(s, 32, lane);
    return rsqrtf(s * (1.f / D) + EPS);
}
__device__ __forceinline__ float row_rstd(const float* ssp, int row, int fq) { return row_rstd_l(ssp, row, fq, (row & 15) + 16 * fq); }
__device__ __forceinline__ void rstd8(const float* ssp, int row0, int fq, float (&rs)[2][4]) {
    f32x4 a[2][4], b[2][4];
#pragma unroll
    for (int ai = 0; ai < 2; ++ai)
#pragma unroll
        for (int m = 0; m < 4; ++m) { const f32x4* p = (const f32x4*)(ssp + (size_t)(row0 + ai * HALF + m * 16) * 32 + 8 * fq); a[ai][m] = p[0]; b[ai][m] = p[1]; }
#pragma unroll
    for (int ai = 0; ai < 2; ++ai)
#pragma unroll
        for (int m = 0; m < 4; ++m) rs[ai][m] = ((a[ai][m][0] + a[ai][m][1]) + (a[ai][m][2] + a[ai][m][3])) + ((b[ai][m][0] + b[ai][m][1]) + (b[ai][m][2] + b[ai][m][3]));
#pragma unroll
    for (int ai = 0; ai < 2; ++ai)
#pragma unroll
        for (int m = 0; m < 4; ++m) rs[ai][m] += shx(rs[ai][m], 16, (row0 & 15) + 16 * fq);
#pragma unroll
    for (int ai = 0; ai < 2; ++ai)
#pragma unroll
        for (int m = 0; m < 4; ++m) rs[ai][m] += shx(rs[ai][m], 32, (row0 & 15) + 16 * fq);
#pragma unroll
    for (int ai = 0; ai < 2; ++ai)
#pragma unroll
        for (int m = 0; m < 4; ++m) rs[ai][m] = rsqrtf(rs[ai][m] * (1.f / D) + EPS);
}
__device__ __forceinline__ void rstd_table_fill(const float* ssp, int tid) {
    LAS float* rtab = (LAS float*)(__builtin_amdgcn_groupstaticsize() + MISC_OFF + 1024);
    const int pm = 4 * ((int)blockIdx.x & 7) + (((int)blockIdx.x >> 3) & 3), row = tid >> 1, hf = tid & 1; const f32x4* p = (const f32x4*)(ssp + ((size_t)pm * 256 + row) * 32 + 16 * hf);
    const f32x4 a = p[0], b = p[1], c = p[2], d = p[3];
    float sacc = (((a[0] + a[1]) + (a[2] + a[3])) + ((b[0] + b[1]) + (b[2] + b[3]))) + (((c[0] + c[1]) + (c[2] + c[3])) + ((d[0] + d[1]) + (d[2] + d[3])));
    sacc += shx(sacc, 1, tid & 63);
    if (hf == 0) rtab[row] = rsqrtf(sacc * (1.f / D) + EPS);
    __syncthreads();
}
__device__ __forceinline__ void rstd8_tab(const float* ssp, const Unit& u, int wr, int fr, int fq, float (&rs)[2][4]) {
    const LAS float* rtab = (const LAS float*)(__builtin_amdgcn_groupstaticsize() + MISC_OFF + 1024);
    const int tab_pm = 4 * ((int)blockIdx.x & 7) + (((int)blockIdx.x >> 3) & 3);
    if (u.pm == tab_pm) {
#pragma unroll
        for (int ai = 0; ai < 2; ++ai)
#pragma unroll
            for (int m = 0; m < 4; ++m) rs[ai][m] = rtab[wr * 64 + fr + ai * HALF + m * 16];
    } else {
#pragma unroll
        for (int ai = 0; ai < 2; ++ai)
#pragma unroll
            for (int m = 0; m < 4; ++m) { rs[ai][m] = row_rstd(ssp, u.pm * BM + wr * 64 + fr + ai * HALF + m * 16, fq); asm volatile("" ::: "memory"); }
    }
}
__device__ __forceinline__ void rstd8_tab4(const float* ssp, const Unit& u, int wr, int fr, int fq, float (&rs)[2][4]) {
    const LAS float* rtab = (const LAS float*)(__builtin_amdgcn_groupstaticsize() + MISC_OFF + 1024);
    const int tab_pm = 4 * ((int)blockIdx.x & 7) + (((int)blockIdx.x >> 3) & 3);
    if (u.pm == tab_pm) {
#pragma unroll
        for (int ai = 0; ai < 2; ++ai) { const f32x4 q = *(const LAS f32x4*)(rtab + wr * 64 + ai * HALF + 4 * fr); rs[ai][0] = q[0]; rs[ai][1] = q[1]; rs[ai][2] = q[2]; rs[ai][3] = q[3]; }
    } else {
#pragma unroll
        for (int ai = 0; ai < 2; ++ai)
#pragma unroll
            for (int m = 0; m < 4; ++m) { rs[ai][m] = row_rstd_l(ssp, u.pm * BM + wr * 64 + ai * HALF + 4 * fr + m, fq, fr + 16 * fq); asm volatile("" ::: "memory"); }
    }
}
struct EpiScaleBf16 {
    static constexpr bool PERM = true, AFTER_DRAIN = false, PREFILL = true, ROWPERM = false; static constexpr int NST = 16;
    __device__ __forceinline__ void prefill(int tid) const { rstd_table_fill(ss, tid); }
    bf16_t* O; int ldc; const float* ss; int gate_pn; float* la; const float* bg;
    __device__ __forceinline__ void operator()(const f32x4 (&acc)[2][2][4][2], const Unit& u, int wr, int wc, int fr, int fq) const {
        const int row0 = u.pm * BM + wr * 64 + fr, cl = wc * 32 + 8 * fq;
        float rs8[2][4]; rstd8_tab(ss, u, wr, fr, fq, rs8);
        if (u.pn == gate_pn) {
#pragma unroll
            for (int ai = 0; ai < 2; ++ai)
#pragma unroll
                for (int m = 0; m < 4; ++m) { const int row = row0 + ai * HALF + m * 16; const float rs = rs8[ai][m];
#pragma unroll
                    for (int bj = 0; bj < 2; ++bj) { const int c = bj * HALF + cl; const f32x4 b0 = *(const f32x4*)(bg + c), b1 = *(const f32x4*)(bg + c + 4);
                        f32x4 v0 = acc[ai][bj][m][0] * rs + b0, v1 = acc[ai][bj][m][1] * rs + b1;
#pragma unroll
                        for (int e = 0; e < 4; ++e) { v0[e] = logsigf(v0[e]) * (1.f / 16.f); v1[e] = logsigf(v1[e]) * (1.f / 16.f); }
                        *(f32x4*)(la + (size_t)row * 256 + c) = v0; *(f32x4*)(la + (size_t)row * 256 + c + 4) = v1; } }
        } else {
#pragma unroll
            for (int ai = 0; ai < 2; ++ai)
#pragma unroll
                for (int m = 0; m < 4; ++m) { const int row = row0 + ai * HALF + m * 16; const float rs = rs8[ai][m];
                    bf16_t* rowp = O + (size_t)row * ldc + u.pn * BM + cl;
#pragma unroll
                    for (int bj = 0; bj < 2; ++bj) { const f32x4 v0 = acc[ai][bj][m][0] * rs, v1 = acc[ai][bj][m][1] * rs;
                        u32x4 w; w.x = cvt_pk_bf16(v0[0], v0[1]); w.y = cvt_pk_bf16(v0[2], v0[3]); w.z = cvt_pk_bf16(v1[0], v1[1]); w.w = cvt_pk_bf16(v1[2], v1[3]);
                        st16_wt(rowp + bj * HALF, w); } }
        }
    }
};
struct EpiPlain {
    static constexpr bool PERM = true, AFTER_DRAIN = false, PREFILL = false, ROWPERM = false; static constexpr int NST = 0;
    __device__ __forceinline__ void operator()(const f32x4 (&acc)[2][2][4][2], const Unit& u, int wr, int wc, int fr, int fq) const {
        const int row0 = u.pm * BM + wr * 64 + fr, cl = u.pn * BM + wc * 32 + 8 * fq; const float sc = u.sc; bf16_t* O = (bf16_t*)u.o;
#pragma unroll
        for (int ai = 0; ai < 2; ++ai)
#pragma unroll
            for (int m = 0; m < 4; ++m) { bf16_t* rowp = O + (size_t)(row0 + ai * HALF + m * 16) * u.ldc + cl;
#pragma unroll
                for (int bj = 0; bj < 2; ++bj) { const f32x4 v0 = acc[ai][bj][m][0] * sc, v1 = acc[ai][bj][m][1] * sc;
                    u32x4 w; w.x = cvt_pk_bf16(v0[0], v0[1]); w.y = cvt_pk_bf16(v0[2], v0[3]); w.z = cvt_pk_bf16(v1[0], v1[1]); w.w = cvt_pk_bf16(v1[2], v1[3]);
                    st16_wt(rowp + bj * HALF, w); } }
    }
};
struct EpiScaleF32 {
    static constexpr bool PERM = false, AFTER_DRAIN = false, PREFILL = false, ROWPERM = false;
    float* O; int ldc; const float* ss;
    __device__ __forceinline__ void operator()(const f32x4 (&acc)[2][2][4][2], const Unit& u, int wr, int wc, int fr, int fq) const {
        const int row0 = u.pm * BM + wr * 64 + fr, c0 = u.pn * BM + wc * 32 + 4 * fq;
#pragma unroll
        for (int ai = 0; ai < 2; ++ai)
#pragma unroll
            for (int m = 0; m < 4; ++m) { const int row = row0 + ai * HALF + m * 16; const float rs = row_rstd(ss, row, fq);
#pragma unroll
                for (int bj = 0; bj < 2; ++bj)
#pragma unroll
                    for (int n = 0; n < 2; ++n) *(f32x4*)(O + (size_t)row * ldc + c0 + bj * HALF + n * 16) = acc[ai][bj][m][n] * rs; }
    }
};
struct EpiRes {
    static constexpr bool PERM = true, AFTER_DRAIN = false, PREFILL = false, ROWPERM = false; static constexpr int NST = 0;
    bf16_t* hb; float* ssn;
    __device__ __forceinline__ void operator()(const f32x4 (&acc)[2][2][4][2], const Unit& u, int wr, int wc, int fr, int fq) const {
        const int row0 = u.pm * BM + wr * 64 + fr, c0 = u.pn * BM + wc * 32 + 8 * fq;
        u32x4 pre[2][4][2];
#pragma unroll
        for (int ai = 0; ai < 2; ++ai)
#pragma unroll
            for (int m = 0; m < 4; ++m)
#pragma unroll
                for (int bj = 0; bj < 2; ++bj) pre[ai][m][bj] = *(const u32x4*)(hb + (size_t)(row0 + ai * HALF + m * 16) * D + c0 + bj * HALF);
#pragma unroll
        for (int ai = 0; ai < 2; ++ai)
#pragma unroll
            for (int m = 0; m < 4; ++m) { const int row = row0 + ai * HALF + m * 16; const size_t off = (size_t)row * D + c0; float s = 0.f;
#pragma unroll
                for (int bj = 0; bj < 2; ++bj) { const u32x4 b = pre[ai][m][bj]; const f32x4 a0 = acc[ai][bj][m][0], a1 = acc[ai][bj][m][1];
                    const float o0 = bf2f(b.x & 0xffffu) + a0[0], o1 = bf2f(b.x >> 16) + a0[1], o2 = bf2f(b.y & 0xffffu) + a0[2], o3 = bf2f(b.y >> 16) + a0[3];
                    const float o4 = bf2f(b.z & 0xffffu) + a1[0], o5 = bf2f(b.z >> 16) + a1[1], o6 = bf2f(b.w & 0xffffu) + a1[2], o7 = bf2f(b.w >> 16) + a1[3];
                    u32x4 w; w.x = cvt_pk_bf16(o0, o1); w.y = cvt_pk_bf16(o2, o3); w.z = cvt_pk_bf16(o4, o5); w.w = cvt_pk_bf16(o6, o7); st16_wt(hb + off + bj * HALF, w);
                    s += ((o0 * o0 + o1 * o1) + (o2 * o2 + o3 * o3)) + ((o4 * o4 + o5 * o5) + (o6 * o6 + o7 * o7)); }
                s += shx(s, 16, fr + 16 * fq); s += shx(s, 32, fr + 16 * fq);
                if (fq == 0) ssn[(size_t)row * 32 + u.pn * 4 + wc] = s; }
    }
};
__device__ __forceinline__ void conv_wrap(f32x4& G0, f32x4& G1, const f32x4& u2, const f32x4& u3, const f32x4& w1, const f32x4& w0) {
    asm("s_nop 1\n\t"
        "v_fmac_f32_dpp %0, %12, %16 row_shr:1 row_mask:0xf bank_mask:0xf\n\t"
        "v_fmac_f32_dpp %1, %13, %17 row_shr:1 row_mask:0xf bank_mask:0xf\n\t"
        "v_fmac_f32_dpp %2, %14, %18 row_shr:1 row_mask:0xf bank_mask:0xf\n\t"
        "v_fmac_f32_dpp %3, %15, %19 row_shr:1 row_mask:0xf bank_mask:0xf\n\t"
        "v_fmac_f32_dpp %0, %8, %20 row_shr:1 row_mask:0xf bank_mask:0xf\n\t"
        "v_fmac_f32_dpp %1, %9, %21 row_shr:1 row_mask:0xf bank_mask:0xf\n\t"
        "v_fmac_f32_dpp %2, %10, %22 row_shr:1 row_mask:0xf bank_mask:0xf\n\t"
        "v_fmac_f32_dpp %3, %11, %23 row_shr:1 row_mask:0xf bank_mask:0xf\n\t"
        "v_fmac_f32_dpp %4, %12, %20 row_shr:1 row_mask:0xf bank_mask:0xf\n\t"
        "v_fmac_f32_dpp %5, %13, %21 row_shr:1 row_mask:0xf bank_mask:0xf\n\t"
        "v_fmac_f32_dpp %6, %14, %22 row_shr:1 row_mask:0xf bank_mask:0xf\n\t"
        "v_fmac_f32_dpp %7, %15, %23 row_shr:1 row_mask:0xf bank_mask:0xf"
        : "+v"(G0[0]), "+v"(G0[1]), "+v"(G0[2]), "+v"(G0[3]), "+v"(G1[0]), "+v"(G1[1]), "+v"(G1[2]), "+v"(G1[3])
        : "v"(u2[0]), "v"(u2[1]), "v"(u2[2]), "v"(u2[3]), "v"(u3[0]), "v"(u3[1]), "v"(u3[2]), "v"(u3[3]), "v"(w1[0]), "v"(w1[1]), "v"(w1[2]), "v"(w1[3]), "v"(w0[0]), "v"(w0[1]), "v"(w0[2]), "v"(w0[3]));
}
__device__ __forceinline__ float exp_sub(float x, float mL) { return __builtin_amdgcn_exp2f(__builtin_fmaf(x, 1.44269504088896341f, -mL)); }
__device__ __forceinline__ float silu_fast(float x) { return x * __builtin_amdgcn_rcpf(1.f + __expf(-x)); }
struct EpiUpConv {
    static constexpr bool PERM = true, AFTER_DRAIN = false, PREFILL = true, ROWPERM = true; static constexpr int NST = 16;
    __device__ __forceinline__ void prefill(int tid) const { rstd_table_fill(ss, tid); }
    bf16_t* AB; bf16_t* HT; const float* ss; const float* wcv; const float* bcv;
    __device__ __forceinline__ void operator()(const f32x4 (&acc)[2][2][4][2], const Unit& u, int wr, int wc, int fr, int fq) const {
        const int row0 = u.pm * BM + wr * 64 + 4 * fr, chl = wc * 32 + 8 * fq, ch0 = u.pn * 128 + chl;
        float rs8[2][4]; rstd8_tab4(ss, u, wr, fr, fq, rs8);
        u32x2 keep[2][4];
        u32x2 hk[2][4];
#pragma unroll
        for (int n = 0; n < 2; ++n) {
            const int ch = ch0 + 4 * n;
            const f32x4 wg0 = *(const f32x4*)(wcv + ch), wg1 = *(const f32x4*)(wcv + NUP + ch), wg2 = *(const f32x4*)(wcv + 2 * NUP + ch), bg = *(const f32x4*)(bcv + ch);
            const f32x4 wv0 = *(const f32x4*)(wcv + DFF + ch), wv1 = *(const f32x4*)(wcv + NUP + DFF + ch), wv2 = *(const f32x4*)(wcv + 2 * NUP + DFF + ch), bv = *(const f32x4*)(bcv + DFF + ch);
#pragma unroll
            for (int ai = 0; ai < 2; ++ai) {
                const int kb = u.pm * 4 + ai * 2 + wr;
                f32x4 ug[4], uv[4];
#pragma unroll
                for (int m = 0; m < 4; ++m) { ug[m] = acc[ai][0][m][n] * rs8[ai][m]; uv[m] = acc[ai][1][m][n] * rs8[ai][m]; }
                {   const bool tail = (fr == 15);
                    const f32x4 g0 = tail ? ug[2] : ug[0], g1 = tail ? ug[3] : ug[1], v0 = tail ? uv[2] : uv[0], v1 = tail ? uv[3] : uv[1];
                    u32x2 q[4]; q[0].x = cvt_pk_bf16(g0[0], g0[1]); q[0].y = cvt_pk_bf16(g0[2], g0[3]); q[1].x = cvt_pk_bf16(g1[0], g1[1]); q[1].y = cvt_pk_bf16(g1[2], g1[3]);
                    q[2].x = cvt_pk_bf16(v0[0], v0[1]); q[2].y = cvt_pk_bf16(v0[2], v0[3]); q[3].x = cvt_pk_bf16(v1[0], v1[1]); q[3].y = cvt_pk_bf16(v1[2], v1[3]);
                    if (n == 0) {
#pragma unroll
                        for (int k = 0; k < 4; ++k) hk[ai][k] = q[k];
                    } else if (fr == 0 || tail) { bf16_t* hb2 = HT + ((size_t)kb * 4 + (tail ? 2 : 0)) * NUP + u.pn * 256 + chl;
                        *(u32x4*)hb2 = (u32x4){hk[ai][0].x, hk[ai][0].y, q[0].x, q[0].y}; *(u32x4*)(hb2 + NUP) = (u32x4){hk[ai][1].x, hk[ai][1].y, q[1].x, q[1].y};
                        *(u32x4*)(hb2 + 128) = (u32x4){hk[ai][2].x, hk[ai][2].y, q[2].x, q[2].y}; *(u32x4*)(hb2 + NUP + 128) = (u32x4){hk[ai][3].x, hk[ai][3].y, q[3].x, q[3].y}; } }
                f32x4 G[4], V[4];
                G[0] = bg + wg2 * ug[0];                               V[0] = bv + wv2 * uv[0];
                G[1] = bg + wg2 * ug[1] + wg1 * ug[0];                 V[1] = bv + wv2 * uv[1] + wv1 * uv[0];
                G[2] = bg + wg2 * ug[2] + wg1 * ug[1] + wg0 * ug[0];   V[2] = bv + wv2 * uv[2] + wv1 * uv[1] + wv0 * uv[0];
                G[3] = bg + wg2 * ug[3] + wg1 * ug[2] + wg0 * ug[1];   V[3] = bv + wv2 * uv[3] + wv1 * uv[2] + wv0 * uv[1];
                conv_wrap(G[0], G[1], ug[2], ug[3], wg1, wg0); conv_wrap(V[0], V[1], uv[2], uv[3], wv1, wv0);
#pragma unroll
                for (int m = 0; m < 4; ++m) { float o[4];
#pragma unroll
                    for (int e = 0; e < 4; ++e) o[e] = silu_fast(G[m][e]) * V[m][e];
                    u32x2 w; w.x = cvt_pk_bf16(o[0], o[1]); w.y = cvt_pk_bf16(o[2], o[3]);
                    if (n == 0) keep[ai][m] = w; else st16_wt(AB + (size_t)(row0 + ai * HALF + m) * DFF + ch0, (u32x4){keep[ai][m].x, keep[ai][m].y, w.x, w.y}); }
            }
        }
    }
};
struct EpiSoftmax {
    static constexpr bool PERM = true, AFTER_DRAIN = true, PREFILL = true, ROWPERM = false; static constexpr int NST = 0;
    __device__ __forceinline__ void prefill(int tid) const { rstd_table_fill(ss, tid); }
    bf16_t* P; const float* ss;
    __device__ __forceinline__ void fused(f32x4 (&acc)[2][2][4][2], const Unit& u, int wr, int wc, int fr, int fq, LAS unsigned char* lds, int wid, int lane) const {
        LAS float* MX = (LAS float*)lds; LAS float* SM = MX + 1024;
        const int rl0 = wr * 64 + fr, row0 = u.pm * BM + rl0;
        float rs8[2][4]; rstd8_tab(ss, u, wr, fr, fq, rs8);
#pragma unroll
        for (int ai = 0; ai < 2; ++ai)
#pragma unroll
            for (int m = 0; m < 4; ++m) { const float rs = rs8[ai][m]; float mx = -INFINITY;
#pragma unroll
                for (int bj = 0; bj < 2; ++bj)
#pragma unroll
                    for (int n = 0; n < 2; ++n) { f32x4 v = acc[ai][bj][m][n] * rs; acc[ai][bj][m][n] = v; mx = fmaxf(fmaxf(mx, fmaxf(v[0], v[1])), fmaxf(v[2], v[3])); }
                mx = fmaxf(mx, shx(mx, 16, lane)); mx = fmaxf(mx, shx(mx, 32, lane));
                if (fq == 0) MX[(rl0 + ai * HALF + m * 16) * 4 + wc] = mx; }
        asm volatile("s_waitcnt lgkmcnt(0)" ::: "memory"); __builtin_amdgcn_s_barrier(); asm volatile("" ::: "memory");
#pragma unroll
        for (int ai = 0; ai < 2; ++ai)
#pragma unroll
            for (int m = 0; m < 4; ++m) { const f32x4 q = *(const LAS f32x4*)(MX + (rl0 + ai * HALF + m * 16) * 4); const float mx = fmaxf(fmaxf(q[0], q[1]), fmaxf(q[2], q[3])), mxL = mx * 1.44269504088896341f; float sm = 0.f;
#pragma unroll
                for (int bj = 0; bj < 2; ++bj)
#pragma unroll
                    for (int n = 0; n < 2; ++n) { f32x4 v = acc[ai][bj][m][n];
#pragma unroll
                        for (int e = 0; e < 4; ++e) { v[e] = exp_sub(v[e], mxL); sm += v[e]; }
                        acc[ai][bj][m][n] = v; }
                sm += shx(sm, 16, lane); sm += shx(sm, 32, lane);
                if (fq == 0) SM[(rl0 + ai * HALF + m * 16) * 4 + wc] = sm; }
        asm volatile("s_waitcnt lgkmcnt(0)" ::: "memory"); __builtin_amdgcn_s_barrier(); asm volatile("" ::: "memory");
        const int cl = u.pn * BM + wc * 32 + 8 * fq;
#pragma unroll
        for (int ai = 0; ai < 2; ++ai)
#pragma unroll
            for (int m = 0; m < 4; ++m) { const f32x4 q = *(const LAS f32x4*)(SM + (rl0 + ai * HALF + m * 16) * 4); const float inv = 1.f / ((q[0] + q[1]) + (q[2] + q[3]));
                bf16_t* rowp = P + (size_t)(row0 + ai * HALF + m * 16) * NSC + cl;
#pragma unroll
                for (int bj = 0; bj < 2; ++bj) { const f32x4 v0 = acc[ai][bj][m][0] * inv, v1 = acc[ai][bj][m][1] * inv;
                    u32x4 w; w.x = cvt_pk_bf16(v0[0], v0[1]); w.y = cvt_pk_bf16(v0[2], v0[3]); w.z = cvt_pk_bf16(v1[0], v1[1]); w.w = cvt_pk_bf16(v1[2], v1[3]);
                    st16_wt(rowp + bj * HALF, w); } }
    }
};
}

#define XB_TMO      128
#define XB_XCNT(j)  (256  + 64 * (j))
#define XB_XSUB(j)  (1280 + 64 * (j))
#define XB_XGEN(j)  (2304 + 64 * (j))
#define XB_TOP      3328
#define XB_TOPGEN   3392
#define XCD_BAR_WORDS 3456
#define XB_SPIN_CAP (1u << 18)
__device__ __forceinline__ unsigned xb_ld(unsigned* p)              { return __hip_atomic_load(p, __ATOMIC_RELAXED, __HIP_MEMORY_SCOPE_AGENT); }
__device__ __forceinline__ unsigned xb_add(unsigned* p, unsigned v) { return __hip_atomic_fetch_add(p, v, __ATOMIC_RELAXED, __HIP_MEMORY_SCOPE_AGENT); }
__device__ __forceinline__ unsigned xb_xcc_id() { return (unsigned)__builtin_amdgcn_s_getreg((3 << 11) | 20) & 0xFu; }
#define XB_SPIN(cond, bar) do { unsigned _sp = 0; while (cond) { __builtin_amdgcn_s_sleep(1); \
    if ((++_sp & 255u) == 0u) { if (xb_ld(&(bar)[XB_TMO])) break; if (_sp > XB_SPIN_CAP) { atomicAdd(&(bar)[XB_TMO], 1u); break; } } } } while (0)
struct XcdBarrier { unsigned* bar; unsigned x; volatile LAS unsigned* st; };
__device__ __forceinline__ XcdBarrier xcd_barrier_post(unsigned* bar, volatile LAS unsigned* st) {
    XcdBarrier b; b.bar = bar; b.x = xb_xcc_id(); b.st = st;
    if (threadIdx.x == 0) (void)xb_add(&bar[XB_XCNT(b.x)], 1u);
    return b;
}
__device__ __forceinline__ void xcd_barrier_complete(unsigned* bar, unsigned x, unsigned& nloc, unsigned& nx) {
    const unsigned G = gridDim.x * gridDim.y * gridDim.z;
    unsigned sum, cnt, mine, sp = 0u;
    for (;;) {
        sum = 0u; cnt = 0u; mine = 0u;
#pragma unroll
        for (unsigned j = 0; j < 16; ++j) { const unsigned c = xb_ld(&bar[XB_XCNT(j)]); sum += c; cnt += (c > 0u) ? 1u : 0u; mine = (j == x) ? c : mine; }
        if (sum == G) break;
        __builtin_amdgcn_s_sleep(1);
        if ((++sp & 255u) == 0u) { if (xb_ld(&bar[XB_TMO])) break; if (sp > XB_SPIN_CAP) { atomicAdd(&bar[XB_TMO], 1u); break; } }
    }
    nloc = mine > 0u ? mine : 1u; nx = cnt > 0u ? cnt : 1u;
}
__device__ __forceinline__ void xcd_barrier(const XcdBarrier& b) {
    asm volatile("s_waitcnt vmcnt(0)" ::: "memory");
    __syncthreads();
    if (threadIdx.x == 0) {
        unsigned* bar = b.bar;
        __builtin_amdgcn_s_waitcnt(0);
        unsigned nloc = b.st[0], nx = b.st[1];
        if (nloc == 0u) { xcd_barrier_complete(bar, b.x, nloc, nx); b.st[0] = nloc; b.st[1] = nx; }
        const unsigned old = xb_add(&bar[XB_XSUB(b.x)], 1u);
        const unsigned gen = old / nloc;
        if (old + 1u == (gen + 1u) * nloc) {
            __builtin_amdgcn_fence(__ATOMIC_RELEASE, "agent");
            asm volatile("s_waitcnt vmcnt(0)" ::: "memory");
            const unsigned og = xb_add(&bar[XB_TOP], 1u);
            const unsigned tg = og / nx;
            if (og + 1u == (tg + 1u) * nx) xb_add(&bar[XB_TOPGEN], 1u);
            else XB_SPIN(xb_ld(&bar[XB_TOPGEN]) == tg, bar);
            __builtin_amdgcn_fence(__ATOMIC_ACQUIRE, "agent");
            xb_add(&bar[XB_XGEN(b.x)], 1u);
            asm volatile("s_waitcnt vmcnt(0)" ::: "memory");
        } else {
            XB_SPIN(xb_ld(&bar[XB_XGEN(b.x)]) == gen, bar);
            __builtin_amdgcn_fence(__ATOMIC_ACQUIRE, "agent");
            asm volatile("s_waitcnt vmcnt(0)" ::: "memory");
        }
    }
    __syncthreads();
}

struct Args { const void* in[23]; float* out; unsigned char* ws; int ph_lo, ph_hi; };
struct Frame {
    LAS unsigned char* lds; unsigned char* ws;
    int tid, lane, wave, G, bid;
};
__device__ __forceinline__ const void* in_ptr(int k) {
    const __attribute__((address_space(4))) char* kp = (const __attribute__((address_space(4))) char*)__builtin_amdgcn_kernarg_segment_ptr();
    asm volatile("" : "+s"(kp));
    return *(const void* const __attribute__((address_space(4)))*)(kp + 8 * k);
}
__device__ __forceinline__ unsigned char* ws_ptr() {
    const __attribute__((address_space(4))) char* kp = (const __attribute__((address_space(4))) char*)__builtin_amdgcn_kernarg_segment_ptr();
    asm volatile("" : "+s"(kp));
    return *(unsigned char* const __attribute__((address_space(4)))*)(kp + 8 * 24);
}
template <class Tp> __device__ __forceinline__ Tp* wsp(const Frame& F, size_t off) { return (Tp*)(F.ws + off); }
__device__ __forceinline__ float* ss_ptr(const Frame& F, int idx) { return (float*)(F.ws + WS_SSP) + (size_t)idx * T * 32; }

struct BlkDesc { const float* src; bf16_t* dst; const float* g; int ldw, K; };
constexpr int NA_IN = 32 * 68, NA_22 = 32 * 32, NA_UP = 32 * 176, NA_DN = 88 * 32, NA = NA_IN + NA_22 + NA_UP + NA_DN, NB = 3 * NA_22;
constexpr int NA_HEAD = NA_IN + NA_22, CV_T = NA_HEAD + 5100;
__device__ __forceinline__ BlkDesc desc_a(const Frame& F, int l, int r) {
    BlkDesc d;
    if (r < NA_IN) {
        const int kb = r / 68, nb = r % 68, sc0 = nb < 24 ? 64 * nb : 1552 + 64 * (nb - 24), dr0 = nb < 24 ? 64 * nb : 1792 + 64 * (nb - 24);
        d.src = (const float*)in_ptr(4) + (size_t)l * D * NIN + (size_t)(64 * kb) * NIN + sc0; d.dst = wsp<bf16_t>(F, WS_WIN + l * SZ_WIN) + (size_t)dr0 * D + 64 * kb; d.g = (const float*)in_ptr(3) + l * D + 64 * kb; d.ldw = NIN; d.K = D; return d; }
    r -= NA_IN;
    if (r < NA_22) { const int kb = r / 32, nb = r % 32;
        d.src = (const float*)in_ptr(10) + (size_t)l * D * D + (size_t)(64 * kb) * D + 64 * nb; d.dst = wsp<bf16_t>(F, WS_WOUT + l * SZ_W22) + (size_t)(64 * nb) * D + 64 * kb; d.g = nullptr; d.ldw = D; d.K = D; return d; }
    r -= NA_22;
    if (r < NA_UP) { const int kb = r / 176, nb = r % 176, c = 64 * nb, bj = c >= DFF ? 1 : 0, ch = c - DFF * bj, dr0 = 256 * (ch >> 7) + 128 * bj + (ch & 127);
        d.src = (const float*)in_ptr(18) + (size_t)l * D * NUP + (size_t)(64 * kb) * NUP + c; d.dst = wsp<bf16_t>(F, WS_WUP + l * SZ_WUP) + (size_t)dr0 * D + 64 * kb; d.g = (const float*)in_ptr(17) + l * D + 64 * kb; d.ldw = NUP; d.K = D; return d; }
    r -= NA_UP;
    { const int kb = r / 32, nb = r % 32;
        d.src = (const float*)in_ptr(21) + (size_t)l * DFF * D + (size_t)(64 * kb) * D + 64 * nb; d.dst = wsp<bf16_t>(F, WS_WDN + l * SZ_WDN) + (size_t)(64 * nb) * DFF + 64 * kb; d.g = nullptr; d.ldw = D; d.K = DFF; return d; }
}
__device__ __forceinline__ BlkDesc desc_b(const Frame& F, int l, int r) {
    BlkDesc d; const int w = r / NA_22, q = r % NA_22, kb = q / 32, nb = q % 32;
    d.src = (const float*)(w == 0 ? in_ptr(14) : w == 1 ? in_ptr(15) : in_ptr(16)) + (size_t)l * D * D + (size_t)(64 * kb) * D + 64 * nb;
    d.dst = wsp<bf16_t>(F, (w == 0 ? WS_WK : w == 1 ? WS_WV : WS_WO) + l * SZ_W22) + (size_t)(64 * nb) * D + 64 * kb; d.g = nullptr; d.ldw = D; d.K = D; return d;
}
__device__ __forceinline__ void blk_load(const BlkDesc& d, f32x4 (&v)[16], int lane) {
    const float* p = d.src + (size_t)(lane >> 4) * d.ldw + 4 * (lane & 15);
#pragma unroll
    for (int i = 0; i < 16; ++i) v[i] = __builtin_nontemporal_load((const f32x4*)(p + (size_t)(4 * i) * d.ldw));
}
__device__ __forceinline__ void blk_to_lds(const BlkDesc& d, const f32x4 (&v)[16], LAS float* scr, int lane) {
    const int kr = lane >> 4, cg = lane & 15;
#pragma unroll
    for (int i = 0; i < 16; ++i) { const int k = 4 * i + kr; f32x4 x = v[i]; if (d.g) x = x * d.g[k]; *(LAS f32x4*)(scr + k * 64 + ((cg ^ (k >> 3)) << 2)) = x; }
    LDS_WAIT(); asm volatile("" ::: "memory");
}
template <bool NTS> __device__ __forceinline__ void blk_store(const BlkDesc& d, LAS float* scr, int lane) {
    const int n0 = lane >> 3, c = lane & 7;
#pragma unroll
    for (int j = 0; j < 8; ++j) { const int n = n0 + 8 * j; const LAS float* sp = scr + (8 * c) * 64 + ((((n >> 2) ^ c) << 2) | (n & 3));
        u32x4 o; o.x = pk2(sp[0 * 64], sp[1 * 64]); o.y = pk2(sp[2 * 64], sp[3 * 64]); o.z = pk2(sp[4 * 64], sp[5 * 64]); o.w = pk2(sp[6 * 64], sp[7 * 64]);
        if constexpr (NTS) __builtin_nontemporal_store(o, (u32x4*)(d.dst + (size_t)n * d.K + 8 * c)); else *(u32x4*)(d.dst + (size_t)n * d.K + 8 * c) = o; }
    LDS_WAIT(); asm volatile("" ::: "memory");
}
template <bool TYPE_B, bool NTS = false> __device__ __forceinline__ void convert_blocks(const Frame& F, int l, int lo, int hi, int wv, int nw) {
    LAS float* scr = (LAS float*)(F.lds + F.wave * 16384); const int lane = F.lane;
    int it = lo + wv; if (it >= hi) return;
    f32x4 v[16]; BlkDesc d = TYPE_B ? desc_b(F, l, it) : desc_a(F, l, it); blk_load(d, v, lane);
    for (;;) {
        blk_to_lds(d, v, scr, lane);
        const int itn = it + nw; const bool hn = itn < hi; BlkDesc dn = d;
        if (hn) { dn = TYPE_B ? desc_b(F, l, itn) : desc_a(F, l, itn); blk_load(dn, v, lane); }
        blk_store<NTS>(d, scr, lane);
        if (!hn) break;
        it = itn; d = dn;
    }
}
__device__ __forceinline__ void fold_gate_item(const Frame& F, int l, int item) {
    LAS float* scr = (LAS float*)(F.lds + F.wave * 16384);
    const int kb = item >> 2, cq = item & 3, lane = F.lane, k = 64 * kb + lane; const float* wrow = (const float*)in_ptr(4) + ((size_t)l * D + k) * NIN + 1536;
    {   const float* wg = (const float*)in_ptr(5) + (size_t)l * 16 * 256 + (lane >> 2) * 256 + 64 * cq + 16 * (lane & 3); LAS float* dp = scr + (lane >> 2) * 64 + 16 * (lane & 3);
#pragma unroll
        for (int q = 0; q < 4; ++q) *(LAS f32x4*)(dp + 4 * q) = *(const f32x4*)(wg + 4 * q); }
    const f32x4 l0 = *(const f32x4*)wrow, l1 = *(const f32x4*)(wrow + 4), l2 = *(const f32x4*)(wrow + 8), l3 = *(const f32x4*)(wrow + 12);
    const float lr[16] = {l0[0], l0[1], l0[2], l0[3], l1[0], l1[1], l1[2], l1[3], l2[0], l2[1], l2[2], l2[3], l3[0], l3[1], l3[2], l3[3]};
    const float gk = ((const float*)in_ptr(3))[l * D + k]; bf16_t* WT = wsp<bf16_t>(F, WS_WIN + l * SZ_WIN) + (size_t)(1536 + 64 * cq) * D + k;
    LDS_WAIT(); asm volatile("" ::: "memory");
#pragma unroll 1
    for (int cc = 0; cc < 4; ++cc) { float a[16];
#pragma unroll
        for (int j = 0; j < 16; ++j) a[j] = 0.f;
#pragma unroll
        for (int r = 0; r < 16; ++r) { const LAS f32x4* wp = (const LAS f32x4*)(scr + r * 64 + 16 * cc); const f32x4 w0 = wp[0], w1 = wp[1], w2 = wp[2], w3 = wp[3];
            a[0] += lr[r] * w0[0]; a[1] += lr[r] * w0[1]; a[2] += lr[r] * w0[2]; a[3] += lr[r] * w0[3]; a[4] += lr[r] * w1[0]; a[5] += lr[r] * w1[1]; a[6] += lr[r] * w1[2]; a[7] += lr[r] * w1[3];
            a[8] += lr[r] * w2[0]; a[9] += lr[r] * w2[1]; a[10] += lr[r] * w2[2]; a[11] += lr[r] * w2[3]; a[12] += lr[r] * w3[0]; a[13] += lr[r] * w3[1]; a[14] += lr[r] * w3[2]; a[15] += lr[r] * w3[3];
            asm volatile("" ::: "memory"); }
#pragma unroll
        for (int j = 0; j < 16; ++j) WT[(size_t)(16 * cc + j) * D] = (bf16_t)f2bf(a[j] * gk); }
    LDS_WAIT(); asm volatile("" ::: "memory");
}
__device__ __forceinline__ void convert_slot(const Frame& F, int l, int lo, int hi, bool fold, int rank, int nr) {
    if (rank < 0 || rank >= nr) return;
    convert_blocks<false>(F, l, lo, hi, rank * 8 + F.wave, nr * 8);
    if (fold) for (int it = rank * 8 + F.wave; it < 128; it += nr * 8) fold_gate_item(F, l, it);
}
__device__ __forceinline__ void sincos_acc(float ang, float& c, float& s) {
    const double a = (double)ang; const double k = rint(a * 0.63661977236758134308);
    double r = fma(-k, 1.57079632679489655800, a); r = fma(-k, 6.12323399573676603587e-17, r);
    const float x = (float)r, x2 = x * x;
    const float sp = x + x * x2 * (-1.6666654611e-1f + x2 * (8.3321608736e-3f + x2 * (-1.9515295891e-4f)));
    const float cp = 1.f - 0.5f * x2 + x2 * x2 * (4.166664568298827e-2f + x2 * (-1.388731625493765e-3f + x2 * 2.443315711809948e-5f));
    const int q = ((int)k) & 3;
    c = (q == 0) ? cp : (q == 1) ? -sp : (q == 2) ? -cp : sp;
    s = (q == 0) ? sp : (q == 1) ? cp : (q == 2) ? -sp : -cp;
}
__device__ __forceinline__ void p_prologue(Frame& F, const Args& A) {
    const int gw = F.bid * 8 + F.wave, NGW = F.G * 8, lane = F.lane;
    const float* x = (const float*)in_ptr(0); const float* mem = (const float*)in_ptr(1); const int* pos = (const int*)in_ptr(2);
    convert_blocks<false, false>(F, 0, 0, NA_HEAD, gw, NGW);
    for (int l = 0; l < NL; ++l) convert_blocks<true, true>(F, l, 0, NB, gw, NGW);
    for (int it = gw; it < NL * D; it += NGW) { const int l = it / D, k = it % D; const float g = ((const float*)in_ptr(11))[l * D + k];
        const f32x4* src = (const f32x4*)((const float*)in_ptr(13) + ((size_t)l * D + k) * D) + lane; u32x2* dst = (u32x2*)(wsp<bf16_t>(F, WS_WQP + l * SZ_W22) + (size_t)k * D) + lane;
#pragma unroll
        for (int j = 0; j < 8; ++j) { const f32x4 v = __builtin_nontemporal_load(src + 64 * j) * g; u32x2 o; o.x = pk2(v[0], v[1]); o.y = pk2(v[2], v[3]); __builtin_nontemporal_store(o, dst + 64 * j); } }
    for (int it = gw; it < 128; it += NGW) fold_gate_item(F, 0, it);
    { float* ss0 = ss_ptr(F, 0); bf16_t* hb = wsp<bf16_t>(F, WS_HB);
      for (int m = gw; m < T; m += NGW) { const f32x4* xr = (const f32x4*)(x + (size_t)m * D) + lane; u32x2* o = (u32x2*)(hb + (size_t)m * D) + lane; float s = 0.f;
#pragma unroll
          for (int j = 0; j < 8; ++j) { const f32x4 v = __builtin_nontemporal_load(xr + 64 * j); s += (v[0] * v[0] + v[1] * v[1]) + (v[2] * v[2] + v[3] * v[3]); u32x2 w; w.x = pk2(v[0], v[1]); w.y = pk2(v[2], v[3]); o[64 * j] = w; }
          s = wave_sum(s, lane); if (lane < 32) ss0[(size_t)m * 32 + lane] = (lane == 0) ? s : 0.f; } }
    for (int it = gw; it < NL * NMEM; it += NGW) { const int l = it / NMEM, m = it % NMEM; const f32x4* xr = (const f32x4*)(mem + (size_t)m * D) + lane; const f32x4* gr = (const f32x4*)((const float*)in_ptr(12) + l * D) + lane;
        f32x4 v[8]; float s = 0.f;
#pragma unroll
        for (int j = 0; j < 8; ++j) { v[j] = xr[64 * j]; s += (v[j][0] * v[j][0] + v[j][1] * v[j][1]) + (v[j][2] * v[j][2] + v[j][3] * v[j][3]); }
        const float rs = rsqrtf(wave_sum(s, lane) * (1.f / D) + EPS); u32x2* o = (u32x2*)(wsp<bf16_t>(F, WS_MEMN + l * SZ_MEM) + (size_t)m * D) + lane;
#pragma unroll
        for (int j = 0; j < 8; ++j) { const f32x4 g = gr[64 * j]; u32x2 w; w.x = pk2(v[j][0] * rs * g[0], v[j][1] * rs * g[1]); w.y = pk2(v[j][2] * rs * g[2], v[j][3] * rs * g[3]); o[64 * j] = w; } }
    { float* ct = wsp<float>(F, WS_ROPE); float* st = ct + T * 32;
      for (int i = F.bid * 512 + F.tid; i < T * 32; i += F.G * 512) { const int t = i >> 5, j = i & 31; const float inv = 1.0f / powf(10000.0f, (float)(2 * j) / 64.0f); const float ang = (float)pos[t] * inv;
          float c, s; sincos_acc(ang, c, s); ct[i] = c; st[i] = s; } }
}

struct KVOrder {
    unsigned char* ws; int G, c;
    __device__ __forceinline__ bool next(int i, pg8::Unit& u) const {
        const int L = i * G + c; if (L >= 64) return false;
        const int b = L >> 3, pn = L & 7, l = b >> 1, kv = b & 1;
        u.pm = 0; u.pn = pn; u.a = (const char*)(ws + WS_MEMN + l * SZ_MEM); u.b = (const char*)(ws + (kv ? WS_WV : WS_WK) + l * SZ_W22 + (size_t)pn * 256 * D * 2);
        u.o = (char*)(ws + (kv ? WS_VMEM : WS_KMEM) + l * SZ_MEM); u.ldc = D; u.sc = 1.f; return true; }
    __device__ __forceinline__ void a_ready(const pg8::Unit&) const {}
    __device__ __forceinline__ void done(const pg8::Unit&) const {}
};
struct FoldOrder {
    unsigned char* ws; int G, c;
    __device__ __forceinline__ bool next(int i, pg8::Unit& u) const {
        int L = i * G + c; if (L >= 256) return false;
        if (L < 128) { const int b = L >> 3, pn = L & 7, l = b >> 2, hd = b & 3;
            u.pm = 0; u.pn = pn; u.a = (const char*)(ws + WS_KMEM + l * SZ_MEM + 512 * hd * 2); u.b = (const char*)(ws + WS_WQP + l * SZ_W22 + 512 * hd * 2 + (size_t)pn * 256 * D * 2);
            u.o = (char*)(ws + WS_WST + l * SZ_WS + (size_t)256 * hd * D * 2); u.ldc = D; u.sc = 0.044194173824159216f; }
        else { L -= 128; const int b = L >> 3, pm = L & 7, l = b >> 2, hd = b & 3;
            u.pm = pm; u.pn = 0; u.a = (const char*)(ws + WS_WO + l * SZ_W22 + 512 * hd * 2 + (size_t)pm * 256 * D * 2); u.b = (const char*)(ws + WS_VMEM + l * SZ_MEM + 512 * hd * 2);
            u.o = (char*)(ws + WS_VWT + l * SZ_WS + 256 * hd * 2); u.ldc = NSC; u.sc = 1.f; }
        return true; }
    __device__ __forceinline__ void a_ready(const pg8::Unit&) const {}
    __device__ __forceinline__ void done(const pg8::Unit&) const {}
};

__device__ __forceinline__ void gla_cumsum(const Frame& F, const float* la, int t0, int h, LAS float* tot, float (&c)[8]) {
    const int w = F.wave, d = F.lane; float run = 0.f;
#pragma unroll
    for (int i = 0; i < 8; ++i) { run += la[(size_t)(t0 + 8 * w + i) * 256 + h * 64 + d]; c[i] = run; }
    tot[w * 64 + d] = run;
    __syncthreads();
    float off = 0.f;
#pragma unroll
    for (int j = 0; j < 8; ++j) off += (j < w) ? tot[j * 64 + d] : 0.f;
#pragma unroll
    for (int i = 0; i < 8; ++i) c[i] += off;
}
__device__ __forceinline__ void gla_local(Frame& F, int unit) {
    const int h = unit >> 7, ck = unit & 127, t0 = ck * 64, w = F.wave, lane = F.lane, tid = F.tid;
    const bf16_t* z = wsp<bf16_t>(F, WS_Z); const float* la = wsp<float>(F, WS_LA);
    LAS float* tot = (LAS float*)F.lds; LAS float* khat = tot + 512; LAS float* vt = khat + 64 * 64;
    float c[8]; gla_cumsum(F, la, t0, h, tot, c);
    float total = 0.f;
#pragma unroll
    for (int j = 0; j < 8; ++j) total += tot[j * 64 + lane];
#pragma unroll
    for (int i = 0; i < 8; ++i) { const int t = 8 * w + i; const float k = bf2f(z[(size_t)(t0 + t) * NZ + ZK + h * 64 + lane]); khat[t * 64 + lane] = k * __expf(total - c[i]); }
#pragma unroll
    for (int j = 0; j < 2; ++j) { const int idx = tid + 512 * j, t = idx >> 4, ch = idx & 15; const u32x4 r = *(const u32x4*)(z + (size_t)(t0 + t) * NZ + ZV + h * 128 + ch * 8);
        LAS float* p = vt + t * 128 + ch * 8;
        p[0] = bf2f(r.x & 0xffffu); p[1] = bf2f(r.x >> 16); p[2] = bf2f(r.y & 0xffffu); p[3] = bf2f(r.y >> 16); p[4] = bf2f(r.z & 0xffffu); p[5] = bf2f(r.z >> 16); p[6] = bf2f(r.w & 0xffffu); p[7] = bf2f(r.w >> 16); }
    if (w == 0) wsp<float>(F, WS_DEC)[(size_t)unit * 64 + lane] = __expf(total);
    __syncthreads();
    const int e = tid & 127, dg = tid >> 7;
    float acc[16];
#pragma unroll
    for (int j = 0; j < 16; ++j) acc[j] = 0.f;
    for (int t = 0; t < 64; ++t) { const float v = vt[t * 128 + e];
#pragma unroll
        for (int j = 0; j < 16; ++j) acc[j] += v * khat[t * 64 + 16 * dg + j]; }
    float* U = wsp<float>(F, WS_UB) + (size_t)unit * 8192;
#pragma unroll
    for (int j = 0; j < 16; ++j) U[(16 * dg + j) * 128 + e] = acc[j];
    __syncthreads();
}
__device__ __forceinline__ void gla_scan4(Frame& F) {
    LAS f32x2* AB = (LAS f32x2*)F.lds;
    const int per = (4 * 8192 + F.G - 1) / F.G, seg = F.wave >> 1, el = ((F.wave & 1) << 6) | F.lane;
    for (int e0 = 0; e0 < per; e0 += 128) {
        const int e = e0 + el, gid = F.bid * per + e; const bool act = (e < per) && (gid < 4 * 8192);
        const int gidc = act ? gid : 0, h = gidc >> 13, rem = gidc & 8191, d = rem >> 7;
        const float* __restrict__ U = wsp<float>(F, WS_UB) + (size_t)h * 128 * 8192 + rem + (size_t)(32 * seg) * 8192; const float* __restrict__ dec = wsp<float>(F, WS_DEC) + (size_t)h * 128 * 64 + d + (32 * seg) * 64;
        bf16_t* __restrict__ Sb = wsp<bf16_t>(F, WS_SB) + (size_t)h * 128 * 8192 + rem + (size_t)(32 * seg) * 8192;
        float u[32], dd[32];
#pragma unroll
        for (int i = 0; i < 32; ++i) { u[i] = U[(size_t)i * 8192]; dd[i] = dec[i * 64]; }
        float S = 0.f, P = 1.f;
#pragma unroll
        for (int i = 0; i < 32; ++i) { const float un = u[i], dn = dd[i]; u[i] = S; dd[i] = P; S = S * dn + un; P = P * dn; }
        AB[seg * 128 + el] = (f32x2){P, S};
        __syncthreads();
        float Sin = 0.f;
#pragma unroll
        for (int j = 0; j < 3; ++j) { if (j < seg) { const f32x2 ab = AB[j * 128 + el]; Sin = Sin * ab.x + ab.y; } }
        if ((e0 + el < per) && (F.bid * per + e0 + el < 4 * 8192)) {
#pragma unroll
            for (int i = 0; i < 32; ++i) Sb[(size_t)i * 8192] = (bf16_t)f2bf(u[i] + dd[i] * Sin); }
        __syncthreads();
    }
}
__device__ __forceinline__ void gla_scan(Frame& F) {
    const int per = (4 * 8192 + F.G - 1) / F.G;
    for (int e = F.tid; e < per; e += 128) { const int gid = F.bid * per + e; if (gid >= 4 * 8192) break;
        const int h = gid >> 13, rem = gid & 8191, d = rem >> 7;
        const float* __restrict__ U = wsp<float>(F, WS_UB) + (size_t)h * 128 * 8192 + rem; const float* __restrict__ dec = wsp<float>(F, WS_DEC) + (size_t)h * 128 * 64 + d; bf16_t* __restrict__ Sb = wsp<bf16_t>(F, WS_SB) + (size_t)h * 128 * 8192 + rem;
        float S = 0.f;
#pragma unroll 1
        for (int b = 0; b < 4; ++b) { float u[32], dd[32];
#pragma unroll
            for (int i = 0; i < 32; ++i) { u[i] = U[(size_t)(32 * b + i) * 8192]; dd[i] = dec[(32 * b + i) * 64]; }
#pragma unroll
            for (int i = 0; i < 32; ++i) { Sb[(size_t)(32 * b + i) * 8192] = (bf16_t)f2bf(S); S = S * dd[i] + u[i]; } }
    }
}
__device__ __forceinline__ void gla_out(Frame& F, const Args& A, int unit, int layer) {
    const int h = unit >> 7, ck = unit & 127, t0 = ck * 64, w = F.wave, lane = F.lane, tid = F.tid;
    const bf16_t* z = wsp<bf16_t>(F, WS_Z); const float* la = wsp<float>(F, WS_LA);
    LAS float* tot = (LAS float*)F.lds; LAS float* qtT = tot + 512; LAS float* qeT = qtT + 64 * 65; LAS float* attT = qeT + 64 * 65; LAS float* ktl = attT + 64 * 65;
    LAS float* red = ktl + 64 * 64; LAS bf16_t* vs = (LAS bf16_t*)(red + 512); LAS bf16_t* Ss = vs + 64 * 128;
    float c[8]; gla_cumsum(F, la, t0, h, tot, c);
    const float ref = tot[lane] + tot[64 + lane] + tot[128 + lane] + tot[192 + lane];
#pragma unroll
    for (int i = 0; i < 8; ++i) { const int t = 8 * w + i; const size_t zo = (size_t)(t0 + t) * NZ + h * 64 + lane;
        const float q = bf2f(z[zo + ZQ]) * 0.125f, k = bf2f(z[zo + ZK]);
        qtT[lane * 65 + t] = q * __expf(c[i] - ref); qeT[lane * 65 + t] = q * __expf(c[i]); ktl[t * 64 + lane] = k * __expf(ref - c[i]); }
#pragma unroll
    for (int j = 0; j < 2; ++j) { const int idx = tid + 512 * j, t = idx >> 4, ch = idx & 15;
        *(LAS u32x4*)(vs + t * 128 + ch * 8) = *(const u32x4*)(z + (size_t)(t0 + t) * NZ + ZV + h * 128 + ch * 8);
        *(LAS u32x4*)(Ss + t * 128 + ch * 8) = *(const u32x4*)(wsp<bf16_t>(F, WS_SB) + (size_t)unit * 8192 + t * 128 + ch * 8); }
    __syncthreads();
    {
        float a[8];
#pragma unroll
        for (int j = 0; j < 8; ++j) a[j] = 0.f;
        for (int d = 0; d < 64; ++d) { const float q = qtT[d * 65 + lane];
#pragma unroll
            for (int j = 0; j < 8; ++j) a[j] += q * ktl[(8 * w + j) * 64 + d]; }
#pragma unroll
        for (int j = 0; j < 8; ++j) attT[(8 * w + j) * 65 + lane] = (8 * w + j <= lane) ? a[j] : 0.f;
    }
    __syncthreads();
    float o[16];
#pragma unroll
    for (int j = 0; j < 16; ++j) o[j] = 0.f;
    for (int s = 0; s < 64; ++s) { const float a = attT[s * 65 + lane]; const u32x4 v0 = *(const LAS u32x4*)(vs + s * 128 + 16 * w), v1 = *(const LAS u32x4*)(vs + s * 128 + 16 * w + 8);
        o[0] += a * bf2f(v0.x & 0xffffu); o[1] += a * bf2f(v0.x >> 16); o[2] += a * bf2f(v0.y & 0xffffu); o[3] += a * bf2f(v0.y >> 16);
        o[4] += a * bf2f(v0.z & 0xffffu); o[5] += a * bf2f(v0.z >> 16); o[6] += a * bf2f(v0.w & 0xffffu); o[7] += a * bf2f(v0.w >> 16);
        o[8] += a * bf2f(v1.x & 0xffffu); o[9] += a * bf2f(v1.x >> 16); o[10] += a * bf2f(v1.y & 0xffffu); o[11] += a * bf2f(v1.y >> 16);
        o[12] += a * bf2f(v1.z & 0xffffu); o[13] += a * bf2f(v1.z >> 16); o[14] += a * bf2f(v1.w & 0xffffu); o[15] += a * bf2f(v1.w >> 16); }
    for (int d = 0; d < 64; ++d) { const float a = qeT[d * 65 + lane]; const u32x4 v0 = *(const LAS u32x4*)(Ss + d * 128 + 16 * w), v1 = *(const LAS u32x4*)(Ss + d * 128 + 16 * w + 8);
        o[0] += a * bf2f(v0.x & 0xffffu); o[1] += a * bf2f(v0.x >> 16); o[2] += a * bf2f(v0.y & 0xffffu); o[3] += a * bf2f(v0.y >> 16);
        o[4] += a * bf2f(v0.z & 0xffffu); o[5] += a * bf2f(v0.z >> 16); o[6] += a * bf2f(v0.w & 0xffffu); o[7] += a * bf2f(v0.w >> 16);
        o[8] += a * bf2f(v1.x & 0xffffu); o[9] += a * bf2f(v1.x >> 16); o[10] += a * bf2f(v1.y & 0xffffu); o[11] += a * bf2f(v1.y >> 16);
        o[12] += a * bf2f(v1.z & 0xffffu); o[13] += a * bf2f(v1.z >> 16); o[14] += a * bf2f(v1.w & 0xffffu); o[15] += a * bf2f(v1.w >> 16); }
    float p = 0.f;
#pragma unroll
    for (int j = 0; j < 16; ++j) p += o[j] * o[j];
    red[w * 64 + lane] = p;
    __syncthreads();
    float sq = 0.f;
#pragma unroll
    for (int j = 0; j < 8; ++j) sq += red[j * 64 + lane];
    const float rs = rsqrtf(sq * (1.f / 128.f) + EPS);
    const float* gn = (const float*)in_ptr(7) + layer * 128 + 16 * w; const size_t zr = (size_t)(t0 + lane) * NZ + ZR + h * 128 + 16 * w;
    const u32x4 r0 = *(const u32x4*)(z + zr), r1 = *(const u32x4*)(z + zr + 8);
    const unsigned rr[8] = {r0.x, r0.y, r0.z, r0.w, r1.x, r1.y, r1.z, r1.w};
    unsigned ow[8];
#pragma unroll
    for (int j = 0; j < 8; ++j) { const float g0 = bf2f(rr[j] & 0xffffu), g1 = bf2f(rr[j] >> 16);
        ow[j] = pk2(o[2 * j] * rs * gn[2 * j] * siluf(g0), o[2 * j + 1] * rs * gn[2 * j + 1] * siluf(g1)); }
    bf16_t* mx = wsp<bf16_t>(F, WS_MIX) + (size_t)(t0 + lane) * D + h * 128 + 16 * w;
    *(u32x4*)mx = (u32x4){ow[0], ow[1], ow[2], ow[3]}; *(u32x4*)(mx + 8) = (u32x4){ow[4], ow[5], ow[6], ow[7]};
    __syncthreads();
}

__device__ __forceinline__ void swa_unit(Frame& F, const Args& A, int unit, int layer) {
    const int g = unit & 7, n = (unit >> 3) & 63, j = unit >> 9, hq = 8 * j + g, tid = F.tid;
    const bf16_t* z = wsp<bf16_t>(F, WS_Z); const float* ct = wsp<float>(F, WS_ROPE); const float* st = ct + T * 32;
    LAS bf16_t* Ks = (LAS bf16_t*)F.lds; LAS bf16_t* Vs = Ks + 256 * 66; LAS float* red = (LAS float*)(Vs + 256 * 66);
    LAS float* ob = (LAS float*)F.lds;
    {
        const int row = tid >> 1, hf = tid & 1, tk = 128 * n - 128 + row;
        if (tk >= 0) {
            const bf16_t* kp = z + (size_t)tk * NZ + ZSK + j * 64; const bf16_t* vp = z + (size_t)tk * NZ + ZSV + j * 64;
            const u32x4 a0 = *(const u32x4*)(kp + 16 * hf), a1 = *(const u32x4*)(kp + 16 * hf + 8), b0 = *(const u32x4*)(kp + 32 + 16 * hf), b1 = *(const u32x4*)(kp + 32 + 16 * hf + 8);
            const unsigned x1[8] = {a0.x, a0.y, a0.z, a0.w, a1.x, a1.y, a1.z, a1.w}, x2[8] = {b0.x, b0.y, b0.z, b0.w, b1.x, b1.y, b1.z, b1.w};
#pragma unroll
            for (int q = 0; q < 8; ++q) { const int i0 = 16 * hf + 2 * q; const float c0 = ct[tk * 32 + i0], s0 = st[tk * 32 + i0], c1 = ct[tk * 32 + i0 + 1], s1 = st[tk * 32 + i0 + 1];
                const float u0 = bf2f(x1[q] & 0xffffu), u1 = bf2f(x1[q] >> 16), w0 = bf2f(x2[q] & 0xffffu), w1 = bf2f(x2[q] >> 16);
                *(LAS unsigned*)(Ks + row * 66 + i0) = pk2(u0 * c0 - w0 * s0, u1 * c1 - w1 * s1);
                *(LAS unsigned*)(Ks + row * 66 + 32 + i0) = pk2(w0 * c0 + u0 * s0, w1 * c1 + u1 * s1); }
            const u32x4 v0 = *(const u32x4*)(vp + 32 * hf), v1 = *(const u32x4*)(vp + 32 * hf + 8), v2 = *(const u32x4*)(vp + 32 * hf + 16), v3 = *(const u32x4*)(vp + 32 * hf + 24);
            const unsigned vv[16] = {v0.x, v0.y, v0.z, v0.w, v1.x, v1.y, v1.z, v1.w, v2.x, v2.y, v2.z, v2.w, v3.x, v3.y, v3.z, v3.w};
#pragma unroll
            for (int q = 0; q < 16; ++q) *(LAS unsigned*)(Vs + row * 66 + 32 * hf + 2 * q) = vv[q];
        } else {
#pragma unroll
            for (int q = 0; q < 16; ++q) { *(LAS unsigned*)(Ks + row * 66 + 32 * hf + 2 * q) = 0u; *(LAS unsigned*)(Vs + row * 66 + 32 * hf + 2 * q) = 0u; }
        }
    }
    const int r = tid & 127, part = tid >> 7, tq = 128 * n + r;
    float q[64];
    {   const bf16_t* qp = z + (size_t)tq * NZ + ZSQ + hq * 64;
#pragma unroll
        for (int c8 = 0; c8 < 4; ++c8) { const u32x4 a = *(const u32x4*)(qp + 8 * c8), b = *(const u32x4*)(qp + 32 + 8 * c8); const unsigned x1[4] = {a.x, a.y, a.z, a.w}, x2[4] = {b.x, b.y, b.z, b.w};
#pragma unroll
            for (int p = 0; p < 4; ++p) { const int i0 = 8 * c8 + 2 * p; const float c0 = ct[tq * 32 + i0], s0 = st[tq * 32 + i0], c1 = ct[tq * 32 + i0 + 1], s1 = st[tq * 32 + i0 + 1];
                const float u0 = bf2f(x1[p] & 0xffffu), u1 = bf2f(x1[p] >> 16), w0 = bf2f(x2[p] & 0xffffu), w1 = bf2f(x2[p] >> 16);
                q[i0] = (u0 * c0 - w0 * s0) * 0.125f; q[i0 + 1] = (u1 * c1 - w1 * s1) * 0.125f; q[32 + i0] = (w0 * c0 + u0 * s0) * 0.125f; q[32 + i0 + 1] = (w1 * c1 + u1 * s1) * 0.125f; } }
    }
    __syncthreads();
    float s[32]; float mx = -INFINITY;
#pragma unroll
    for (int kk = 0; kk < 32; ++kk) { const int ki = r + 1 + 32 * part + kk; const LAS unsigned* kr = (const LAS unsigned*)(Ks + ki * 66); float a = 0.f;
#pragma unroll
        for (int d2 = 0; d2 < 32; ++d2) { const unsigned kw = kr[d2]; a += q[2 * d2] * bf2f(kw & 0xffffu) + q[2 * d2 + 1] * bf2f(kw >> 16); }
        const bool valid = (n > 0) || (ki >= 128); s[kk] = valid ? a : -INFINITY; mx = fmaxf(mx, s[kk]); }
    red[part * 128 + r] = mx;
    __syncthreads();
    const float sink = ((const float*)in_ptr(8))[layer * 16 + hq];
    const float m = fmaxf(fmaxf(fmaxf(red[r], red[128 + r]), fmaxf(red[256 + r], red[384 + r])), sink);
    float sum = 0.f;
#pragma unroll
    for (int kk = 0; kk < 32; ++kk) { s[kk] = __expf(s[kk] - m); sum += s[kk]; }
    red[512 + part * 128 + r] = sum;
    __syncthreads();
    const float den = red[512 + r] + red[640 + r] + red[768 + r] + red[896 + r] + __expf(sink - m), inv = 1.f / den;
    float o[64];
#pragma unroll
    for (int e = 0; e < 64; ++e) o[e] = 0.f;
#pragma unroll 4
    for (int kk = 0; kk < 32; ++kk) { const int ki = r + 1 + 32 * part + kk; const LAS unsigned* vr = (const LAS unsigned*)(Vs + ki * 66); const float p = s[kk] * inv;
#pragma unroll
        for (int d2 = 0; d2 < 32; ++d2) { const unsigned vw = vr[d2]; o[2 * d2] += p * bf2f(vw & 0xffffu); o[2 * d2 + 1] += p * bf2f(vw >> 16); } }
    for (int pp = 0; pp < 4; ++pp) {
        if (part == pp) {
#pragma unroll
            for (int e = 0; e < 64; ++e) { if (pp == 0) ob[r * 65 + e] = o[e]; else ob[r * 65 + e] += o[e]; }
        }
        __syncthreads();
    }
    {   const int row = tid >> 2, e0 = 16 * (tid & 3); unsigned ow[8];
#pragma unroll
        for (int p = 0; p < 8; ++p) ow[p] = pk2(ob[row * 65 + e0 + 2 * p], ob[row * 65 + e0 + 2 * p + 1]);
        bf16_t* mxp = wsp<bf16_t>(F, WS_MIX) + (size_t)(128 * n + row) * D + 512 + hq * 64 + e0;
        *(u32x4*)mxp = (u32x4){ow[0], ow[1], ow[2], ow[3]}; *(u32x4*)(mxp + 8) = (u32x4){ow[4], ow[5], ow[6], ow[7]}; }
    __syncthreads();
}


typedef float f32x16 __attribute__((ext_vector_type(16)));
typedef short s16x4 __attribute__((ext_vector_type(4)));
typedef short v4i16_t __attribute__((ext_vector_type(4)));
#define MFMA32(a, b, c) __builtin_amdgcn_mfma_f32_32x32x16_bf16((a), (b), (c), 0, 0, 0)
__device__ __forceinline__ s16x4 tr_read(const LAS bf16_t* p) { return __builtin_bit_cast(s16x4, __builtin_amdgcn_ds_read_tr16_b64_v4i16((LAS v4i16_t*)p)); }
__device__ __forceinline__ void swa_unit_mfma(Frame& F, int unit, int layer) {
    constexpr int KST = 72, VST = 96;
    const int hf = unit & 1, n = (unit >> 1) & 63, j = unit >> 7, tid = F.tid, lane = F.lane, w = F.wave, r = lane & 31, hh = lane >> 5;
    const bf16_t* z = wsp<bf16_t>(F, WS_Z); const float* ct = wsp<float>(F, WS_ROPE); const float* st = ct + T * 32;
    LAS bf16_t* Ks = (LAS bf16_t*)F.lds; LAS bf16_t* Vs = Ks + 256 * KST;
    const int hq = 8 * j + 4 * hf + (w & 3);
    bf16x8 qf[2][4]; u32x4 qxa[2][2], qxb[2][2]; f32x4 qc[2][2][2], qs[2][2][2];
#pragma unroll
        for (int pi = 0; pi < 2; ++pi) { const int tq = 128 * n + 32 * (2 * (w >> 2) + pi) + r; const bf16_t* qp = z + (size_t)tq * NZ + ZSQ + hq * 64;
#pragma unroll
            for (int s2 = 0; s2 < 2; ++s2) { qxa[pi][s2] = *(const u32x4*)(qp + 16 * s2 + 8 * hh); qxb[pi][s2] = *(const u32x4*)(qp + 32 + 16 * s2 + 8 * hh);
                qc[pi][s2][0] = *(const f32x4*)(ct + tq * 32 + 16 * s2 + 8 * hh); qc[pi][s2][1] = *(const f32x4*)(ct + tq * 32 + 16 * s2 + 8 * hh + 4);
                qs[pi][s2][0] = *(const f32x4*)(st + tq * 32 + 16 * s2 + 8 * hh); qs[pi][s2][1] = *(const f32x4*)(st + tq * 32 + 16 * s2 + 8 * hh + 4); } }
    {
        const int row = tid >> 1, hp = tid & 1, tk = 128 * n - 128 + row;
        if (tk >= 0) {
            const bf16_t* kp = z + (size_t)tk * NZ + ZSK + j * 64; const bf16_t* vp = z + (size_t)tk * NZ + ZSV + j * 64;
            const u32x4 a0 = *(const u32x4*)(kp + 16 * hp), a1 = *(const u32x4*)(kp + 16 * hp + 8), b0 = *(const u32x4*)(kp + 32 + 16 * hp), b1 = *(const u32x4*)(kp + 32 + 16 * hp + 8);
            const unsigned x1[8] = {a0.x, a0.y, a0.z, a0.w, a1.x, a1.y, a1.z, a1.w}, x2[8] = {b0.x, b0.y, b0.z, b0.w, b1.x, b1.y, b1.z, b1.w};
            unsigned o1[8], o2[8];
            const f32x4* cp4 = (const f32x4*)(ct + tk * 32 + 16 * hp); const f32x4* sp4 = (const f32x4*)(st + tk * 32 + 16 * hp);
            const f32x4 cA = cp4[0], cB = cp4[1], cC = cp4[2], cD = cp4[3], sA = sp4[0], sB = sp4[1], sC = sp4[2], sD = sp4[3];
            const float cc[16] = {cA[0], cA[1], cA[2], cA[3], cB[0], cB[1], cB[2], cB[3], cC[0], cC[1], cC[2], cC[3], cD[0], cD[1], cD[2], cD[3]};
            const float sn[16] = {sA[0], sA[1], sA[2], sA[3], sB[0], sB[1], sB[2], sB[3], sC[0], sC[1], sC[2], sC[3], sD[0], sD[1], sD[2], sD[3]};
#pragma unroll
            for (int q = 0; q < 8; ++q) { const float c0 = cc[2 * q], s0 = sn[2 * q], c1 = cc[2 * q + 1], s1 = sn[2 * q + 1];
                const float u0 = bf2f(x1[q] & 0xffffu), u1 = bf2f(x1[q] >> 16), w0 = bf2f(x2[q] & 0xffffu), w1 = bf2f(x2[q] >> 16);
                o1[q] = pk2(u0 * c0 - w0 * s0, u1 * c1 - w1 * s1); o2[q] = pk2(w0 * c0 + u0 * s0, w1 * c1 + u1 * s1); }
            *(LAS u32x4*)(Ks + row * KST + 16 * hp) = (u32x4){o1[0], o1[1], o1[2], o1[3]}; *(LAS u32x4*)(Ks + row * KST + 16 * hp + 8) = (u32x4){o1[4], o1[5], o1[6], o1[7]};
            *(LAS u32x4*)(Ks + row * KST + 32 + 16 * hp) = (u32x4){o2[0], o2[1], o2[2], o2[3]}; *(LAS u32x4*)(Ks + row * KST + 32 + 16 * hp + 8) = (u32x4){o2[4], o2[5], o2[6], o2[7]};
#pragma unroll
            for (int q = 0; q < 4; ++q) *(LAS u32x4*)(Vs + row * VST + 32 * hp + 8 * q) = *(const u32x4*)(vp + 32 * hp + 8 * q);
        } else {
            const u32x4 zz = (u32x4){0u, 0u, 0u, 0u};
#pragma unroll
            for (int q = 0; q < 4; ++q) { *(LAS u32x4*)(Ks + row * KST + 32 * hp + 8 * q) = zz; *(LAS u32x4*)(Vs + row * VST + 32 * hp + 8 * q) = zz; }
        }
    }
#pragma unroll
    for (int pi = 0; pi < 2; ++pi)
#pragma unroll
        for (int s2 = 0; s2 < 2; ++s2) { const u32x4 xa = qxa[pi][s2], xb = qxb[pi][s2]; const f32x4 c0 = qc[pi][s2][0], c1 = qc[pi][s2][1], s0 = qs[pi][s2][0], s1 = qs[pi][s2][1];
            const unsigned x1[4] = {xa.x, xa.y, xa.z, xa.w}, x2[4] = {xb.x, xb.y, xb.z, xb.w}; const float cc[8] = {c0[0], c0[1], c0[2], c0[3], c1[0], c1[1], c1[2], c1[3]}, sn[8] = {s0[0], s0[1], s0[2], s0[3], s1[0], s1[1], s1[2], s1[3]};
            unsigned o1[4], o2[4];
#pragma unroll
            for (int q = 0; q < 4; ++q) { const float u0 = bf2f(x1[q] & 0xffffu), u1 = bf2f(x1[q] >> 16), w0 = bf2f(x2[q] & 0xffffu), w1 = bf2f(x2[q] >> 16);
                o1[q] = pk2((u0 * cc[2 * q] - w0 * sn[2 * q]) * 0.125f, (u1 * cc[2 * q + 1] - w1 * sn[2 * q + 1]) * 0.125f);
                o2[q] = pk2((w0 * cc[2 * q] + u0 * sn[2 * q]) * 0.125f, (w1 * cc[2 * q + 1] + u1 * sn[2 * q + 1]) * 0.125f); }
            qf[pi][s2] = __builtin_bit_cast(bf16x8, (u32x4){o1[0], o1[1], o1[2], o1[3]}); qf[pi][s2 + 2] = __builtin_bit_cast(bf16x8, (u32x4){o2[0], o2[1], o2[2], o2[3]}); }
    __syncthreads();
    const float sink = ((const float*)in_ptr(8))[layer * 16 + hq];
    const int i16 = lane & 15, q4 = i16 >> 2, p4 = i16 & 3, blk = (lane >> 4) & 1;
    const LAS bf16_t* vbase = Vs + (4 * hh + q4) * VST + 16 * blk + 4 * p4;
#pragma unroll
    for (int pi = 0; pi < 2; ++pi) {
        const int p = 2 * (w >> 2) + pi, tq = 128 * n + 32 * p + r;
        f32x16 X[5];
#pragma unroll
        for (int b = 0; b < 5; ++b) {
#pragma unroll
            for (int i = 0; i < 16; ++i) X[b][i] = 0.f;
#pragma unroll
            for (int s = 0; s < 4; ++s) { const bf16x8 kf = *(const LAS bf16x8*)(Ks + (32 * (p + b) + r) * KST + 16 * s + 8 * hh); X[b] = MFMA32(kf, qf[pi][s], X[b]); } }
        float mx = -INFINITY;
#pragma unroll
        for (int b = 0; b < 5; ++b)
#pragma unroll
            for (int i = 0; i < 16; ++i) { const int cr = (i & 3) + 8 * (i >> 2) + 4 * hh; bool valid = (b == 0) ? (cr > r) : (b == 4) ? (cr <= r) : true; if (n == 0) valid = valid && (p + b >= 4);
                const float v = valid ? X[b][i] : -INFINITY; X[b][i] = v; mx = fmaxf(mx, v); }
        mx = fmaxf(mx, shx(mx, 32, lane));
        const float m = fmaxf(mx, sink), mL = m * 1.44269504088896341f;
        float sum = 0.f;
#pragma unroll
        for (int b = 0; b < 5; ++b)
#pragma unroll
            for (int i = 0; i < 16; ++i) { const float e = pg8::exp_sub(X[b][i], mL); X[b][i] = e; sum += e; }
        sum += shx(sum, 32, lane);
        const float inv = 1.f / (sum + __expf(sink - m));
        f32x16 Z[2];
#pragma unroll
        for (int et = 0; et < 2; ++et)
#pragma unroll
            for (int i = 0; i < 16; ++i) Z[et][i] = 0.f;
#pragma unroll
        for (int b = 0; b < 5; ++b)
#pragma unroll
            for (int s2 = 0; s2 < 2; ++s2) {
                u32x4 pw;
                pw.x = pk2(X[b][8 * s2 + 0] * inv, X[b][8 * s2 + 1] * inv); pw.y = pk2(X[b][8 * s2 + 2] * inv, X[b][8 * s2 + 3] * inv);
                pw.z = pk2(X[b][8 * s2 + 4] * inv, X[b][8 * s2 + 5] * inv); pw.w = pk2(X[b][8 * s2 + 6] * inv, X[b][8 * s2 + 7] * inv);
                const bf16x8 pa = __builtin_bit_cast(bf16x8, pw);
                const LAS bf16_t* vp = vbase + (32 * (p + b) + 16 * s2) * VST;
#pragma unroll
                for (int et = 0; et < 2; ++et) { const s16x4 lo = tr_read(vp + 32 * et), hi = tr_read(vp + 8 * VST + 32 * et);
                    const bf16x8 vb = (bf16x8){lo[0], lo[1], lo[2], lo[3], hi[0], hi[1], hi[2], hi[3]};
                    Z[et] = MFMA32(pa, vb, Z[et]); } }
        LAS bf16_t* stg = Vs + 256 * VST + w * (32 * 72);
#pragma unroll
        for (int et = 0; et < 2; ++et)
#pragma unroll
            for (int i = 0; i < 16; ++i) { const int cr = (i & 3) + 8 * (i >> 2) + 4 * hh; stg[cr * 72 + 32 * et + r] = (bf16_t)f2bf(Z[et][i]); }
        LDS_WAIT(); asm volatile("" ::: "memory");
        bf16_t* mxp = wsp<bf16_t>(F, WS_MIX) + (size_t)(128 * n + 32 * p) * D + 512 + hq * 64;
#pragma unroll
        for (int jq = 0; jq < 4; ++jq) { const int id = lane + 64 * jq, row = id >> 3, c16 = id & 7; *(u32x4*)(mxp + (size_t)row * D + 8 * c16) = *(const LAS u32x4*)(stg + row * 72 + 8 * c16); }
        LDS_WAIT(); asm volatile("" ::: "memory");
    }
    __syncthreads();
}


__device__ __forceinline__ void gla_local_mfma(Frame& F, int unit) {
    constexpr int KS = 96, VS = 160;
    const int h = unit >> 7, ck = unit & 127, t0 = ck * 64, w = F.wave, lane = F.lane, tid = F.tid;
    const bf16_t* z = wsp<bf16_t>(F, WS_Z); const float* la = wsp<float>(F, WS_LA);
    LAS float* tot = (LAS float*)F.lds; LAS bf16_t* kh = (LAS bf16_t*)(tot + 512); LAS bf16_t* vs = kh + 64 * KS;
    bf16_t kraw[8]; u32x4 vraw[2];
#pragma unroll
    for (int i = 0; i < 8; ++i) kraw[i] = z[(size_t)(t0 + 8 * w + i) * NZ + ZK + h * 64 + lane];
#pragma unroll
    for (int j = 0; j < 2; ++j) { const int idx = tid + 512 * j, t = idx >> 4, ch = idx & 15; vraw[j] = *(const u32x4*)(z + (size_t)(t0 + t) * NZ + ZV + h * 128 + ch * 8); }
    float c[8]; gla_cumsum(F, la, t0, h, tot, c);
    float total = 0.f;
#pragma unroll
    for (int j = 0; j < 8; ++j) total += tot[j * 64 + lane];
#pragma unroll
    for (int i = 0; i < 8; ++i) { const int t = 8 * w + i; kh[t * KS + lane] = (bf16_t)f2bf(bf2f(kraw[i]) * __expf(total - c[i])); }
#pragma unroll
    for (int j = 0; j < 2; ++j) { const int idx = tid + 512 * j, t = idx >> 4, ch = idx & 15; *(LAS u32x4*)(vs + t * VS + ch * 8) = vraw[j]; }
    if (w == 0) wsp<float>(F, WS_DEC)[(size_t)unit * 64 + lane] = __expf(total);
    __syncthreads();
    const int r = lane & 31, hh = lane >> 5, i16 = lane & 15, q4 = i16 >> 2, p4 = i16 & 3, blk = (lane >> 4) & 1, dt = w & 1, et = w >> 1;
    const LAS bf16_t* ka = kh + (8 * hh + q4) * KS + 32 * dt + 16 * blk + 4 * p4;
    const LAS bf16_t* va = vs + (8 * hh + q4) * VS + 32 * et + 16 * blk + 4 * p4;
    f32x16 acc;
#pragma unroll
    for (int i = 0; i < 16; ++i) acc[i] = 0.f;
#pragma unroll
    for (int s4 = 0; s4 < 4; ++s4) {
        const s16x4 al = tr_read(ka + 16 * s4 * KS), ah = tr_read(ka + (16 * s4 + 4) * KS), bl = tr_read(va + 16 * s4 * VS), bh = tr_read(va + (16 * s4 + 4) * VS);
        acc = MFMA32(((bf16x8){al[0], al[1], al[2], al[3], ah[0], ah[1], ah[2], ah[3]}), ((bf16x8){bl[0], bl[1], bl[2], bl[3], bh[0], bh[1], bh[2], bh[3]}), acc); }
    float* U = wsp<float>(F, WS_UB) + (size_t)unit * 8192 + 32 * et + r;
#pragma unroll
    for (int i = 0; i < 16; ++i) U[(32 * dt + (i & 3) + 8 * (i >> 2) + 4 * hh) * 128] = acc[i];
    __syncthreads();
}
__device__ __forceinline__ void gla_out_mfma(Frame& F, int unit, int layer) {
    constexpr int QS = 72, VS = 160;
    const int h = unit >> 7, ck = unit & 127, t0 = ck * 64, w = F.wave, lane = F.lane, tid = F.tid;
    const bf16_t* z = wsp<bf16_t>(F, WS_Z); const float* la = wsp<float>(F, WS_LA);
    LAS float* tot = (LAS float*)F.lds; LAS float* red = tot + 512;
    LAS bf16_t* qt = (LAS bf16_t*)(red + 256); LAS bf16_t* kt = qt + 64 * QS; LAS bf16_t* qe = kt + 64 * QS; LAS bf16_t* vs = qe + 64 * QS; LAS bf16_t* Ss = vs + 64 * VS;
    bf16_t qraw[8], kraw[8]; u32x4 vraw[2], sraw[2];
#pragma unroll
    for (int i = 0; i < 8; ++i) { const size_t zo = (size_t)(t0 + 8 * w + i) * NZ + h * 64 + lane; qraw[i] = z[zo + ZQ]; kraw[i] = z[zo + ZK]; }
#pragma unroll
    for (int j = 0; j < 2; ++j) { const int idx = tid + 512 * j, t = idx >> 4, ch = idx & 15;
        vraw[j] = *(const u32x4*)(z + (size_t)(t0 + t) * NZ + ZV + h * 128 + ch * 8); sraw[j] = *(const u32x4*)(wsp<bf16_t>(F, WS_SB) + (size_t)unit * 8192 + t * 128 + ch * 8); }
    const int r_ = lane & 31, hh_ = lane >> 5, tt_ = w & 1, et_ = w >> 1, tl_ = 32 * tt_ + r_;
    u32x2 grv[4]; f32x4 gnv[4];
    {   const bf16_t* zr = z + (size_t)(t0 + tl_) * NZ + ZR + h * 128 + 32 * et_ + 4 * hh_; const float* gn = (const float*)in_ptr(7) + layer * 128 + 32 * et_ + 4 * hh_;
#pragma unroll
        for (int g4 = 0; g4 < 4; ++g4) { grv[g4] = *(const u32x2*)(zr + 8 * g4); gnv[g4] = *(const f32x4*)(gn + 8 * g4); } }
    float c[8]; gla_cumsum(F, la, t0, h, tot, c);
    const float ref = tot[lane] + tot[64 + lane] + tot[128 + lane] + tot[192 + lane];
#pragma unroll
    for (int i = 0; i < 8; ++i) { const int t = 8 * w + i; const float q = bf2f(qraw[i]) * 0.125f, k = bf2f(kraw[i]);
        qt[t * QS + lane] = (bf16_t)f2bf(q * __expf(c[i] - ref)); qe[t * QS + lane] = (bf16_t)f2bf(q * __expf(c[i])); kt[t * QS + lane] = (bf16_t)f2bf(k * __expf(ref - c[i])); }
#pragma unroll
    for (int j = 0; j < 2; ++j) { const int idx = tid + 512 * j, t = idx >> 4, ch = idx & 15; *(LAS u32x4*)(vs + t * VS + ch * 8) = vraw[j]; *(LAS u32x4*)(Ss + t * VS + ch * 8) = sraw[j]; }
    __syncthreads();
    const int r = lane & 31, hh = lane >> 5, i16 = lane & 15, q4 = i16 >> 2, p4 = i16 & 3, blk = (lane >> 4) & 1, tt = w & 1, et = w >> 1;
    f32x16 Y;
#pragma unroll
    for (int i = 0; i < 16; ++i) Y[i] = 0.f;
    {   const LAS bf16_t* sa = Ss + (8 * hh + q4) * VS + 32 * et + 16 * blk + 4 * p4; const LAS bf16_t* qb = qe + (32 * tt + r) * QS + 8 * hh;
#pragma unroll
        for (int s4 = 0; s4 < 4; ++s4) { const s16x4 al = tr_read(sa + 16 * s4 * VS), ah = tr_read(sa + (16 * s4 + 4) * VS); const bf16x8 bq = *(const LAS bf16x8*)(qb + 16 * s4);
            Y = MFMA32(((bf16x8){al[0], al[1], al[2], al[3], ah[0], ah[1], ah[2], ah[3]}), bq, Y); } }
    const LAS bf16_t* va = vs + (4 * hh + q4) * VS + 32 * et + 16 * blk + 4 * p4;
#pragma unroll
    for (int st = 0; st < 2; ++st) {
        if (st <= tt) {
            f32x16 X;
#pragma unroll
            for (int i = 0; i < 16; ++i) X[i] = 0.f;
            const LAS bf16_t* ka = kt + (32 * st + r) * QS + 8 * hh; const LAS bf16_t* qb = qt + (32 * tt + r) * QS + 8 * hh;
#pragma unroll
            for (int s4 = 0; s4 < 4; ++s4) X = MFMA32(*(const LAS bf16x8*)(ka + 16 * s4), *(const LAS bf16x8*)(qb + 16 * s4), X);
            if (st == tt) {
#pragma unroll
                for (int i = 0; i < 16; ++i) { const int cr = (i & 3) + 8 * (i >> 2) + 4 * hh; X[i] = (cr <= r) ? X[i] : 0.f; } }
#pragma unroll
            for (int s2 = 0; s2 < 2; ++s2) {
                u32x4 pw; pw.x = pk2(X[8 * s2 + 0], X[8 * s2 + 1]); pw.y = pk2(X[8 * s2 + 2], X[8 * s2 + 3]); pw.z = pk2(X[8 * s2 + 4], X[8 * s2 + 5]); pw.w = pk2(X[8 * s2 + 6], X[8 * s2 + 7]);
                const LAS bf16_t* vp = va + (32 * st + 16 * s2) * VS;
                const s16x4 lo = tr_read(vp), hi = tr_read(vp + 8 * VS);
                Y = MFMA32(((bf16x8){lo[0], lo[1], lo[2], lo[3], hi[0], hi[1], hi[2], hi[3]}), __builtin_bit_cast(bf16x8, pw), Y); }
        }
    }
    float p = 0.f;
#pragma unroll
    for (int i = 0; i < 16; ++i) p += Y[i] * Y[i];
    p += shx(p, 32, lane);
    if (hh == 0) red[et * 64 + 32 * tt + r] = p;
    __syncthreads();
    const int tl = 32 * tt + r;
    const float rs = rsqrtf(((red[tl] + red[64 + tl]) + (red[128 + tl] + red[192 + tl])) * (1.f / 128.f) + EPS);
    bf16_t* mx = wsp<bf16_t>(F, WS_MIX) + (size_t)(t0 + tl) * D + h * 128 + 32 * et + 4 * hh;
#pragma unroll
    for (int g4 = 0; g4 < 4; ++g4) { const u32x2 rr = grv[g4]; const f32x4 g = gnv[g4];
        u32x2 o; o.x = pk2(Y[4 * g4 + 0] * rs * g[0] * siluf(bf2f(rr.x & 0xffffu)), Y[4 * g4 + 1] * rs * g[1] * siluf(bf2f(rr.x >> 16)));
        o.y = pk2(Y[4 * g4 + 2] * rs * g[2] * siluf(bf2f(rr.y & 0xffffu)), Y[4 * g4 + 3] * rs * g[3] * siluf(bf2f(rr.y >> 16)));
        *(u32x2*)(mx + 8 * g4) = o; }
    __syncthreads();
}

struct SCIn { u32x4 a[6], b[6], cb[4]; f32x4 w[3][2]; };
__device__ __forceinline__ void sconv_load(const Frame& F, int it, int layer, SCIn& g) {
    const bf16_t* __restrict__ z = wsp<bf16_t>(F, WS_Z); const float* wc = (const float*)in_ptr(9) + layer * 3 * 512; const int c0 = (F.tid & 63) * 8, t0 = 4 * (it >> 6);
#pragma unroll
    for (int jj = 0; jj < 3; ++jj) { g.w[jj][0] = *(const f32x4*)(wc + jj * 512 + c0); g.w[jj][1] = *(const f32x4*)(wc + jj * 512 + c0 + 4); }
#pragma unroll
    for (int r = 0; r < 6; ++r) { const int ts = t0 - 2 + r, tc = ts < 0 ? 0 : ts; g.a[r] = *(const u32x4*)(z + (size_t)tc * NZ + ZCC + c0); g.b[r] = *(const u32x4*)(z + (size_t)tc * NZ + ZCH + c0); }
#pragma unroll
    for (int k = 0; k < 4; ++k) g.cb[k] = *(const u32x4*)(z + (size_t)(t0 + k) * NZ + ZCB + c0);
}
__device__ __forceinline__ void sconv_compute(const Frame& F, int it, const SCIn& g) {
    bf16_t* __restrict__ mix = wsp<bf16_t>(F, WS_MIX); const int c0 = (F.tid & 63) * 8, t0 = 4 * (it >> 6);
    float p[6][8];
#pragma unroll
    for (int r = 0; r < 6; ++r) { const unsigned aa[4] = {g.a[r].x, g.a[r].y, g.a[r].z, g.a[r].w}, bb[4] = {g.b[r].x, g.b[r].y, g.b[r].z, g.b[r].w}; const bool ok = (t0 - 2 + r) >= 0;
#pragma unroll
        for (int q = 0; q < 4; ++q) { p[r][2 * q] = ok ? bf2f(aa[q] & 0xffffu) * bf2f(bb[q] & 0xffffu) : 0.f; p[r][2 * q + 1] = ok ? bf2f(aa[q] >> 16) * bf2f(bb[q] >> 16) : 0.f; } }
#pragma unroll
    for (int k = 0; k < 4; ++k) { float acc[8];
#pragma unroll
        for (int e = 0; e < 8; ++e) { acc[e] = g.w[0][e >> 2][e & 3] * p[k][e]; acc[e] += g.w[1][e >> 2][e & 3] * p[k + 1][e]; acc[e] += g.w[2][e >> 2][e & 3] * p[k + 2][e]; }
        const unsigned cc[4] = {g.cb[k].x, g.cb[k].y, g.cb[k].z, g.cb[k].w}; unsigned ow[4];
#pragma unroll
        for (int q = 0; q < 4; ++q) ow[q] = pk2(acc[2 * q] * bf2f(cc[q] & 0xffffu), acc[2 * q + 1] * bf2f(cc[q] >> 16));
        *(u32x4*)(mix + (size_t)(t0 + k) * D + 1536 + c0) = (u32x4){ow[0], ow[1], ow[2], ow[3]}; }
}
__device__ __forceinline__ void scan_sconv_phase(Frame& F, int layer) {
    constexpr int NIT = (T / 4) * 64; const int it0 = F.bid * 512 + F.tid, stride = F.G * 512;
    SCIn g; sconv_load(F, it0 < NIT ? it0 : 0, layer, g);
    gla_scan4(F);
    if (it0 < NIT) sconv_compute(F, it0, g);
    for (int it = it0 + stride; it < NIT; it += stride) { SCIn h; sconv_load(F, it, layer, h); sconv_compute(F, it, h); }
}
__device__ __forceinline__ void xsoftmax_phase(Frame& F) {
    const float* sc = wsp<float>(F, WS_SC); bf16_t* pb = wsp<bf16_t>(F, WS_PB);
    for (int it = F.bid * 8 + F.wave; it < T * 4; it += F.G * 8) { const f32x4 v = *((const f32x4*)(sc + (size_t)it * 256) + F.lane);
        const float m = wave_max(fmaxf(fmaxf(v[0], v[1]), fmaxf(v[2], v[3])), F.lane);
        const float e0 = __expf(v[0] - m), e1 = __expf(v[1] - m), e2 = __expf(v[2] - m), e3 = __expf(v[3] - m); const float inv = 1.f / wave_sum((e0 + e1) + (e2 + e3), F.lane);
        u32x2 o; o.x = pk2(e0 * inv, e1 * inv); o.y = pk2(e2 * inv, e3 * inv); *((u32x2*)(pb + (size_t)it * 256) + F.lane) = o; }
}
__device__ __forceinline__ void fconv_phase(Frame& F, const Args& A, int layer) {
    const bf16_t* u = wsp<bf16_t>(F, WS_U); bf16_t* ab = wsp<bf16_t>(F, WS_AB); const float* wc = (const float*)in_ptr(19) + (size_t)layer * 3 * NUP; const float* bc = (const float*)in_ptr(20) + (size_t)layer * NUP;
    for (int it = F.bid * 512 + F.tid; it < T * 704; it += F.G * 512) { const int t = it / 704, c0 = (it % 704) * 8; float g[8], v[8];
#pragma unroll
        for (int e = 0; e < 8; ++e) { g[e] = bc[c0 + e]; v[e] = bc[DFF + c0 + e]; }
#pragma unroll
        for (int jj = 0; jj < 3; ++jj) { const int ts = t - 2 + jj; if (ts < 0) continue;
            const u32x4 a = *(const u32x4*)(u + (size_t)ts * NUP + c0), b = *(const u32x4*)(u + (size_t)ts * NUP + DFF + c0); const unsigned aa[4] = {a.x, a.y, a.z, a.w}, bb[4] = {b.x, b.y, b.z, b.w};
#pragma unroll
            for (int p = 0; p < 4; ++p) { g[2 * p] += wc[jj * NUP + c0 + 2 * p] * bf2f(aa[p] & 0xffffu); g[2 * p + 1] += wc[jj * NUP + c0 + 2 * p + 1] * bf2f(aa[p] >> 16);
                v[2 * p] += wc[jj * NUP + DFF + c0 + 2 * p] * bf2f(bb[p] & 0xffffu); v[2 * p + 1] += wc[jj * NUP + DFF + c0 + 2 * p + 1] * bf2f(bb[p] >> 16); } }
        unsigned ow[4];
#pragma unroll
        for (int p = 0; p < 4; ++p) ow[p] = pk2(siluf(g[2 * p]) * v[2 * p], siluf(g[2 * p + 1]) * v[2 * p + 1]);
        *(u32x4*)(ab + (size_t)t * DFF + c0) = (u32x4){ow[0], ow[1], ow[2], ow[3]}; }
}
__device__ __forceinline__ void final_phase(Frame& F, const Args& A, float* out) {
    const bf16_t* hb = wsp<bf16_t>(F, WS_HB); const float* ss = ss_ptr(F, 12); const f32x4* gr = (const f32x4*)in_ptr(22) + F.lane;
    for (int m = F.bid * 8 + F.wave; m < T; m += F.G * 8) { const float rs = rsqrtf(wave_sum(F.lane < 32 ? ss[(size_t)m * 32 + F.lane] : 0.f, F.lane) * (1.f / D) + EPS);
        const u32x2* hr = (const u32x2*)(hb + (size_t)m * D) + F.lane; f32x4* o = (f32x4*)(out + (size_t)m * D) + F.lane;
#pragma unroll
        for (int j = 0; j < 8; ++j) { const u32x2 b = hr[64 * j]; const f32x4 g = gr[64 * j];
            __builtin_nontemporal_store((f32x4){bf2f(b.x & 0xffffu) * rs * g[0], bf2f(b.x >> 16) * rs * g[1], bf2f(b.y & 0xffffu) * rs * g[2], bf2f(b.y >> 16) * rs * g[3]}, o + 64 * j); } }
}
__device__ __forceinline__ void ffn_fixup(Frame& F, int pm, int layer) {
    const bf16_t* HT = wsp<bf16_t>(F, WS_HT); bf16_t* ab = wsp<bf16_t>(F, WS_AB);
    const float* wcv = (const float*)in_ptr(19) + (size_t)layer * 3 * NUP; const float* bcv = (const float*)in_ptr(20) + (size_t)layer * NUP;
    for (int chunk = F.tid; chunk < 704; chunk += 512) {
        const int ch = 8 * chunk, col = 256 * (ch >> 7) + (ch & 127);
        f32x4 wg[3][2], wv[3][2], bg[2], bv[2];
#pragma unroll
        for (int jj = 0; jj < 3; ++jj)
#pragma unroll
            for (int hh = 0; hh < 2; ++hh) { wg[jj][hh] = *(const f32x4*)(wcv + jj * NUP + ch + 4 * hh); wv[jj][hh] = *(const f32x4*)(wcv + jj * NUP + DFF + ch + 4 * hh); }
#pragma unroll
        for (int hh = 0; hh < 2; ++hh) { bg[hh] = *(const f32x4*)(bcv + ch + 4 * hh); bv[hh] = *(const f32x4*)(bcv + DFF + ch + 4 * hh); }
        u32x4 xg[4][4], xv[4][4];
#pragma unroll
        for (int q = 0; q < 4; ++q) { const int kb = 4 * pm + q;
#pragma unroll
            for (int rr = 0; rr < 4; ++rr) { const bool z = (rr < 2) && (kb == 0); const bf16_t* rp = HT + (size_t)(rr < 2 ? (z ? 0 : kb - 1) * 4 + 2 + rr : kb * 4 + (rr - 2)) * NUP + col;
                const u32x4 zz = (u32x4){0u, 0u, 0u, 0u}; xg[q][rr] = z ? zz : *(const u32x4*)rp; xv[q][rr] = z ? zz : *(const u32x4*)(rp + 128); } }
#pragma unroll
        for (int q = 0; q < 4; ++q) { const int kb = 4 * pm + q;
            f32x4 rg[4][2], rv[4][2];
#pragma unroll
            for (int rr = 0; rr < 4; ++rr) { const u32x4 a = xg[q][rr], b = xv[q][rr];
                rg[rr][0] = (f32x4){bf2f(a.x & 0xffffu), bf2f(a.x >> 16), bf2f(a.y & 0xffffu), bf2f(a.y >> 16)}; rg[rr][1] = (f32x4){bf2f(a.z & 0xffffu), bf2f(a.z >> 16), bf2f(a.w & 0xffffu), bf2f(a.w >> 16)};
                rv[rr][0] = (f32x4){bf2f(b.x & 0xffffu), bf2f(b.x >> 16), bf2f(b.y & 0xffffu), bf2f(b.y >> 16)}; rv[rr][1] = (f32x4){bf2f(b.z & 0xffffu), bf2f(b.z >> 16), bf2f(b.w & 0xffffu), bf2f(b.w >> 16)}; }
#pragma unroll
            for (int i = 0; i < 2; ++i) {
                unsigned ow[4];
#pragma unroll
                for (int hh = 0; hh < 2; ++hh) { const f32x4 G = bg[hh] + wg[0][hh] * rg[i][hh] + wg[1][hh] * rg[i + 1][hh] + wg[2][hh] * rg[i + 2][hh];
                    const f32x4 V = bv[hh] + wv[0][hh] * rv[i][hh] + wv[1][hh] * rv[i + 1][hh] + wv[2][hh] * rv[i + 2][hh];
                    ow[2 * hh] = pk2(pg8::silu_fast(G[0]) * V[0], pg8::silu_fast(G[1]) * V[1]); ow[2 * hh + 1] = pk2(pg8::silu_fast(G[2]) * V[2], pg8::silu_fast(G[3]) * V[3]); }
                *(u32x4*)(ab + (size_t)(64 * kb + i) * DFF + ch) = (u32x4){ow[0], ow[1], ow[2], ow[3]}; } }
    }
}
__device__ __forceinline__ void fill_rstd_table(Frame& F, const float* ssp, int pm) {
    LAS float* rtab = (LAS float*)(__builtin_amdgcn_groupstaticsize() + MISC_OFF + 1024);
    if (pm >= 0) { const int row = F.tid >> 1, hf = F.tid & 1; const f32x4* p = (const f32x4*)(ssp + ((size_t)pm * 256 + row) * 32 + 16 * hf);
        const f32x4 a = p[0], b = p[1], c = p[2], d = p[3];
        float sacc = (((a[0] + a[1]) + (a[2] + a[3])) + ((b[0] + b[1]) + (b[2] + b[3]))) + (((c[0] + c[1]) + (c[2] + c[3])) + ((d[0] + d[1]) + (d[2] + d[3])));
        sacc += shx(sacc, 1, F.lane);
        if (hf == 0) rtab[row] = rsqrtf(sacc * (1.f / D) + EPS); }
    __syncthreads();
}
__device__ __forceinline__ void frame_refresh(Frame& F) {
    int ln; asm volatile("v_mbcnt_lo_u32_b32 %0, -1, 0\n\tv_mbcnt_hi_u32_b32 %0, -1, %0" : "=v"(ln)); F.lane = ln; F.tid = (F.wave << 6) | ln; F.ws = ws_ptr();
}
constexpr int PH_PER_LAYER = 9, N_PHASES = 1 + NL * PH_PER_LAYER + 1;
__global__ void __launch_bounds__(512, 2) fwd(Args args) {
    extern __shared__ __attribute__((aligned(16))) unsigned char lds_raw[];
    Frame F; F.lds = (LAS unsigned char*)lds_raw; F.ws = args.ws;
    F.tid = threadIdx.x; F.lane = F.tid & 63; F.wave = __builtin_amdgcn_readfirstlane(F.tid >> 6); F.G = gridDim.x; F.bid = blockIdx.x;
    volatile LAS unsigned* MISC = (volatile LAS unsigned*)(F.lds + MISC_OFF);
    if (F.tid < 64) MISC[F.tid] = 0u;
    __syncthreads();
    XcdBarrier bar; bar.bar = (unsigned*)(args.ws + WS_CTL) + CW_BAR; bar.x = 0; bar.st = nullptr;
#if MK_ONE_LAUNCH
    bar = xcd_barrier_post((unsigned*)(args.ws + WS_CTL) + CW_BAR, MISC + 8);
#define SEAM() xcd_barrier(bar)
#else
#define SEAM() do {} while (0)
#endif
    const int lo = args.ph_lo, hi = args.ph_hi;
#define IN(k) (lo <= (k) && (k) < hi && (frame_refresh(F), true))
    const int cid = (int)blockIdx.x;

    if (IN(0)) { p_prologue(F, args); SEAM(); }
    for (int l = 0; l < NL; ++l) {
        const int p0 = 1 + l * PH_PER_LAYER;
        if (IN(p0 + 0)) {
            pg8::TileOrder S; S.init(wsp<bf16_t>(F, WS_HB), wsp<bf16_t>(F, WS_WIN + l * SZ_WIN), T, NZ, D, D, F.G, cid);
            pg8::EpiScaleBf16 E{wsp<bf16_t>(F, WS_Z), NZ, ss_ptr(F, 3 * l + 0), ZG / 256, wsp<float>(F, WS_LA), (const float*)in_ptr(6) + l * 256};
            pg8::gemm_phase<pg8::EpiScaleBf16, pg8::TileOrder, true>(F.lds, pg8::Gemm{D, D, D}, S, E, F.tid);
            if (l == 0) { KVOrder S2{F.ws, F.G, (cid + F.G - 64) % F.G}; pg8::EpiPlain E2; pg8::gemm_phase<pg8::EpiPlain, KVOrder, true>(F.lds, pg8::Gemm{D, D, D}, S2, E2, F.tid); }
            { const int first = (l == 0) ? 128 : 64; convert_slot(F, l, NA_HEAD, CV_T, false, cid - first, F.G - first); }
            SEAM(); }
        if (IN(p0 + 1)) {
            for (int u = cid; u < 512; u += F.G) gla_local_mfma(F, u);
            if (l == 0) { FoldOrder S2{F.ws, F.G, cid}; pg8::EpiPlain E2; pg8::gemm_phase<pg8::EpiPlain, FoldOrder, true>(F.lds, pg8::Gemm{512, D, D}, S2, E2, F.tid); }
            SEAM(); }
        if (IN(p0 + 2)) {
            scan_sconv_phase(F, l);
            for (int u = cid; u < 256; u += F.G) swa_unit_mfma(F, u, l);
            SEAM(); }
        if (IN(p0 + 3)) { for (int u = cid; u < 512; u += F.G) gla_out_mfma(F, u, l); SEAM(); }
        if (IN(p0 + 4)) {
            pg8::TileOrder S; S.init(wsp<bf16_t>(F, WS_MIX), wsp<bf16_t>(F, WS_WOUT + l * SZ_W22), T, D, D, D, F.G, cid);
            pg8::EpiRes E{wsp<bf16_t>(F, WS_HB), ss_ptr(F, 3 * l + 1)};
            pg8::gemm_phase<pg8::EpiRes, pg8::TileOrder, true>(F.lds, pg8::Gemm{D, D, D}, S, E, F.tid); SEAM(); }
        if (IN(p0 + 5)) {
            pg8::TileOrder S; S.init(wsp<bf16_t>(F, WS_HB), wsp<bf16_t>(F, WS_WST + l * SZ_WS), T, NSC, D, D, F.G, cid);
            pg8::EpiSoftmax E{wsp<bf16_t>(F, WS_PB), ss_ptr(F, 3 * l + 1)};
            pg8::gemm_phase<pg8::EpiSoftmax, pg8::TileOrder, false>(F.lds, pg8::Gemm{D, D, D}, S, E, F.tid);
            convert_slot(F, l, CV_T, NA, false, cid - 128, F.G - 128);
            SEAM(); }
        if (IN(p0 + 6)) {
            pg8::TileOrder S; S.init(wsp<bf16_t>(F, WS_PB), wsp<bf16_t>(F, WS_VWT + l * SZ_WS), T, D, NSC, NSC, F.G, cid);
            pg8::EpiRes E{wsp<bf16_t>(F, WS_HB), ss_ptr(F, 3 * l + 2)};
            pg8::gemm_phase<pg8::EpiRes, pg8::TileOrder, true>(F.lds, pg8::Gemm{NSC, NSC, NSC}, S, E, F.tid); SEAM(); }
        if (IN(p0 + 7)) {
            pg8::TileOrder S; S.init(wsp<bf16_t>(F, WS_HB), wsp<bf16_t>(F, WS_WUP + l * SZ_WUP), T, NUP, D, D, F.G, cid);
            pg8::EpiUpConv E{wsp<bf16_t>(F, WS_AB), wsp<bf16_t>(F, WS_HT), ss_ptr(F, 3 * l + 2), (const float*)in_ptr(19) + (size_t)l * 3 * NUP, (const float*)in_ptr(20) + (size_t)l * NUP};
            pg8::gemm_phase<pg8::EpiUpConv, pg8::TileOrder, true>(F.lds, pg8::Gemm{D, D, D}, S, E, F.tid);
            if (l + 1 < NL) convert_slot(F, l + 1, 0, NA_HEAD, true, cid - 128, F.G - 128);
            SEAM(); }
        if (IN(p0 + 8)) {
            pg8::TileOrder S; S.init(wsp<bf16_t>(F, WS_AB), wsp<bf16_t>(F, WS_WDN + l * SZ_WDN), T, D, DFF, DFF, F.G, cid);
            { pg8::Unit u0; for (int i = 0; S.next(i, u0); ++i) ffn_fixup(F, u0.pm, l); VM_WAIT(); __syncthreads(); }
            pg8::EpiRes E{wsp<bf16_t>(F, WS_HB), ss_ptr(F, 3 * l + 3)};
            pg8::gemm_phase<pg8::EpiRes, pg8::TileOrder, true>(F.lds, pg8::Gemm{DFF, DFF, DFF}, S, E, F.tid); SEAM(); }
    }
    if (IN(N_PHASES - 1)) final_phase(F, args, args.out);
#undef IN
#undef SEAM
}

extern "C" void kernel_launch(void* const* d_in, const int* in_sizes, int n_in, void* d_out, int out_size, void* d_ws, size_t ws_size, hipStream_t stream) {
    static int grid = 0;
    if (grid == 0) {
        if (n_in != 23 || ws_size < WS_END) { fprintf(stderr, "kernel_launch: expected 23 inputs and >= %zu bytes of workspace (got %d, %zu)\n", (size_t)WS_END, n_in, ws_size); grid = -1; return; }
        int dev = 0, cus = 0, per_cu = 0;
        if (hipGetDevice(&dev) != hipSuccess || hipDeviceGetAttribute(&cus, hipDeviceAttributeMultiprocessorCount, dev) != hipSuccess) { grid = -1; return; }
        if (hipFuncSetAttribute((const void*)fwd, hipFuncAttributeMaxDynamicSharedMemorySize, LDS_BYTES) != hipSuccess) { fprintf(stderr, "kernel_launch: hipFuncSetAttribute failed\n"); grid = -1; return; }
        if (hipOccupancyMaxActiveBlocksPerMultiprocessor(&per_cu, (const void*)fwd, 512, LDS_BYTES) != hipSuccess || per_cu < 1) { fprintf(stderr, "kernel_launch: occupancy query says %d\n", per_cu); }
        (void)hipGetLastError();
        grid = cus;
    }
    if (grid < 0) return;
    (void)hipMemsetAsync((char*)d_ws + WS_CTL, 0, 65536, stream);
    Args a{};
    for (int i = 0; i < 23; ++i) a.in[i] = d_in[i];
    a.out = (float*)d_out; a.ws = (unsigned char*)d_ws;
#if MK_ONE_LAUNCH
    a.ph_lo = 0; a.ph_hi = N_PHASES;
    hipLaunchKernelGGL(fwd, dim3(grid), dim3(512), LDS_BYTES, stream, a);
#else
    for (int p = 0; p < N_PHASES; ++p) { a.ph_lo = p; a.ph_hi = p + 1; hipLaunchKernelGGL(fwd, dim3(grid), dim3(512), LDS_BYTES, stream, a); }
#endif
}
```

```cpp
#include <hip/hip_runtime.h>
#include <cstdio>
#include <cstdint>

#define LAS __attribute__((address_space(3)))
#define GAS __attribute__((address_space(1)))
typedef unsigned short bf16_t;
typedef short bf16x8 __attribute__((ext_vector_type(8)));
typedef float f32x4 __attribute__((ext_vector_type(4)));
typedef float f32x2 __attribute__((ext_vector_type(2)));
typedef unsigned u32x4 __attribute__((ext_vector_type(4)));
typedef unsigned u32x2 __attribute__((ext_vector_type(2)));

#ifndef MK_ONE_LAUNCH
#define MK_ONE_LAUNCH 1
#endif

constexpr int T = 8192, D = 2048, NL = 4, NMEM = 256, NZ = 4608, DFF = 5632, NUP = 11264, NSC = 1024, NIN = 4368;
constexpr float EPS = 1e-6f;
constexpr int ZQ = 0, ZK = 256, ZV = 512, ZR = 1024, ZG = 1536, ZSQ = 1792, ZSK = 2816, ZSV = 2944, ZCB = 3072, ZCC = 3584, ZCH = 4096;

constexpr size_t MiB = 1u << 20;
constexpr size_t WS_CTL = 0, CTL_BYTES = 2 * MiB;
constexpr size_t SZ_WIN = (size_t)NZ * D * 2, SZ_W22 = (size_t)D * D * 2, SZ_WUP = (size_t)NUP * D * 2, SZ_WDN = (size_t)D * DFF * 2;
constexpr size_t SZ_WS = (size_t)NSC * D * 2, SZ_MEM = (size_t)NMEM * D * 2;
constexpr size_t WS_WIN = WS_CTL + CTL_BYTES;
constexpr size_t WS_WOUT = WS_WIN + NL * SZ_WIN;
constexpr size_t WS_WQP = WS_WOUT + NL * SZ_W22;
constexpr size_t WS_WK = WS_WQP + NL * SZ_W22;
constexpr size_t WS_WV = WS_WK + NL * SZ_W22;
constexpr size_t WS_WO = WS_WV + NL * SZ_W22;
constexpr size_t WS_WUP = WS_WO + NL * SZ_W22;
constexpr size_t WS_WDN = WS_WUP + NL * SZ_WUP;
constexpr size_t WS_WST = WS_WDN + NL * SZ_WDN;
constexpr size_t WS_VWT = WS_WST + NL * SZ_WS;
constexpr size_t WS_MEMN = WS_VWT + NL * SZ_WS;
constexpr size_t WS_KMEM = WS_MEMN + NL * SZ_MEM;
constexpr size_t WS_VMEM = WS_KMEM + NL * SZ_MEM;
constexpr size_t WS_ROPE = WS_VMEM + NL * SZ_MEM;
constexpr size_t WS_H = WS_ROPE + 2 * MiB;
constexpr size_t WS_HB = WS_H + (size_t)T * D * 4;
constexpr size_t WS_Z = WS_HB + (size_t)T * D * 2;
constexpr size_t WS_LA = WS_Z + (size_t)T * NZ * 2;
constexpr size_t WS_MIX = WS_LA + (size_t)T * 256 * 4;
constexpr size_t WS_UB = WS_MIX + (size_t)T * D * 2;
constexpr size_t WS_DEC = WS_UB + (size_t)4 * 128 * 64 * 128 * 4;
constexpr size_t WS_SB = WS_DEC + 1 * MiB;
constexpr size_t WS_SC = WS_SB + (size_t)4 * 128 * 64 * 128 * 2;
constexpr size_t WS_PB = WS_SC + (size_t)T * NSC * 4;
constexpr size_t WS_U = WS_PB + (size_t)T * NSC * 2;
constexpr size_t WS_HT = WS_U;
constexpr size_t WS_AB = WS_U + (size_t)T * NUP * 2;
constexpr size_t WS_SSP = WS_AB + (size_t)T * DFF * 2;
constexpr size_t WS_END = WS_SSP + (size_t)13 * T * 32 * 4;
constexpr int CW_TMO = 0, CW_BAR = 4096;

constexpr int RING_BYTES = 131072, MISC_OFF = RING_BYTES, LDS_BYTES = 147456;

__device__ __forceinline__ float bf2f(unsigned b) { return __uint_as_float(b << 16); }
typedef __bf16 bf16x2_t __attribute__((ext_vector_type(2)));
__device__ __forceinline__ unsigned pk2(float lo, float hi) { const f32x2 v = {lo, hi}; return __builtin_bit_cast(unsigned, __builtin_convertvector(v, bf16x2_t)); }
__device__ __forceinline__ unsigned f2bf(float f) { return pk2(f, 0.f) & 0xffffu; }
__device__ __forceinline__ unsigned cvt_pk_bf16(float lo, float hi) { unsigned r; asm volatile("v_cvt_pk_bf16_f32 %0, %1, %2" : "=v"(r) : "v"(lo), "v"(hi)); return r; }
__device__ __forceinline__ float shx(float v, int m, int lane) { return __builtin_bit_cast(float, __builtin_amdgcn_ds_bpermute((lane ^ m) << 2, __builtin_bit_cast(int, v))); }
__device__ __forceinline__ float wave_sum(float v, int lane) {
#pragma unroll
    for (int o = 1; o < 64; o <<= 1) v += shx(v, o, lane);
    return v;
}
__device__ __forceinline__ float wave_max(float v, int lane) {
#pragma unroll
    for (int o = 1; o < 64; o <<= 1) v = fmaxf(v, shx(v, o, lane));
    return v;
}
__device__ __forceinline__ float siluf(float x) { return x / (1.f + __expf(-x)); }
__device__ __forceinline__ float logsigf(float x) { return fminf(x, 0.f) - __logf(1.f + __expf(-fabsf(x))); }
__device__ __forceinline__ void st16_wt(void* p, u32x4 v) { *(u32x4*)p = v; }
#define LDS_WAIT() asm volatile("s_waitcnt lgkmcnt(0)" ::: "memory")
#define VM_WAIT() asm volatile("s_waitcnt vmcnt(0)" ::: "memory")

namespace pg8 {
constexpr int BM = 256, BK = 64, HALF = 128, HTB = HALF * BK * 2, STAGE_BYTES = 8 * HTB, NXCD = 8, WGM = 4;
__host__ __device__ __forceinline__ int lds_byte(int r, int c) { const int st = (r >> 4) * 2 + (c >> 5), rr = r & 15, cc = c & 31, ob = rr * 64 + cc * 2; return st * 1024 + (ob ^ (((ob >> 9) & 1) << 5)); }
__host__ __device__ __forceinline__ void stage_rc(int b, int& R, int& C) { const int st = b / 1024, sb = b % 1024, swz = sb ^ (((sb >> 9) & 1) << 5); R = (st >> 1) * 16 + swz / 64; C = (st & 1) * 32 + (swz % 64) / 2; }
__host__ __device__ __forceinline__ int perm32(int rho) { const int n = rho >> 4, i = rho & 15; return 8 * (i >> 2) + 4 * n + (i & 3); }

struct Unit { int pm, pn; const char* a; const char* b; char* o; int ldc; float sc; };
struct Gemm { int K, lda, ldb; };

struct TileOrder {
    const char* A; const char* Bt; int nM, nN, nwg, G, c; size_t ta, tb;
    __device__ __forceinline__ void init(const void* A_, const void* Bt_, int M, int N, int lda, int ldb, int G_, int c_) {
        A = (const char*)A_; Bt = (const char*)Bt_; nM = M / BM; nN = N / BM; nwg = nM * nN; G = G_; c = c_; ta = (size_t)BM * lda * 2; tb = (size_t)BM * ldb * 2; }
    __device__ __forceinline__ bool next(int i, Unit& u) const {
        const long L = (long)i * G + c; if (L >= nwg) return false;
        int wgid = (int)L; { const int q = nwg / NXCD, r = nwg % NXCD, xcd = wgid % NXCD, off = wgid / NXCD; wgid = (xcd < r ? xcd * (q + 1) : r * (q + 1) + (xcd - r) * q) + off; }
        const int nig = WGM * nN, gid = wgid / nig, fm = gid * WGM, gsz = (nM - fm) < WGM ? (nM - fm) : WGM;
        u.pm = fm + ((wgid % nig) % gsz); u.pn = (wgid % nig) / gsz;
        u.a = A + (size_t)u.pm * ta; u.b = Bt + (size_t)u.pn * tb; u.o = nullptr; u.ldc = 0; u.sc = 1.f; return true;
    }
    __device__ __forceinline__ void a_ready(const Unit&) const {}
    __device__ __forceinline__ void done(const Unit&) const {}
};

template <class Epi, class Sched, bool ALIGN_EPI>
__device__ __forceinline__ void gemm_phase(LAS unsigned char* lds, const Gemm g, const Sched& S, const Epi& E, int tid_in) {
    int tid_ = tid_in; asm volatile("" : "+v"(tid_));
    const int tid = tid_, wid = __builtin_amdgcn_readfirstlane(tid >> 6), lane = tid & 63, wr = wid >> 2, wc = wid & 3, fr = lane & 15, fq = lane >> 4;
    const int K = g.K, nt = K / BK;
    unsigned voffA[2], voffB[2];
#pragma unroll
    for (int i = 0; i < 2; ++i) { int R, C; stage_rc(tid * 16 + i * 8192, R, C); const int Rb = Epi::PERM ? ((R & ~31) + perm32(R & 31)) : R;
        const int Ra = Epi::ROWPERM ? ((R & 64) | ((R & 15) << 2) | ((R >> 4) & 3)) : R;
        voffA[i] = (unsigned)(Ra * g.lda + C) * 2u; voffB[i] = (unsigned)(Rb * g.ldb + C) * 2u; }
    const size_t kstep = (size_t)(BK * 2);
    const size_t hstepA = (size_t)HALF * g.lda * 2, hstepB = (size_t)HALF * g.ldb * 2;
    const unsigned ldsw = (unsigned)wid * 1024u;
    const int aoff = lds_byte(wr * 64 + fr, fq * 8), boff = lds_byte(wc * 32 + fr, fq * 8);
#define PG8_SA(b, h) (((b) * 2 + (h)) * HTB)
#define PG8_SB(b, h) ((4 + (b) * 2 + (h)) * HTB)
#define PG8_STAGE(bufoff, gbase, voff) do { _Pragma("unroll") for (int _i = 0; _i < 2; ++_i) \
        __builtin_amdgcn_global_load_lds((const unsigned*)((const char*)(gbase) + (voff)[_i]), (LAS unsigned*)(lds + (bufoff) + ldsw + _i * 8192), 16, 0, 0); } while (0)
#define PG8_LDA(dst, b, h) do { _Pragma("unroll") for (int m = 0; m < 4; ++m) _Pragma("unroll") for (int k = 0; k < 2; ++k) dst[m][k] = *(const LAS bf16x8*)(lds + PG8_SA(b, h) + aoff + m * 2048 + k * 1024); } while (0)
#define PG8_LDB(dst, b, h) do { _Pragma("unroll") for (int n = 0; n < 2; ++n) _Pragma("unroll") for (int k = 0; k < 2; ++k) dst[n][k] = *(const LAS bf16x8*)(lds + PG8_SB(b, h) + boff + n * 2048 + k * 1024); } while (0)
#define PG8_MMA(ai, bj, At, Bt) do { __builtin_amdgcn_s_setprio(1); _Pragma("unroll") for (int m = 0; m < 4; ++m) _Pragma("unroll") for (int n = 0; n < 2; ++n) _Pragma("unroll") for (int k = 0; k < 2; ++k) \
        acc[ai][bj][m][n] = __builtin_amdgcn_mfma_f32_16x16x32_bf16(Bt[n][k], At[m][k], acc[ai][bj][m][n], 0, 0, 0); __builtin_amdgcn_s_setprio(0); } while (0)
#define PG8_WAIT_V(n) asm volatile("s_waitcnt vmcnt(" #n ")" ::: "memory")
#define PG8_WAIT_L(n) asm volatile("s_waitcnt lgkmcnt(" #n ")" ::: "memory")
#define PG8_BAR __builtin_amdgcn_s_barrier()
#define PG8_SCHED __builtin_amdgcn_sched_barrier(0)
    Unit cur, nxt; int ui = 0;
    if (!S.next(0, cur)) return;
    f32x4 acc[2][2][4][2];
#pragma unroll
    for (int a = 0; a < 2; ++a)
#pragma unroll
        for (int b = 0; b < 2; ++b)
#pragma unroll
            for (int m = 0; m < 4; ++m)
#pragma unroll
                for (int n = 0; n < 2; ++n) acc[a][b][m][n] = (f32x4){0.f, 0.f, 0.f, 0.f};
    bf16x8 At[4][2], B0[2][2], B1[2][2];
    const char* cA = cur.a; const char* cB = cur.b;
    S.a_ready(cur);
    PG8_STAGE(PG8_SB(0, 0), cB, voffB); PG8_STAGE(PG8_SB(0, 1), cB + hstepB, voffB); PG8_STAGE(PG8_SA(0, 0), cA, voffA); PG8_STAGE(PG8_SA(0, 1), cA + hstepA, voffA);
    PG8_STAGE(PG8_SB(1, 0), cB + kstep, voffB); PG8_STAGE(PG8_SA(1, 0), cA + kstep, voffA); PG8_STAGE(PG8_SB(1, 1), cB + hstepB + kstep, voffB);
    if constexpr (Epi::PREFILL) E.prefill(tid);
    if (wr == 1) PG8_BAR;
    PG8_WAIT_V(8); PG8_BAR;
    PG8_WAIT_V(6); PG8_BAR;
    for (;;) {
        const bool has_next = S.next(ui + 1, nxt);
        const char* nA = has_next ? nxt.a : cA; const char* nB = has_next ? nxt.b : cB;
        for (int t = 0; t < nt; t += 2) {
            const bool last = (t == nt - 2);
            const char* a1 = cA + (size_t)(t + 1) * kstep;
            const char* a2 = last ? nA : cA + (size_t)(t + 2) * kstep; const char* b2 = last ? nB : cB + (size_t)(t + 2) * kstep;
            const char* a3 = a2 + kstep; const char* b3 = b2 + kstep;
            if (last && has_next) S.a_ready(nxt);
            PG8_LDB(B0, 0, 0); PG8_LDB(B1, 0, 1); PG8_SCHED; PG8_LDA(At, 0, 0); PG8_STAGE(PG8_SA(1, 1), a1 + hstepA, voffA);
            PG8_WAIT_V(8); PG8_WAIT_L(0); PG8_BAR; PG8_MMA(0, 0, At, B0); PG8_MMA(0, 1, At, B1); PG8_BAR; PG8_SCHED;
            PG8_LDA(At, 0, 1); PG8_STAGE(PG8_SB(0, 0), b2, voffB); PG8_STAGE(PG8_SB(0, 1), b2 + hstepB, voffB); PG8_STAGE(PG8_SA(0, 0), a2, voffA);
            PG8_WAIT_V(8); PG8_WAIT_L(0); PG8_BAR; PG8_MMA(1, 0, At, B0); PG8_MMA(1, 1, At, B1); PG8_BAR; PG8_SCHED;
            PG8_LDB(B0, 1, 0); PG8_LDB(B1, 1, 1); PG8_SCHED; PG8_LDA(At, 1, 0); PG8_STAGE(PG8_SA(0, 1), a2 + hstepA, voffA);
            PG8_WAIT_V(8); PG8_WAIT_L(0); PG8_BAR; PG8_MMA(0, 0, At, B0); PG8_MMA(0, 1, At, B1); PG8_BAR; PG8_SCHED;
            PG8_LDA(At, 1, 1); PG8_STAGE(PG8_SB(1, 0), b3, voffB); PG8_STAGE(PG8_SB(1, 1), b3 + hstepB, voffB); PG8_STAGE(PG8_SA(1, 0), a3, voffA);
            PG8_WAIT_V(8); PG8_WAIT_L(0); PG8_BAR; PG8_MMA(1, 0, At, B0); PG8_MMA(1, 1, At, B1); PG8_BAR; PG8_SCHED;
        }
        if constexpr (ALIGN_EPI) { if (wr == 0) PG8_BAR; }
        if constexpr (!Epi::AFTER_DRAIN) { int le; asm volatile("v_mbcnt_lo_u32_b32 %0, -1, 0\n\tv_mbcnt_hi_u32_b32 %0, -1, %0" : "=v"(le));
            E(acc, cur, wr, wc, le & 15, le >> 4); S.done(cur); }
        if (!has_next) break;
#pragma unroll
        for (int a = 0; a < 2; ++a)
#pragma unroll
            for (int b = 0; b < 2; ++b)
#pragma unroll
                for (int m = 0; m < 4; ++m)
#pragma unroll
                    for (int n = 0; n < 2; ++n) acc[a][b][m][n] = (f32x4){0.f, 0.f, 0.f, 0.f};
        cur = nxt; cA = nA; cB = nB; ++ui;
        if constexpr (ALIGN_EPI) { if (wr == 1) PG8_BAR; }
    }
    PG8_WAIT_V(0);
    if constexpr (!ALIGN_EPI) { if (wr == 0) PG8_BAR; }
    PG8_BAR;
    if constexpr (Epi::AFTER_DRAIN) { int le; asm volatile("v_mbcnt_lo_u32_b32 %0, -1, 0\n\tv_mbcnt_hi_u32_b32 %0, -1, %0" : "=v"(le)); E.fused(acc, cur, wr, wc, le & 15, le >> 4, lds, wid, le); S.done(cur); }
#undef PG8_SA
#undef PG8_SB
#undef PG8_STAGE
#undef PG8_LDA
#undef PG8_LDB
#undef PG8_MMA
#undef PG8_WAIT_V
#undef PG8_WAIT_L
#undef PG8_BAR
#undef PG8_SCHED
}


__device__ __forceinline__ float row_rstd_l(const float* ssp, int row, int fq, int lane) {
    const f32x4* p = (const f32x4*)(ssp + (size_t)row * 32 + 8 * fq); const f32x4 a = p[0], b = p[1];
    float s = ((a[0] + a[1]) + (a[2] + a[3])) + ((b[0] + b[1]) + (b[2] + b[3]));
    s += shx(s, 16, lane); s += shx(s, 32, lane);
    return rsqrtf(s * (1.f / D) + EPS);
}
__device__ __forceinline__ float row_rstd(const float* ssp, int row, int fq) { return row_rstd_l(ssp, row, fq, (row & 15) + 16 * fq); }
__device__ __forceinline__ void rstd8(const float* ssp, int row0, int fq, float (&rs)[2][4]) {
    f32x4 a[2][4], b[2][4];
#pragma unroll
    for (int ai = 0; ai < 2; ++ai)
#pragma unroll
        for (int m = 0; m < 4; ++m) { const f32x4* p = (const f32x4*)(ssp + (size_t)(row0 + ai * HALF + m * 16) * 32 + 8 * fq); a[ai][m] = p[0]; b[ai][m] = p[1]; }
#pragma unroll
    for (int ai = 0; ai < 2; ++ai)
#pragma unroll
        for (int m = 0; m < 4; ++m) rs[ai][m] = ((a[ai][m][0] + a[ai][m][1]) + (a[ai][m][2] + a[ai][m][3])) + ((b[ai][m][0] + b[ai][m][1]) + (b[ai][m][2] + b[ai][m][3]));
#pragma unroll
    for (int ai = 0; ai < 2; ++ai)
#pragma unroll
        for (int m = 0; m < 4; ++m) rs[ai][m] += shx(rs[ai][m], 16, (row0 & 15) + 16 * fq);
#pragma unroll
    for (int ai = 0; ai < 2; ++ai)
#pragma unroll
        for (int m = 0; m < 4; ++m) rs[ai][m] += shx(rs[ai][m], 32, (row0 & 15) + 16 * fq);
#pragma unroll
    for (int ai = 0; ai < 2; ++ai)
#pragma unroll
        for (int m = 0; m < 4; ++m) rs[ai][m] = rsqrtf(rs[ai][m] * (1.f / D) + EPS);
}
__device__ __forceinline__ void rstd_table_fill(const float* ssp, int tid) {
    LAS float* rtab = (LAS float*)(__builtin_amdgcn_groupstaticsize() + MISC_OFF + 1024);
    const int pm = 4 * ((int)blockIdx.x & 7) + (((int)blockIdx.x >> 3) & 3), row = tid >> 1, hf = tid & 1; const f32x4* p = (const f32x4*)(ssp + ((size_t)pm * 256 + row) * 32 + 16 * hf);
    const f32x4 a = p[0], b = p[1], c = p[2], d = p[3];
    float sacc = (((a[0] + a[1]) + (a[2] + a[3])) + ((b[0] + b[1]) + (b[2] + b[3]))) + (((c[0] + c[1]) + (c[2] + c[3])) + ((d[0] + d[1]) + (d[2] + d[3])));
    sacc += shx(sacc, 1, tid & 63);
    if (hf == 0) rtab[row] = rsqrtf(sacc * (1.f / D) + EPS);
    __syncthreads();
}
__device__ __forceinline__ void rstd8_tab(const float* ssp, const Unit& u, int wr, int fr, int fq, float (&rs)[2][4]) {
    const LAS float* rtab = (const LAS float*)(__builtin_amdgcn_groupstaticsize() + MISC_OFF + 1024);
    const int tab_pm = 4 * ((int)blockIdx.x & 7) + (((int)blockIdx.x >> 3) & 3);
    if (u.pm == tab_pm) {
#pragma unroll
        for (int ai = 0; ai < 2; ++ai)
#pragma unroll
            for (int m = 0; m < 4; ++m) rs[ai][m] = rtab[wr * 64 + fr + ai * HALF + m * 16];
    } else {
#pragma unroll
        for (int ai = 0; ai < 2; ++ai)
#pragma unroll
            for (int m = 0; m < 4; ++m) { rs[ai][m] = row_rstd(ssp, u.pm * BM + wr * 64 + fr + ai * HALF + m * 16, fq); asm volatile("" ::: "memory"); }
    }
}
__device__ __forceinline__ void rstd8_tab4(const float* ssp, const Unit& u, int wr, int fr, int fq, float (&rs)[2][4]) {
    const LAS float* rtab = (const LAS float*)(__builtin_amdgcn_groupstaticsize() + MISC_OFF + 1024);
    const int tab_pm = 4 * ((int)blockIdx.x & 7) + (((int)blockIdx.x >> 3) & 3);
    if (u.pm == tab_pm) {
#pragma unroll
        for (int ai = 0; ai < 2; ++ai) { const f32x4 q = *(const LAS f32x4*)(rtab + wr * 64 + ai * HALF + 4 * fr); rs[ai][0] = q[0]; rs[ai][1] = q[1]; rs[ai][2] = q[2]; rs[ai][3] = q[3]; }
    } else {
#pragma unroll
        for (int ai = 0; ai < 2; ++ai)
#pragma unroll
            for (int m = 0; m < 4; ++m) { rs[ai][m] = row_rstd_l(ssp, u.pm * BM + wr * 64 + ai * HALF + 4 * fr + m, fq, fr + 16 * fq); asm volatile("" ::: "memory"); }
    }
}
struct EpiScaleBf16 {
    static constexpr bool PERM = true, AFTER_DRAIN = false, PREFILL = true, ROWPERM = false;
    __device__ __forceinline__ void prefill(int tid) const { rstd_table_fill(ss, tid); }
    bf16_t* O; int ldc; const float* ss; int gate_pn; float* la; const float* bg;
    __device__ __forceinline__ void operator()(const f32x4 (&acc)[2][2][4][2], const Unit& u, int wr, int wc, int fr, int fq) const {
        const int row0 = u.pm * BM + wr * 64 + fr, cl = wc * 32 + 8 * fq;
        float rs8[2][4]; rstd8_tab(ss, u, wr, fr, fq, rs8);
        if (u.pn == gate_pn) {
#pragma unroll
            for (int ai = 0; ai < 2; ++ai)
#pragma unroll
                for (int m = 0; m < 4; ++m) { const int row = row0 + ai * HALF + m * 16; const float rs = rs8[ai][m];
#pragma unroll
                    for (int bj = 0; bj < 2; ++bj) { const int c = bj * HALF + cl; const f32x4 b0 = *(const f32x4*)(bg + c), b1 = *(const f32x4*)(bg + c + 4);
                        f32x4 v0 = acc[ai][bj][m][0] * rs + b0, v1 = acc[ai][bj][m][1] * rs + b1;
#pragma unroll
                        for (int e = 0; e < 4; ++e) { v0[e] = logsigf(v0[e]) * (1.f / 16.f); v1[e] = logsigf(v1[e]) * (1.f / 16.f); }
                        *(f32x4*)(la + (size_t)row * 256 + c) = v0; *(f32x4*)(la + (size_t)row * 256 + c + 4) = v1; } }
        } else {
#pragma unroll
            for (int ai = 0; ai < 2; ++ai)
#pragma unroll
                for (int m = 0; m < 4; ++m) { const int row = row0 + ai * HALF + m * 16; const float rs = rs8[ai][m];
                    bf16_t* rowp = O + (size_t)row * ldc + u.pn * BM + cl;
#pragma unroll
                    for (int bj = 0; bj < 2; ++bj) { const f32x4 v0 = acc[ai][bj][m][0] * rs, v1 = acc[ai][bj][m][1] * rs;
                        u32x4 w; w.x = cvt_pk_bf16(v0[0], v0[1]); w.y = cvt_pk_bf16(v0[2], v0[3]); w.z = cvt_pk_bf16(v1[0], v1[1]); w.w = cvt_pk_bf16(v1[2], v1[3]);
                        st16_wt(rowp + bj * HALF, w); } }
        }
    }
};
struct EpiPlain {
    static constexpr bool PERM = true, AFTER_DRAIN = false, PREFILL = false, ROWPERM = false;
    __device__ __forceinline__ void operator()(const f32x4 (&acc)[2][2][4][2], const Unit& u, int wr, int wc, int fr, int fq) const {
        const int row0 = u.pm * BM + wr * 64 + fr, cl = u.pn * BM + wc * 32 + 8 * fq; const float sc = u.sc; bf16_t* O = (bf16_t*)u.o;
#pragma unroll
        for (int ai = 0; ai < 2; ++ai)
#pragma unroll
            for (int m = 0; m < 4; ++m) { bf16_t* rowp = O + (size_t)(row0 + ai * HALF + m * 16) * u.ldc + cl;
#pragma unroll
                for (int bj = 0; bj < 2; ++bj) { const f32x4 v0 = acc[ai][bj][m][0] * sc, v1 = acc[ai][bj][m][1] * sc;
                    u32x4 w; w.x = cvt_pk_bf16(v0[0], v0[1]); w.y = cvt_pk_bf16(v0[2], v0[3]); w.z = cvt_pk_bf16(v1[0], v1[1]); w.w = cvt_pk_bf16(v1[2], v1[3]);
                    st16_wt(rowp + bj * HALF, w); } }
    }
};
struct EpiScaleF32 {
    static constexpr bool PERM = false, AFTER_DRAIN = false, PREFILL = false, ROWPERM = false;
    float* O; int ldc; const float* ss;
    __device__ __forceinline__ void operator()(const f32x4 (&acc)[2][2][4][2], const Unit& u, int wr, int wc, int fr, int fq) const {
        const int row0 = u.pm * BM + wr * 64 + fr, c0 = u.pn * BM + wc * 32 + 4 * fq;
#pragma unroll
        for (int ai = 0; ai < 2; ++ai)
#pragma unroll
            for (int m = 0; m < 4; ++m) { const int row = row0 + ai * HALF + m * 16; const float rs = row_rstd(ss, row, fq);
#pragma unroll
                for (int bj = 0; bj < 2; ++bj)
#pragma unroll
                    for (int n = 0; n < 2; ++n) *(f32x4*)(O + (size_t)row * ldc + c0 + bj * HALF + n * 16) = acc[ai][bj][m][n] * rs; }
    }
};
struct EpiRes {
    static constexpr bool PERM = true, AFTER_DRAIN = false, PREFILL = false, ROWPERM = false;
    bf16_t* hb; float* ssn;
    __device__ __forceinline__ void operator()(const f32x4 (&acc)[2][2][4][2], const Unit& u, int wr, int wc, int fr, int fq) const {
        const int row0 = u.pm * BM + wr * 64 + fr, c0 = u.pn * BM + wc * 32 + 8 * fq;
        u32x4 pre[2][4][2];
#pragma unroll
        for (int ai = 0; ai < 2; ++ai)
#pragma unroll
            for (int m = 0; m < 4; ++m)
#pragma unroll
                for (int bj = 0; bj < 2; ++bj) pre[ai][m][bj] = *(const u32x4*)(hb + (size_t)(row0 + ai * HALF + m * 16) * D + c0 + bj * HALF);
#pragma unroll
        for (int ai = 0; ai < 2; ++ai)
#pragma unroll
            for (int m = 0; m < 4; ++m) { const int row = row0 + ai * HALF + m * 16; const size_t off = (size_t)row * D + c0; float s = 0.f;
#pragma unroll
                for (int bj = 0; bj < 2; ++bj) { const u32x4 b = pre[ai][m][bj]; const f32x4 a0 = acc[ai][bj][m][0], a1 = acc[ai][bj][m][1];
                    const float o0 = bf2f(b.x & 0xffffu) + a0[0], o1 = bf2f(b.x >> 16) + a0[1], o2 = bf2f(b.y & 0xffffu) + a0[2], o3 = bf2f(b.y >> 16) + a0[3];
                    const float o4 = bf2f(b.z & 0xffffu) + a1[0], o5 = bf2f(b.z >> 16) + a1[1], o6 = bf2f(b.w & 0xffffu) + a1[2], o7 = bf2f(b.w >> 16) + a1[3];
                    u32x4 w; w.x = cvt_pk_bf16(o0, o1); w.y = cvt_pk_bf16(o2, o3); w.z = cvt_pk_bf16(o4, o5); w.w = cvt_pk_bf16(o6, o7); st16_wt(hb + off + bj * HALF, w);
                    s += ((o0 * o0 + o1 * o1) + (o2 * o2 + o3 * o3)) + ((o4 * o4 + o5 * o5) + (o6 * o6 + o7 * o7)); }
                s += shx(s, 16, fr + 16 * fq); s += shx(s, 32, fr + 16 * fq);
                if (fq == 0) ssn[(size_t)row * 32 + u.pn * 4 + wc] = s; }
    }
};
__device__ __forceinline__ void conv_wrap(f32x4& G0, f32x4& G1, const f32x4& u2, const f32x4& u3, const f32x4& w1, const f32x4& w0) {
    asm("s_nop 1\n\t"
        "v_fmac_f32_dpp %0, %12, %16 row_shr:1 row_mask:0xf bank_mask:0xf\n\t"
        "v_fmac_f32_dpp %1, %13, %17 row_shr:1 row_mask:0xf bank_mask:0xf\n\t"
        "v_fmac_f32_dpp %2, %14, %18 row_shr:1 row_mask:0xf bank_mask:0xf\n\t"
        "v_fmac_f32_dpp %3, %15, %19 row_shr:1 row_mask:0xf bank_mask:0xf\n\t"
        "v_fmac_f32_dpp %0, %8, %20 row_shr:1 row_mask:0xf bank_mask:0xf\n\t"
        "v_fmac_f32_dpp %1, %9, %21 row_shr:1 row_mask:0xf bank_mask:0xf\n\t"
        "v_fmac_f32_dpp %2, %10, %22 row_shr:1 row_mask:0xf bank_mask:0xf\n\t"
        "v_fmac_f32_dpp %3, %11, %23 row_shr:1 row_mask:0xf bank_mask:0xf\n\t"
        "v_fmac_f32_dpp %4, %12, %20 row_shr:1 row_mask:0xf bank_mask:0xf\n\t"
        "v_fmac_f32_dpp %5, %13, %21 row_shr:1 row_mask:0xf bank_mask:0xf\n\t"
        "v_fmac_f32_dpp %6, %14, %22 row_shr:1 row_mask:0xf bank_mask:0xf\n\t"
        "v_fmac_f32_dpp %7, %15, %23 row_shr:1 row_mask:0xf bank_mask:0xf"
        : "+v"(G0[0]), "+v"(G0[1]), "+v"(G0[2]), "+v"(G0[3]), "+v"(G1[0]), "+v"(G1[1]), "+v"(G1[2]), "+v"(G1[3])
        : "v"(u2[0]), "v"(u2[1]), "v"(u2[2]), "v"(u2[3]), "v"(u3[0]), "v"(u3[1]), "v"(u3[2]), "v"(u3[3]), "v"(w1[0]), "v"(w1[1]), "v"(w1[2]), "v"(w1[3]), "v"(w0[0]), "v"(w0[1]), "v"(w0[2]), "v"(w0[3]));
}
__device__ __forceinline__ float exp_sub(float x, float mL) { return __builtin_amdgcn_exp2f(__builtin_fmaf(x, 1.44269504088896341f, -mL)); }
__device__ __forceinline__ float silu_fast(float x) { return x * __builtin_amdgcn_rcpf(1.f + __expf(-x)); }
struct EpiUpConv {
    static constexpr bool PERM = true, AFTER_DRAIN = false, PREFILL = true, ROWPERM = true;
    __device__ __forceinline__ void prefill(int tid) const { rstd_table_fill(ss, tid); }
    bf16_t* AB; bf16_t* HT; const float* ss; const float* wcv; const float* bcv;
    __device__ __forceinline__ void operator()(const f32x4 (&acc)[2][2][4][2], const Unit& u, int wr, int wc, int fr, int fq) const {
        const int row0 = u.pm * BM + wr * 64 + 4 * fr, chl = wc * 32 + 8 * fq, ch0 = u.pn * 128 + chl;
        float rs8[2][4]; rstd8_tab4(ss, u, wr, fr, fq, rs8);
        u32x2 keep[2][4];
        u32x2 hk[2][4];
#pragma unroll
        for (int n = 0; n < 2; ++n) {
            const int ch = ch0 + 4 * n;
            const f32x4 wg0 = *(const f32x4*)(wcv + ch), wg1 = *(const f32x4*)(wcv + NUP + ch), wg2 = *(const f32x4*)(wcv + 2 * NUP + ch), bg = *(const f32x4*)(bcv + ch);
            const f32x4 wv0 = *(const f32x4*)(wcv + DFF + ch), wv1 = *(const f32x4*)(wcv + NUP + DFF + ch), wv2 = *(const f32x4*)(wcv + 2 * NUP + DFF + ch), bv = *(const f32x4*)(bcv + DFF + ch);
#pragma unroll
            for (int ai = 0; ai < 2; ++ai) {
                const int kb = u.pm * 4 + ai * 2 + wr;
                f32x4 ug[4], uv[4];
#pragma unroll
                for (int m = 0; m < 4; ++m) { ug[m] = acc[ai][0][m][n] * rs8[ai][m]; uv[m] = acc[ai][1][m][n] * rs8[ai][m]; }
                {   const bool tail = (fr == 15);
                    const f32x4 g0 = tail ? ug[2] : ug[0], g1 = tail ? ug[3] : ug[1], v0 = tail ? uv[2] : uv[0], v1 = tail ? uv[3] : uv[1];
                    u32x2 q[4]; q[0].x = cvt_pk_bf16(g0[0], g0[1]); q[0].y = cvt_pk_bf16(g0[2], g0[3]); q[1].x = cvt_pk_bf16(g1[0], g1[1]); q[1].y = cvt_pk_bf16(g1[2], g1[3]);
                    q[2].x = cvt_pk_bf16(v0[0], v0[1]); q[2].y = cvt_pk_bf16(v0[2], v0[3]); q[3].x = cvt_pk_bf16(v1[0], v1[1]); q[3].y = cvt_pk_bf16(v1[2], v1[3]);
                    if (n == 0) {
#pragma unroll
                        for (int k = 0; k < 4; ++k) hk[ai][k] = q[k];
                    } else if (fr == 0 || tail) { bf16_t* hb2 = HT + ((size_t)kb * 4 + (tail ? 2 : 0)) * NUP + u.pn * 256 + chl;
                        *(u32x4*)hb2 = (u32x4){hk[ai][0].x, hk[ai][0].y, q[0].x, q[0].y}; *(u32x4*)(hb2 + NUP) = (u32x4){hk[ai][1].x, hk[ai][1].y, q[1].x, q[1].y};
                        *(u32x4*)(hb2 + 128) = (u32x4){hk[ai][2].x, hk[ai][2].y, q[2].x, q[2].y}; *(u32x4*)(hb2 + NUP + 128) = (u32x4){hk[ai][3].x, hk[ai][3].y, q[3].x, q[3].y}; } }
                f32x4 G[4], V[4];
                G[0] = bg + wg2 * ug[0];                               V[0] = bv + wv2 * uv[0];
                G[1] = bg + wg2 * ug[1] + wg1 * ug[0];                 V[1] = bv + wv2 * uv[1] + wv1 * uv[0];
                G[2] = bg + wg2 * ug[2] + wg1 * ug[1] + wg0 * ug[0];   V[2] = bv + wv2 * uv[2] + wv1 * uv[1] + wv0 * uv[0];
                G[3] = bg + wg2 * ug[3] + wg1 * ug[2] + wg0 * ug[1];   V[3] = bv + wv2 * uv[3] + wv1 * uv[2] + wv0 * uv[1];
                conv_wrap(G[0], G[1], ug[2], ug[3], wg1, wg0); conv_wrap(V[0], V[1], uv[2], uv[3], wv1, wv0);
#pragma unroll
                for (int m = 0; m < 4; ++m) { float o[4];
#pragma unroll
                    for (int e = 0; e < 4; ++e) o[e] = silu_fast(G[m][e]) * V[m][e];
                    u32x2 w; w.x = cvt_pk_bf16(o[0], o[1]); w.y = cvt_pk_bf16(o[2], o[3]);
                    if (n == 0) keep[ai][m] = w; else st16_wt(AB + (size_t)(row0 + ai * HALF + m) * DFF + ch0, (u32x4){keep[ai][m].x, keep[ai][m].y, w.x, w.y}); }
            }
        }
    }
};
struct EpiSoftmax {
    static constexpr bool PERM = true, AFTER_DRAIN = true, PREFILL = true, ROWPERM = false;
    __device__ __forceinline__ void prefill(int tid) const { rstd_table_fill(ss, tid); }
    bf16_t* P; const float* ss;
    __device__ __forceinline__ void fused(f32x4 (&acc)[2][2][4][2], const Unit& u, int wr, int wc, int fr, int fq, LAS unsigned char* lds, int wid, int lane) const {
        LAS float* MX = (LAS float*)lds; LAS float* SM = MX + 1024;
        const int rl0 = wr * 64 + fr, row0 = u.pm * BM + rl0;
        float rs8[2][4]; rstd8_tab(ss, u, wr, fr, fq, rs8);
#pragma unroll
        for (int ai = 0; ai < 2; ++ai)
#pragma unroll
            for (int m = 0; m < 4; ++m) { const float rs = rs8[ai][m]; float mx = -INFINITY;
#pragma unroll
                for (int bj = 0; bj < 2; ++bj)
#pragma unroll
                    for (int n = 0; n < 2; ++n) { f32x4 v = acc[ai][bj][m][n] * rs; acc[ai][bj][m][n] = v; mx = fmaxf(fmaxf(mx, fmaxf(v[0], v[1])), fmaxf(v[2], v[3])); }
                mx = fmaxf(mx, shx(mx, 16, lane)); mx = fmaxf(mx, shx(mx, 32, lane));
                if (fq == 0) MX[(rl0 + ai * HALF + m * 16) * 4 + wc] = mx; }
        asm volatile("s_waitcnt lgkmcnt(0)" ::: "memory"); __builtin_amdgcn_s_barrier(); asm volatile("" ::: "memory");
#pragma unroll
        for (int ai = 0; ai < 2; ++ai)
#pragma unroll
            for (int m = 0; m < 4; ++m) { const f32x4 q = *(const LAS f32x4*)(MX + (rl0 + ai * HALF + m * 16) * 4); const float mx = fmaxf(fmaxf(q[0], q[1]), fmaxf(q[2], q[3])), mxL = mx * 1.44269504088896341f; float sm = 0.f;
#pragma unroll
                for (int bj = 0; bj < 2; ++bj)
#pragma unroll
                    for (int n = 0; n < 2; ++n) { f32x4 v = acc[ai][bj][m][n];
#pragma unroll
                        for (int e = 0; e < 4; ++e) { v[e] = exp_sub(v[e], mxL); sm += v[e]; }
                        acc[ai][bj][m][n] = v; }
                sm += shx(sm, 16, lane); sm += shx(sm, 32, lane);
                if (fq == 0) SM[(rl0 + ai * HALF + m * 16) * 4 + wc] = sm; }
        asm volatile("s_waitcnt lgkmcnt(0)" ::: "memory"); __builtin_amdgcn_s_barrier(); asm volatile("" ::: "memory");
        const int cl = u.pn * BM + wc * 32 + 8 * fq;
#pragma unroll
        for (int ai = 0; ai < 2; ++ai)
#pragma unroll
            for (int m = 0; m < 4; ++m) { const f32x4 q = *(const LAS f32x4*)(SM + (rl0 + ai * HALF + m * 16) * 4); const float inv = 1.f / ((q[0] + q[1]) + (q[2] + q[3]));
                bf16_t* rowp = P + (size_t)(row0 + ai * HALF + m * 16) * NSC + cl;
#pragma unroll
                for (int bj = 0; bj < 2; ++bj) { const f32x4 v0 = acc[ai][bj][m][0] * inv, v1 = acc[ai][bj][m][1] * inv;
                    u32x4 w; w.x = cvt_pk_bf16(v0[0], v0[1]); w.y = cvt_pk_bf16(v0[2], v0[3]); w.z = cvt_pk_bf16(v1[0], v1[1]); w.w = cvt_pk_bf16(v1[2], v1[3]);
                    st16_wt(rowp + bj * HALF, w); } }
    }
};
}

#define XB_TMO      128
#define XB_XCNT(j)  (256  + 64 * (j))
#define XB_XSUB(j)  (1280 + 64 * (j))
#define XB_XGEN(j)  (2304 + 64 * (j))
#define XB_TOP      3328
#define XB_TOPGEN   3392
#define XCD_BAR_WORDS 3456
#define XB_SPIN_CAP (1u << 18)
__device__ __forceinline__ unsigned xb_ld(unsigned* p)              { return __hip_atomic_load(p, __ATOMIC_RELAXED, __HIP_MEMORY_SCOPE_AGENT); }
__device__ __forceinline__ unsigned xb_add(unsigned* p, unsigned v) { return __hip_atomic_fetch_add(p, v, __ATOMIC_RELAXED, __HIP_MEMORY_SCOPE_AGENT); }
__device__ __forceinline__ unsigned xb_xcc_id() { return (unsigned)__builtin_amdgcn_s_getreg((3 << 11) | 20) & 0xFu; }
#define XB_SPIN(cond, bar) do { unsigned _sp = 0; while (cond) { __builtin_amdgcn_s_sleep(1); \
    if ((++_sp & 255u) == 0u) { if (xb_ld(&(bar)[XB_TMO])) break; if (_sp > XB_SPIN_CAP) { atomicAdd(&(bar)[XB_TMO], 1u); break; } } } } while (0)
struct XcdBarrier { unsigned* bar; unsigned x; volatile LAS unsigned* st; };
__device__ __forceinline__ XcdBarrier xcd_barrier_post(unsigned* bar, volatile LAS unsigned* st) {
    XcdBarrier b; b.bar = bar; b.x = xb_xcc_id(); b.st = st;
    if (threadIdx.x == 0) (void)xb_add(&bar[XB_XCNT(b.x)], 1u);
    return b;
}
__device__ __forceinline__ void xcd_barrier_complete(unsigned* bar, unsigned x, unsigned& nloc, unsigned& nx) {
    const unsigned G = gridDim.x * gridDim.y * gridDim.z;
    unsigned sum, cnt, mine, sp = 0u;
    for (;;) {
        sum = 0u; cnt = 0u; mine = 0u;
#pragma unroll
        for (unsigned j = 0; j < 16; ++j) { const unsigned c = xb_ld(&bar[XB_XCNT(j)]); sum += c; cnt += (c > 0u) ? 1u : 0u; mine = (j == x) ? c : mine; }
        if (sum == G) break;
        __builtin_amdgcn_s_sleep(1);
        if ((++sp & 255u) == 0u) { if (xb_ld(&bar[XB_TMO])) break; if (sp > XB_SPIN_CAP) { atomicAdd(&bar[XB_TMO], 1u); break; } }
    }
    nloc = mine > 0u ? mine : 1u; nx = cnt > 0u ? cnt : 1u;
}
__device__ __forceinline__ void xcd_barrier(const XcdBarrier& b) {
    asm volatile("s_waitcnt vmcnt(0)" ::: "memory");
    __syncthreads();
    if (threadIdx.x == 0) {
        unsigned* bar = b.bar;
        __builtin_amdgcn_s_waitcnt(0);
        unsigned nloc = b.st[0], nx = b.st[1];
        if (nloc == 0u) { xcd_barrier_complete(bar, b.x, nloc, nx); b.st[0] = nloc; b.st[1] = nx; }
        const unsigned old = xb_add(&bar[XB_XSUB(b.x)], 1u);
        const unsigned gen = old / nloc;
        if (old + 1u == (gen + 1u) * nloc) {
            __builtin_amdgcn_fence(__ATOMIC_RELEASE, "agent");
            asm volatile("s_waitcnt vmcnt(0)" ::: "memory");
            const unsigned og = xb_add(&bar[XB_TOP], 1u);
            const unsigned tg = og / nx;
            if (og + 1u == (tg + 1u) * nx) xb_add(&bar[XB_TOPGEN], 1u);
            else XB_SPIN(xb_ld(&bar[XB_TOPGEN]) == tg, bar);
            __builtin_amdgcn_fence(__ATOMIC_ACQUIRE, "agent");
            xb_add(&bar[XB_XGEN(b.x)], 1u);
            asm volatile("s_waitcnt vmcnt(0)" ::: "memory");
        } else {
            XB_SPIN(xb_ld(&bar[XB_XGEN(b.x)]) == gen, bar);
            __builtin_amdgcn_fence(__ATOMIC_ACQUIRE, "agent");
            asm volatile("s_waitcnt vmcnt(0)" ::: "memory");
        }
    }
    __syncthreads();
}

struct Args { const void* in[23]; float* out; unsigned char* ws; int ph_lo, ph_hi; };
struct Frame {
    LAS unsigned char* lds; unsigned char* ws;
    int tid, lane, wave, G, bid;
};
__device__ __forceinline__ const void* in_ptr(int k) {
    const __attribute__((address_space(4))) char* kp = (const __attribute__((address_space(4))) char*)__builtin_amdgcn_kernarg_segment_ptr();
    asm volatile("" : "+s"(kp));
    return *(const void* const __attribute__((address_space(4)))*)(kp + 8 * k);
}
__device__ __forceinline__ unsigned char* ws_ptr() {
    const __attribute__((address_space(4))) char* kp = (const __attribute__((address_space(4))) char*)__builtin_amdgcn_kernarg_segment_ptr();
    asm volatile("" : "+s"(kp));
    return *(unsigned char* const __attribute__((address_space(4)))*)(kp + 8 * 24);
}
template <class Tp> __device__ __forceinline__ Tp* wsp(const Frame& F, size_t off) { return (Tp*)(F.ws + off); }
__device__ __forceinline__ float* ss_ptr(const Frame& F, int idx) { return (float*)(F.ws + WS_SSP) + (size_t)idx * T * 32; }

struct BlkDesc { const float* src; bf16_t* dst; const float* g; int ldw, K; };
constexpr int NA_IN = 32 * 68, NA_22 = 32 * 32, NA_UP = 32 * 176, NA_DN = 88 * 32, NA = NA_IN + NA_22 + NA_UP + NA_DN, NB = 3 * NA_22;
constexpr int NA_HEAD = NA_IN + NA_22, CV_T = NA_HEAD + 5100;
__device__ __forceinline__ BlkDesc desc_a(const Frame& F, int l, int r) {
    BlkDesc d;
    if (r < NA_IN) {
        const int kb = r / 68, nb = r % 68, sc0 = nb < 24 ? 64 * nb : 1552 + 64 * (nb - 24), dr0 = nb < 24 ? 64 * nb : 1792 + 64 * (nb - 24);
        d.src = (const float*)in_ptr(4) + (size_t)l * D * NIN + (size_t)(64 * kb) * NIN + sc0; d.dst = wsp<bf16_t>(F, WS_WIN + l * SZ_WIN) + (size_t)dr0 * D + 64 * kb; d.g = (const float*)in_ptr(3) + l * D + 64 * kb; d.ldw = NIN; d.K = D; return d; }
    r -= NA_IN;
    if (r < NA_22) { const int kb = r / 32, nb = r % 32;
        d.src = (const float*)in_ptr(10) + (size_t)l * D * D + (size_t)(64 * kb) * D + 64 * nb; d.dst = wsp<bf16_t>(F, WS_WOUT + l * SZ_W22) + (size_t)(64 * nb) * D + 64 * kb; d.g = nullptr; d.ldw = D; d.K = D; return d; }
    r -= NA_22;
    if (r < NA_UP) { const int kb = r / 176, nb = r % 176, c = 64 * nb, bj = c >= DFF ? 1 : 0, ch = c - DFF * bj, dr0 = 256 * (ch >> 7) + 128 * bj + (ch & 127);
        d.src = (const float*)in_ptr(18) + (size_t)l * D * NUP + (size_t)(64 * kb) * NUP + c; d.dst = wsp<bf16_t>(F, WS_WUP + l * SZ_WUP) + (size_t)dr0 * D + 64 * kb; d.g = (const float*)in_ptr(17) + l * D + 64 * kb; d.ldw = NUP; d.K = D; return d; }
    r -= NA_UP;
    { const int kb = r / 32, nb = r % 32;
        d.src = (const float*)in_ptr(21) + (size_t)l * DFF * D + (size_t)(64 * kb) * D + 64 * nb; d.dst = wsp<bf16_t>(F, WS_WDN + l * SZ_WDN) + (size_t)(64 * nb) * DFF + 64 * kb; d.g = nullptr; d.ldw = D; d.K = DFF; return d; }
}
__device__ __forceinline__ BlkDesc desc_b(const Frame& F, int l, int r) {
    BlkDesc d; const int w = r / NA_22, q = r % NA_22, kb = q / 32, nb = q % 32;
    d.src = (const float*)(w == 0 ? in_ptr(14) : w == 1 ? in_ptr(15) : in_ptr(16)) + (size_t)l * D * D + (size_t)(64 * kb) * D + 64 * nb;
    d.dst = wsp<bf16_t>(F, (w == 0 ? WS_WK : w == 1 ? WS_WV : WS_WO) + l * SZ_W22) + (size_t)(64 * nb) * D + 64 * kb; d.g = nullptr; d.ldw = D; d.K = D; return d;
}
__device__ __forceinline__ void blk_load(const BlkDesc& d, f32x4 (&v)[16], int lane) {
    const float* p = d.src + (size_t)(lane >> 4) * d.ldw + 4 * (lane & 15);
#pragma unroll
    for (int i = 0; i < 16; ++i) v[i] = __builtin_nontemporal_load((const f32x4*)(p + (size_t)(4 * i) * d.ldw));
}
__device__ __forceinline__ void blk_to_lds(const BlkDesc& d, const f32x4 (&v)[16], LAS float* scr, int lane) {
    const int kr = lane >> 4, cg = lane & 15;
#pragma unroll
    for (int i = 0; i < 16; ++i) { const int k = 4 * i + kr; f32x4 x = v[i]; if (d.g) x = x * d.g[k]; *(LAS f32x4*)(scr + k * 64 + ((cg ^ (k >> 3)) << 2)) = x; }
    LDS_WAIT(); asm volatile("" ::: "memory");
}
template <bool NTS> __device__ __forceinline__ void blk_store(const BlkDesc& d, LAS float* scr, int lane) {
    const int n0 = lane >> 3, c = lane & 7;
#pragma unroll
    for (int j = 0; j < 8; ++j) { const int n = n0 + 8 * j; const LAS float* sp = scr + (8 * c) * 64 + ((((n >> 2) ^ c) << 2) | (n & 3));
        u32x4 o; o.x = pk2(sp[0 * 64], sp[1 * 64]); o.y = pk2(sp[2 * 64], sp[3 * 64]); o.z = pk2(sp[4 * 64], sp[5 * 64]); o.w = pk2(sp[6 * 64], sp[7 * 64]);
        if constexpr (NTS) __builtin_nontemporal_store(o, (u32x4*)(d.dst + (size_t)n * d.K + 8 * c)); else *(u32x4*)(d.dst + (size_t)n * d.K + 8 * c) = o; }
    LDS_WAIT(); asm volatile("" ::: "memory");
}
template <bool TYPE_B, bool NTS = false, int SLP = 0> __device__ __forceinline__ void convert_blocks(const Frame& F, int l, int lo, int hi, int wv, int nw) {
    LAS float* scr = (LAS float*)(F.lds + F.wave * 16384); const int lane = F.lane;
    int it = lo + wv; if (it >= hi) return;
    f32x4 v[16]; BlkDesc d = TYPE_B ? desc_b(F, l, it) : desc_a(F, l, it); blk_load(d, v, lane);
    for (;;) {
        blk_to_lds(d, v, scr, lane);
        const int itn = it + nw; const bool hn = itn < hi; BlkDesc dn = d;
        if (hn) { dn = TYPE_B ? desc_b(F, l, itn) : desc_a(F, l, itn); blk_load(dn, v, lane); }
        blk_store<NTS>(d, scr, lane);
        if (!hn) break;
        if constexpr (SLP > 0) __builtin_amdgcn_s_sleep(SLP);
        it = itn; d = dn;
    }
}
__device__ __forceinline__ void fold_gate_item(const Frame& F, int l, int item) {
    LAS float* scr = (LAS float*)(F.lds + F.wave * 16384);
    const int kb = item >> 2, cq = item & 3, lane = F.lane, k = 64 * kb + lane; const float* wrow = (const float*)in_ptr(4) + ((size_t)l * D + k) * NIN + 1536;
    {   const float* wg = (const float*)in_ptr(5) + (size_t)l * 16 * 256 + (lane >> 2) * 256 + 64 * cq + 16 * (lane & 3); LAS float* dp = scr + (lane >> 2) * 64 + 16 * (lane & 3);
#pragma unroll
        for (int q = 0; q < 4; ++q) *(LAS f32x4*)(dp + 4 * q) = *(const f32x4*)(wg + 4 * q); }
    const f32x4 l0 = *(const f32x4*)wrow, l1 = *(const f32x4*)(wrow + 4), l2 = *(const f32x4*)(wrow + 8), l3 = *(const f32x4*)(wrow + 12);
    const float lr[16] = {l0[0], l0[1], l0[2], l0[3], l1[0], l1[1], l1[2], l1[3], l2[0], l2[1], l2[2], l2[3], l3[0], l3[1], l3[2], l3[3]};
    const float gk = ((const float*)in_ptr(3))[l * D + k]; bf16_t* WT = wsp<bf16_t>(F, WS_WIN + l * SZ_WIN) + (size_t)(1536 + 64 * cq) * D + k;
    LDS_WAIT(); asm volatile("" ::: "memory");
#pragma unroll 1
    for (int cc = 0; cc < 4; ++cc) { float a[16];
#pragma unroll
        for (int j = 0; j < 16; ++j) a[j] = 0.f;
#pragma unroll
        for (int r = 0; r < 16; ++r) { const LAS f32x4* wp = (const LAS f32x4*)(scr + r * 64 + 16 * cc); const f32x4 w0 = wp[0], w1 = wp[1], w2 = wp[2], w3 = wp[3];
            a[0] += lr[r] * w0[0]; a[1] += lr[r] * w0[1]; a[2] += lr[r] * w0[2]; a[3] += lr[r] * w0[3]; a[4] += lr[r] * w1[0]; a[5] += lr[r] * w1[1]; a[6] += lr[r] * w1[2]; a[7] += lr[r] * w1[3];
            a[8] += lr[r] * w2[0]; a[9] += lr[r] * w2[1]; a[10] += lr[r] * w2[2]; a[11] += lr[r] * w2[3]; a[12] += lr[r] * w3[0]; a[13] += lr[r] * w3[1]; a[14] += lr[r] * w3[2]; a[15] += lr[r] * w3[3];
            asm volatile("" ::: "memory"); }
#pragma unroll
        for (int j = 0; j < 16; ++j) WT[(size_t)(16 * cc + j) * D] = (bf16_t)f2bf(a[j] * gk); }
    LDS_WAIT(); asm volatile("" ::: "memory");
}
__device__ __forceinline__ void convert_slot(const Frame& F, int l, int lo, int hi, bool fold, int rank, int nr) {
    if (rank < 0 || rank >= nr) return;
    convert_blocks<false, false, 64>(F, l, lo, hi, rank * 8 + F.wave, nr * 8);
    if (fold) for (int it = rank * 8 + F.wave; it < 128; it += nr * 8) fold_gate_item(F, l, it);
}
__device__ __forceinline__ void sincos_acc(float ang, float& c, float& s) {
    const double a = (double)ang; const double k = rint(a * 0.63661977236758134308);
    double r = fma(-k, 1.57079632679489655800, a); r = fma(-k, 6.12323399573676603587e-17, r);
    const float x = (float)r, x2 = x * x;
    const float sp = x + x * x2 * (-1.6666654611e-1f + x2 * (8.3321608736e-3f + x2 * (-1.9515295891e-4f)));
    const float cp = 1.f - 0.5f * x2 + x2 * x2 * (4.166664568298827e-2f + x2 * (-1.388731625493765e-3f + x2 * 2.443315711809948e-5f));
    const int q = ((int)k) & 3;
    c = (q == 0) ? cp : (q == 1) ? -sp : (q == 2) ? -cp : sp;
    s = (q == 0) ? sp : (q == 1) ? cp : (q == 2) ? -sp : -cp;
}
__device__ __forceinline__ void p_prologue(Frame& F, const Args& A) {
    const int gw = F.bid * 8 + F.wave, NGW = F.G * 8, lane = F.lane;
    const float* x = (const float*)in_ptr(0); const float* mem = (const float*)in_ptr(1); const int* pos = (const int*)in_ptr(2);
    convert_blocks<false, false>(F, 0, 0, NA_HEAD, gw, NGW);
    for (int l = 0; l < NL; ++l) convert_blocks<true, true>(F, l, 0, NB, gw, NGW);
    for (int it = gw; it < NL * D; it += NGW) { const int l = it / D, k = it % D; const float g = ((const float*)in_ptr(11))[l * D + k];
        const f32x4* src = (const f32x4*)((const float*)in_ptr(13) + ((size_t)l * D + k) * D) + lane; u32x2* dst = (u32x2*)(wsp<bf16_t>(F, WS_WQP + l * SZ_W22) + (size_t)k * D) + lane;
#pragma unroll
        for (int j = 0; j < 8; ++j) { const f32x4 v = __builtin_nontemporal_load(src + 64 * j) * g; u32x2 o; o.x = pk2(v[0], v[1]); o.y = pk2(v[2], v[3]); __builtin_nontemporal_store(o, dst + 64 * j); } }
    for (int it = gw; it < 128; it += NGW) fold_gate_item(F, 0, it);
    { float* ss0 = ss_ptr(F, 0); bf16_t* hb = wsp<bf16_t>(F, WS_HB);
      for (int m = gw; m < T; m += NGW) { const f32x4* xr = (const f32x4*)(x + (size_t)m * D) + lane; u32x2* o = (u32x2*)(hb + (size_t)m * D) + lane; float s = 0.f;
#pragma unroll
          for (int j = 0; j < 8; ++j) { const f32x4 v = __builtin_nontemporal_load(xr + 64 * j); s += (v[0] * v[0] + v[1] * v[1]) + (v[2] * v[2] + v[3] * v[3]); u32x2 w; w.x = pk2(v[0], v[1]); w.y = pk2(v[2], v[3]); o[64 * j] = w; }
          s = wave_sum(s, lane); if (lane < 32) ss0[(size_t)m * 32 + lane] = (lane == 0) ? s : 0.f; } }
    for (int it = gw; it < NL * NMEM; it += NGW) { const int l = it / NMEM, m = it % NMEM; const f32x4* xr = (const f32x4*)(mem + (size_t)m * D) + lane; const f32x4* gr = (const f32x4*)((const float*)in_ptr(12) + l * D) + lane;
        f32x4 v[8]; float s = 0.f;
#pragma unroll
        for (int j = 0; j < 8; ++j) { v[j] = xr[64 * j]; s += (v[j][0] * v[j][0] + v[j][1] * v[j][1]) + (v[j][2] * v[j][2] + v[j][3] * v[j][3]); }
        const float rs = rsqrtf(wave_sum(s, lane) * (1.f / D) + EPS); u32x2* o = (u32x2*)(wsp<bf16_t>(F, WS_MEMN + l * SZ_MEM) + (size_t)m * D) + lane;
#pragma unroll
        for (int j = 0; j < 8; ++j) { const f32x4 g = gr[64 * j]; u32x2 w; w.x = pk2(v[j][0] * rs * g[0], v[j][1] * rs * g[1]); w.y = pk2(v[j][2] * rs * g[2], v[j][3] * rs * g[3]); o[64 * j] = w; } }
    { float* ct = wsp<float>(F, WS_ROPE); float* st = ct + T * 32;
      for (int i = F.bid * 512 + F.tid; i < T * 32; i += F.G * 512) { const int t = i >> 5, j = i & 31; const float inv = 1.0f / powf(10000.0f, (float)(2 * j) / 64.0f); const float ang = (float)pos[t] * inv;
          float c, s; sincos_acc(ang, c, s); ct[i] = c; st[i] = s; } }
}

struct KVOrder {
    unsigned char* ws; int G, c;
    __device__ __forceinline__ bool next(int i, pg8::Unit& u) const {
        const int L = i * G + c; if (L >= 64) return false;
        const int b = L >> 3, pn = L & 7, l = b >> 1, kv = b & 1;
        u.pm = 0; u.pn = pn; u.a = (const char*)(ws + WS_MEMN + l * SZ_MEM); u.b = (const char*)(ws + (kv ? WS_WV : WS_WK) + l * SZ_W22 + (size_t)pn * 256 * D * 2);
        u.o = (char*)(ws + (kv ? WS_VMEM : WS_KMEM) + l * SZ_MEM); u.ldc = D; u.sc = 1.f; return true; }
    __device__ __forceinline__ void a_ready(const pg8::Unit&) const {}
    __device__ __forceinline__ void done(const pg8::Unit&) const {}
};
struct FoldOrder {
    unsigned char* ws; int G, c;
    __device__ __forceinline__ bool next(int i, pg8::Unit& u) const {
        int L = i * G + c; if (L >= 256) return false;
        if (L < 128) { const int b = L >> 3, pn = L & 7, l = b >> 2, hd = b & 3;
            u.pm = 0; u.pn = pn; u.a = (const char*)(ws + WS_KMEM + l * SZ_MEM + 512 * hd * 2); u.b = (const char*)(ws + WS_WQP + l * SZ_W22 + 512 * hd * 2 + (size_t)pn * 256 * D * 2);
            u.o = (char*)(ws + WS_WST + l * SZ_WS + (size_t)256 * hd * D * 2); u.ldc = D; u.sc = 0.044194173824159216f; }
        else { L -= 128; const int b = L >> 3, pm = L & 7, l = b >> 2, hd = b & 3;
            u.pm = pm; u.pn = 0; u.a = (const char*)(ws + WS_WO + l * SZ_W22 + 512 * hd * 2 + (size_t)pm * 256 * D * 2); u.b = (const char*)(ws + WS_VMEM + l * SZ_MEM + 512 * hd * 2);
            u.o = (char*)(ws + WS_VWT + l * SZ_WS + 256 * hd * 2); u.ldc = NSC; u.sc = 1.f; }
        return true; }
    __device__ __forceinline__ void a_ready(const pg8::Unit&) const {}
    __device__ __forceinline__ void done(const pg8::Unit&) const {}
};

__device__ __forceinline__ void gla_cumsum(const Frame& F, const float* la, int t0, int h, LAS float* tot, float (&c)[8]) {
    const int w = F.wave, d = F.lane; float run = 0.f;
#pragma unroll
    for (int i = 0; i < 8; ++i) { run += la[(size_t)(t0 + 8 * w + i) * 256 + h * 64 + d]; c[i] = run; }
    tot[w * 64 + d] = run;
    __syncthreads();
    float off = 0.f;
#pragma unroll
    for (int j = 0; j < 8; ++j) off += (j < w) ? tot[j * 64 + d] : 0.f;
#pragma unroll
    for (int i = 0; i < 8; ++i) c[i] += off;
}
__device__ __forceinline__ void gla_local(Frame& F, int unit) {
    const int h = unit >> 7, ck = unit & 127, t0 = ck * 64, w = F.wave, lane = F.lane, tid = F.tid;
    const bf16_t* z = wsp<bf16_t>(F, WS_Z); const float* la = wsp<float>(F, WS_LA);
    LAS float* tot = (LAS float*)F.lds; LAS float* khat = tot + 512; LAS float* vt = khat + 64 * 64;
    float c[8]; gla_cumsum(F, la, t0, h, tot, c);
    float total = 0.f;
#pragma unroll
    for (int j = 0; j < 8; ++j) total += tot[j * 64 + lane];
#pragma unroll
    for (int i = 0; i < 8; ++i) { const int t = 8 * w + i; const float k = bf2f(z[(size_t)(t0 + t) * NZ + ZK + h * 64 + lane]); khat[t * 64 + lane] = k * __expf(total - c[i]); }
#pragma unroll
    for (int j = 0; j < 2; ++j) { const int idx = tid + 512 * j, t = idx >> 4, ch = idx & 15; const u32x4 r = *(const u32x4*)(z + (size_t)(t0 + t) * NZ + ZV + h * 128 + ch * 8);
        LAS float* p = vt + t * 128 + ch * 8;
        p[0] = bf2f(r.x & 0xffffu); p[1] = bf2f(r.x >> 16); p[2] = bf2f(r.y & 0xffffu); p[3] = bf2f(r.y >> 16); p[4] = bf2f(r.z & 0xffffu); p[5] = bf2f(r.z >> 16); p[6] = bf2f(r.w & 0xffffu); p[7] = bf2f(r.w >> 16); }
    if (w == 0) wsp<float>(F, WS_DEC)[(size_t)unit * 64 + lane] = __expf(total);
    __syncthreads();
    const int e = tid & 127, dg = tid >> 7;
    float acc[16];
#pragma unroll
    for (int j = 0; j < 16; ++j) acc[j] = 0.f;
    for (int t = 0; t < 64; ++t) { const float v = vt[t * 128 + e];
#pragma unroll
        for (int j = 0; j < 16; ++j) acc[j] += v * khat[t * 64 + 16 * dg + j]; }
    float* U = wsp<float>(F, WS_UB) + (size_t)unit * 8192;
#pragma unroll
    for (int j = 0; j < 16; ++j) U[(16 * dg + j) * 128 + e] = acc[j];
    __syncthreads();
}
__device__ __forceinline__ void gla_scan4(Frame& F) {
    LAS f32x2* AB = (LAS f32x2*)F.lds;
    const int per = (4 * 8192 + F.G - 1) / F.G, seg = F.wave >> 1, el = ((F.wave & 1) << 6) | F.lane;
    for (int e0 = 0; e0 < per; e0 += 128) {
        const int e = e0 + el, gid = F.bid * per + e; const bool act = (e < per) && (gid < 4 * 8192);
        const int gidc = act ? gid : 0, h = gidc >> 13, rem = gidc & 8191, d = rem >> 7;
        const float* __restrict__ U = wsp<float>(F, WS_UB) + (size_t)h * 128 * 8192 + rem + (size_t)(32 * seg) * 8192; const float* __restrict__ dec = wsp<float>(F, WS_DEC) + (size_t)h * 128 * 64 + d + (32 * seg) * 64;
        bf16_t* __restrict__ Sb = wsp<bf16_t>(F, WS_SB) + (size_t)h * 128 * 8192 + rem + (size_t)(32 * seg) * 8192;
        float u[32], dd[32];
#pragma unroll
        for (int i = 0; i < 32; ++i) { u[i] = U[(size_t)i * 8192]; dd[i] = dec[i * 64]; }
        float S = 0.f, P = 1.f;
#pragma unroll
        for (int i = 0; i < 32; ++i) { const float un = u[i], dn = dd[i]; u[i] = S; dd[i] = P; S = S * dn + un; P = P * dn; }
        AB[seg * 128 + el] = (f32x2){P, S};
        __syncthreads();
        float Sin = 0.f;
#pragma unroll
        for (int j = 0; j < 3; ++j) { if (j < seg) { const f32x2 ab = AB[j * 128 + el]; Sin = Sin * ab.x + ab.y; } }
        if ((e0 + el < per) && (F.bid * per + e0 + el < 4 * 8192)) {
#pragma unroll
            for (int i = 0; i < 32; ++i) Sb[(size_t)i * 8192] = (bf16_t)f2bf(u[i] + dd[i] * Sin); }
        __syncthreads();
    }
}
__device__ __forceinline__ void gla_scan(Frame& F) {
    const int per = (4 * 8192 + F.G - 1) / F.G;
    for (int e = F.tid; e < per; e += 128) { const int gid = F.bid * per + e; if (gid >= 4 * 8192) break;
        const int h = gid >> 13, rem = gid & 8191, d = rem >> 7;
        const float* __restrict__ U = wsp<float>(F, WS_UB) + (size_t)h * 128 * 8192 + rem; const float* __restrict__ dec = wsp<float>(F, WS_DEC) + (size_t)h * 128 * 64 + d; bf16_t* __restrict__ Sb = wsp<bf16_t>(F, WS_SB) + (size_t)h * 128 * 8192 + rem;
        float S = 0.f;
#pragma unroll 1
        for (int b = 0; b < 4; ++b) { float u[32], dd[32];
#pragma unroll
            for (int i = 0; i < 32; ++i) { u[i] = U[(size_t)(32 * b + i) * 8192]; dd[i] = dec[(32 * b + i) * 64]; }
#pragma unroll
            for (int i = 0; i < 32; ++i) { Sb[(size_t)(32 * b + i) * 8192] = (bf16_t)f2bf(S); S = S * dd[i] + u[i]; } }
    }
}
__device__ __forceinline__ void gla_out(Frame& F, const Args& A, int unit, int layer) {
    const int h = unit >> 7, ck = unit & 127, t0 = ck * 64, w = F.wave, lane = F.lane, tid = F.tid;
    const bf16_t* z = wsp<bf16_t>(F, WS_Z); const float* la = wsp<float>(F, WS_LA);
    LAS float* tot = (LAS float*)F.lds; LAS float* qtT = tot + 512; LAS float* qeT = qtT + 64 * 65; LAS float* attT = qeT + 64 * 65; LAS float* ktl = attT + 64 * 65;
    LAS float* red = ktl + 64 * 64; LAS bf16_t* vs = (LAS bf16_t*)(red + 512); LAS bf16_t* Ss = vs + 64 * 128;
    float c[8]; gla_cumsum(F, la, t0, h, tot, c);
    const float ref = tot[lane] + tot[64 + lane] + tot[128 + lane] + tot[192 + lane];
#pragma unroll
    for (int i = 0; i < 8; ++i) { const int t = 8 * w + i; const size_t zo = (size_t)(t0 + t) * NZ + h * 64 + lane;
        const float q = bf2f(z[zo + ZQ]) * 0.125f, k = bf2f(z[zo + ZK]);
        qtT[lane * 65 + t] = q * __expf(c[i] - ref); qeT[lane * 65 + t] = q * __expf(c[i]); ktl[t * 64 + lane] = k * __expf(ref - c[i]); }
#pragma unroll
    for (int j = 0; j < 2; ++j) { const int idx = tid + 512 * j, t = idx >> 4, ch = idx & 15;
        *(LAS u32x4*)(vs + t * 128 + ch * 8) = *(const u32x4*)(z + (size_t)(t0 + t) * NZ + ZV + h * 128 + ch * 8);
        *(LAS u32x4*)(Ss + t * 128 + ch * 8) = *(const u32x4*)(wsp<bf16_t>(F, WS_SB) + (size_t)unit * 8192 + t * 128 + ch * 8); }
    __syncthreads();
    {
        float a[8];
#pragma unroll
        for (int j = 0; j < 8; ++j) a[j] = 0.f;
        for (int d = 0; d < 64; ++d) { const float q = qtT[d * 65 + lane];
#pragma unroll
            for (int j = 0; j < 8; ++j) a[j] += q * ktl[(8 * w + j) * 64 + d]; }
#pragma unroll
        for (int j = 0; j < 8; ++j) attT[(8 * w + j) * 65 + lane] = (8 * w + j <= lane) ? a[j] : 0.f;
    }
    __syncthreads();
    float o[16];
#pragma unroll
    for (int j = 0; j < 16; ++j) o[j] = 0.f;
    for (int s = 0; s < 64; ++s) { const float a = attT[s * 65 + lane]; const u32x4 v0 = *(const LAS u32x4*)(vs + s * 128 + 16 * w), v1 = *(const LAS u32x4*)(vs + s * 128 + 16 * w + 8);
        o[0] += a * bf2f(v0.x & 0xffffu); o[1] += a * bf2f(v0.x >> 16); o[2] += a * bf2f(v0.y & 0xffffu); o[3] += a * bf2f(v0.y >> 16);
        o[4] += a * bf2f(v0.z & 0xffffu); o[5] += a * bf2f(v0.z >> 16); o[6] += a * bf2f(v0.w & 0xffffu); o[7] += a * bf2f(v0.w >> 16);
        o[8] += a * bf2f(v1.x & 0xffffu); o[9] += a * bf2f(v1.x >> 16); o[10] += a * bf2f(v1.y & 0xffffu); o[11] += a * bf2f(v1.y >> 16);
        o[12] += a * bf2f(v1.z & 0xffffu); o[13] += a * bf2f(v1.z >> 16); o[14] += a * bf2f(v1.w & 0xffffu); o[15] += a * bf2f(v1.w >> 16); }
    for (int d = 0; d < 64; ++d) { const float a = qeT[d * 65 + lane]; const u32x4 v0 = *(const LAS u32x4*)(Ss + d * 128 + 16 * w), v1 = *(const LAS u32x4*)(Ss + d * 128 + 16 * w + 8);
        o[0] += a * bf2f(v0.x & 0xffffu); o[1] += a * bf2f(v0.x >> 16); o[2] += a * bf2f(v0.y & 0xffffu); o[3] += a * bf2f(v0.y >> 16);
        o[4] += a * bf2f(v0.z & 0xffffu); o[5] += a * bf2f(v0.z >> 16); o[6] += a * bf2f(v0.w & 0xffffu); o[7] += a * bf2f(v0.w >> 16);
        o[8] += a * bf2f(v1.x & 0xffffu); o[9] += a * bf2f(v1.x >> 16); o[10] += a * bf2f(v1.y & 0xffffu); o[11] += a * bf2f(v1.y >> 16);
        o[12] += a * bf2f(v1.z & 0xffffu); o[13] += a * bf2f(v1.z >> 16); o[14] += a * bf2f(v1.w & 0xffffu); o[15] += a * bf2f(v1.w >> 16); }
    float p = 0.f;
#pragma unroll
    for (int j = 0; j < 16; ++j) p += o[j] * o[j];
    red[w * 64 + lane] = p;
    __syncthreads();
    float sq = 0.f;
#pragma unroll
    for (int j = 0; j < 8; ++j) sq += red[j * 64 + lane];
    const float rs = rsqrtf(sq * (1.f / 128.f) + EPS);
    const float* gn = (const float*)in_ptr(7) + layer * 128 + 16 * w; const size_t zr = (size_t)(t0 + lane) * NZ + ZR + h * 128 + 16 * w;
    const u32x4 r0 = *(const u32x4*)(z + zr), r1 = *(const u32x4*)(z + zr + 8);
    const unsigned rr[8] = {r0.x, r0.y, r0.z, r0.w, r1.x, r1.y, r1.z, r1.w};
    unsigned ow[8];
#pragma unroll
    for (int j = 0; j < 8; ++j) { const float g0 = bf2f(rr[j] & 0xffffu), g1 = bf2f(rr[j] >> 16);
        ow[j] = pk2(o[2 * j] * rs * gn[2 * j] * siluf(g0), o[2 * j + 1] * rs * gn[2 * j + 1] * siluf(g1)); }
    bf16_t* mx = wsp<bf16_t>(F, WS_MIX) + (size_t)(t0 + lane) * D + h * 128 + 16 * w;
    *(u32x4*)mx = (u32x4){ow[0], ow[1], ow[2], ow[3]}; *(u32x4*)(mx + 8) = (u32x4){ow[4], ow[5], ow[6], ow[7]};
    __syncthreads();
}

__device__ __forceinline__ void swa_unit(Frame& F, const Args& A, int unit, int layer) {
    const int g = unit & 7, n = (unit >> 3) & 63, j = unit >> 9, hq = 8 * j + g, tid = F.tid;
    const bf16_t* z = wsp<bf16_t>(F, WS_Z); const float* ct = wsp<float>(F, WS_ROPE); const float* st = ct + T * 32;
    LAS bf16_t* Ks = (LAS bf16_t*)F.lds; LAS bf16_t* Vs = Ks + 256 * 66; LAS float* red = (LAS float*)(Vs + 256 * 66);
    LAS float* ob = (LAS float*)F.lds;
    {
        const int row = tid >> 1, hf = tid & 1, tk = 128 * n - 128 + row;
        if (tk >= 0) {
            const bf16_t* kp = z + (size_t)tk * NZ + ZSK + j * 64; const bf16_t* vp = z + (size_t)tk * NZ + ZSV + j * 64;
            const u32x4 a0 = *(const u32x4*)(kp + 16 * hf), a1 = *(const u32x4*)(kp + 16 * hf + 8), b0 = *(const u32x4*)(kp + 32 + 16 * hf), b1 = *(const u32x4*)(kp + 32 + 16 * hf + 8);
            const unsigned x1[8] = {a0.x, a0.y, a0.z, a0.w, a1.x, a1.y, a1.z, a1.w}, x2[8] = {b0.x, b0.y, b0.z, b0.w, b1.x, b1.y, b1.z, b1.w};
#pragma unroll
            for (int q = 0; q < 8; ++q) { const int i0 = 16 * hf + 2 * q; const float c0 = ct[tk * 32 + i0], s0 = st[tk * 32 + i0], c1 = ct[tk * 32 + i0 + 1], s1 = st[tk * 32 + i0 + 1];
                const float u0 = bf2f(x1[q] & 0xffffu), u1 = bf2f(x1[q] >> 16), w0 = bf2f(x2[q] & 0xffffu), w1 = bf2f(x2[q] >> 16);
                *(LAS unsigned*)(Ks + row * 66 + i0) = pk2(u0 * c0 - w0 * s0, u1 * c1 - w1 * s1);
                *(LAS unsigned*)(Ks + row * 66 + 32 + i0) = pk2(w0 * c0 + u0 * s0, w1 * c1 + u1 * s1); }
            const u32x4 v0 = *(const u32x4*)(vp + 32 * hf), v1 = *(const u32x4*)(vp + 32 * hf + 8), v2 = *(const u32x4*)(vp + 32 * hf + 16), v3 = *(const u32x4*)(vp + 32 * hf + 24);
            const unsigned vv[16] = {v0.x, v0.y, v0.z, v0.w, v1.x, v1.y, v1.z, v1.w, v2.x, v2.y, v2.z, v2.w, v3.x, v3.y, v3.z, v3.w};
#pragma unroll
            for (int q = 0; q < 16; ++q) *(LAS unsigned*)(Vs + row * 66 + 32 * hf + 2 * q) = vv[q];
        } else {
#pragma unroll
            for (int q = 0; q < 16; ++q) { *(LAS unsigned*)(Ks + row * 66 + 32 * hf + 2 * q) = 0u; *(LAS unsigned*)(Vs + row * 66 + 32 * hf + 2 * q) = 0u; }
        }
    }
    const int r = tid & 127, part = tid >> 7, tq = 128 * n + r;
    float q[64];
    {   const bf16_t* qp = z + (size_t)tq * NZ + ZSQ + hq * 64;
#pragma unroll
        for (int c8 = 0; c8 < 4; ++c8) { const u32x4 a = *(const u32x4*)(qp + 8 * c8), b = *(const u32x4*)(qp + 32 + 8 * c8); const unsigned x1[4] = {a.x, a.y, a.z, a.w}, x2[4] = {b.x, b.y, b.z, b.w};
#pragma unroll
            for (int p = 0; p < 4; ++p) { const int i0 = 8 * c8 + 2 * p; const float c0 = ct[tq * 32 + i0], s0 = st[tq * 32 + i0], c1 = ct[tq * 32 + i0 + 1], s1 = st[tq * 32 + i0 + 1];
                const float u0 = bf2f(x1[p] & 0xffffu), u1 = bf2f(x1[p] >> 16), w0 = bf2f(x2[p] & 0xffffu), w1 = bf2f(x2[p] >> 16);
                q[i0] = (u0 * c0 - w0 * s0) * 0.125f; q[i0 + 1] = (u1 * c1 - w1 * s1) * 0.125f; q[32 + i0] = (w0 * c0 + u0 * s0) * 0.125f; q[32 + i0 + 1] = (w1 * c1 + u1 * s1) * 0.125f; } }
    }
    __syncthreads();
    float s[32]; float mx = -INFINITY;
#pragma unroll
    for (int kk = 0; kk < 32; ++kk) { const int ki = r + 1 + 32 * part + kk; const LAS unsigned* kr = (const LAS unsigned*)(Ks + ki * 66); float a = 0.f;
#pragma unroll
        for (int d2 = 0; d2 < 32; ++d2) { const unsigned kw = kr[d2]; a += q[2 * d2] * bf2f(kw & 0xffffu) + q[2 * d2 + 1] * bf2f(kw >> 16); }
        const bool valid = (n > 0) || (ki >= 128); s[kk] = valid ? a : -INFINITY; mx = fmaxf(mx, s[kk]); }
    red[part * 128 + r] = mx;
    __syncthreads();
    const float sink = ((const float*)in_ptr(8))[layer * 16 + hq];
    const float m = fmaxf(fmaxf(fmaxf(red[r], red[128 + r]), fmaxf(red[256 + r], red[384 + r])), sink);
    float sum = 0.f;
#pragma unroll
    for (int kk = 0; kk < 32; ++kk) { s[kk] = __expf(s[kk] - m); sum += s[kk]; }
    red[512 + part * 128 + r] = sum;
    __syncthreads();
    const float den = red[512 + r] + red[640 + r] + red[768 + r] + red[896 + r] + __expf(sink - m), inv = 1.f / den;
    float o[64];
#pragma unroll
    for (int e = 0; e < 64; ++e) o[e] = 0.f;
#pragma unroll 4
    for (int kk = 0; kk < 32; ++kk) { const int ki = r + 1 + 32 * part + kk; const LAS unsigned* vr = (const LAS unsigned*)(Vs + ki * 66); const float p = s[kk] * inv;
#pragma unroll
        for (int d2 = 0; d2 < 32; ++d2) { const unsigned vw = vr[d2]; o[2 * d2] += p * bf2f(vw & 0xffffu); o[2 * d2 + 1] += p * bf2f(vw >> 16); } }
    for (int pp = 0; pp < 4; ++pp) {
        if (part == pp) {
#pragma unroll
            for (int e = 0; e < 64; ++e) { if (pp == 0) ob[r * 65 + e] = o[e]; else ob[r * 65 + e] += o[e]; }
        }
        __syncthreads();
    }
    {   const int row = tid >> 2, e0 = 16 * (tid & 3); unsigned ow[8];
#pragma unroll
        for (int p = 0; p < 8; ++p) ow[p] = pk2(ob[row * 65 + e0 + 2 * p], ob[row * 65 + e0 + 2 * p + 1]);
        bf16_t* mxp = wsp<bf16_t>(F, WS_MIX) + (size_t)(128 * n + row) * D + 512 + hq * 64 + e0;
        *(u32x4*)mxp = (u32x4){ow[0], ow[1], ow[2], ow[3]}; *(u32x4*)(mxp + 8) = (u32x4){ow[4], ow[5], ow[6], ow[7]}; }
    __syncthreads();
}


typedef float f32x16 __attribute__((ext_vector_type(16)));
typedef short s16x4 __attribute__((ext_vector_type(4)));
typedef short v4i16_t __attribute__((ext_vector_type(4)));
#define MFMA32(a, b, c) __builtin_amdgcn_mfma_f32_32x32x16_bf16((a), (b), (c), 0, 0, 0)
__device__ __forceinline__ s16x4 tr_read(const LAS bf16_t* p) { return __builtin_bit_cast(s16x4, __builtin_amdgcn_ds_read_tr16_b64_v4i16((LAS v4i16_t*)p)); }
__device__ __forceinline__ void swa_unit_mfma(Frame& F, int unit, int layer) {
    constexpr int KST = 72, VST = 96;
    const int hf = unit & 1, n = (unit >> 1) & 63, j = unit >> 7, tid = F.tid, lane = F.lane, w = F.wave, r = lane & 31, hh = lane >> 5;
    const bf16_t* z = wsp<bf16_t>(F, WS_Z); const float* ct = wsp<float>(F, WS_ROPE); const float* st = ct + T * 32;
    LAS bf16_t* Ks = (LAS bf16_t*)F.lds; LAS bf16_t* Vs = Ks + 256 * KST;
    const int hq = 8 * j + 4 * hf + (w & 3);
    bf16x8 qf[2][4]; u32x4 qxa[2][2], qxb[2][2]; f32x4 qc[2][2][2], qs[2][2][2];
#pragma unroll
        for (int pi = 0; pi < 2; ++pi) { const int tq = 128 * n + 32 * (2 * (w >> 2) + pi) + r; const bf16_t* qp = z + (size_t)tq * NZ + ZSQ + hq * 64;
#pragma unroll
            for (int s2 = 0; s2 < 2; ++s2) { qxa[pi][s2] = *(const u32x4*)(qp + 16 * s2 + 8 * hh); qxb[pi][s2] = *(const u32x4*)(qp + 32 + 16 * s2 + 8 * hh);
                qc[pi][s2][0] = *(const f32x4*)(ct + tq * 32 + 16 * s2 + 8 * hh); qc[pi][s2][1] = *(const f32x4*)(ct + tq * 32 + 16 * s2 + 8 * hh + 4);
                qs[pi][s2][0] = *(const f32x4*)(st + tq * 32 + 16 * s2 + 8 * hh); qs[pi][s2][1] = *(const f32x4*)(st + tq * 32 + 16 * s2 + 8 * hh + 4); } }
    {
        const int row = tid >> 1, hp = tid & 1, tk = 128 * n - 128 + row;
        if (tk >= 0) {
            const bf16_t* kp = z + (size_t)tk * NZ + ZSK + j * 64; const bf16_t* vp = z + (size_t)tk * NZ + ZSV + j * 64;
            const u32x4 a0 = *(const u32x4*)(kp + 16 * hp), a1 = *(const u32x4*)(kp + 16 * hp + 8), b0 = *(const u32x4*)(kp + 32 + 16 * hp), b1 = *(const u32x4*)(kp + 32 + 16 * hp + 8);
            const unsigned x1[8] = {a0.x, a0.y, a0.z, a0.w, a1.x, a1.y, a1.z, a1.w}, x2[8] = {b0.x, b0.y, b0.z, b0.w, b1.x, b1.y, b1.z, b1.w};
            unsigned o1[8], o2[8];
            const f32x4* cp4 = (const f32x4*)(ct + tk * 32 + 16 * hp); const f32x4* sp4 = (const f32x4*)(st + tk * 32 + 16 * hp);
            const f32x4 cA = cp4[0], cB = cp4[1], cC = cp4[2], cD = cp4[3], sA = sp4[0], sB = sp4[1], sC = sp4[2], sD = sp4[3];
            const float cc[16] = {cA[0], cA[1], cA[2], cA[3], cB[0], cB[1], cB[2], cB[3], cC[0], cC[1], cC[2], cC[3], cD[0], cD[1], cD[2], cD[3]};
            const float sn[16] = {sA[0], sA[1], sA[2], sA[3], sB[0], sB[1], sB[2], sB[3], sC[0], sC[1], sC[2], sC[3], sD[0], sD[1], sD[2], sD[3]};
#pragma unroll
            for (int q = 0; q < 8; ++q) { const float c0 = cc[2 * q], s0 = sn[2 * q], c1 = cc[2 * q + 1], s1 = sn[2 * q + 1];
                const float u0 = bf2f(x1[q] & 0xffffu), u1 = bf2f(x1[q] >> 16), w0 = bf2f(x2[q] & 0xffffu), w1 = bf2f(x2[q] >> 16);
                o1[q] = pk2(u0 * c0 - w0 * s0, u1 * c1 - w1 * s1); o2[q] = pk2(w0 * c0 + u0 * s0, w1 * c1 + u1 * s1); }
            *(LAS u32x4*)(Ks + row * KST + 16 * hp) = (u32x4){o1[0], o1[1], o1[2], o1[3]}; *(LAS u32x4*)(Ks + row * KST + 16 * hp + 8) = (u32x4){o1[4], o1[5], o1[6], o1[7]};
            *(LAS u32x4*)(Ks + row * KST + 32 + 16 * hp) = (u32x4){o2[0], o2[1], o2[2], o2[3]}; *(LAS u32x4*)(Ks + row * KST + 32 + 16 * hp + 8) = (u32x4){o2[4], o2[5], o2[6], o2[7]};
#pragma unroll
            for (int q = 0; q < 4; ++q) *(LAS u32x4*)(Vs + row * VST + 32 * hp + 8 * q) = *(const u32x4*)(vp + 32 * hp + 8 * q);
        } else {
            const u32x4 zz = (u32x4){0u, 0u, 0u, 0u};
#pragma unroll
            for (int q = 0; q < 4; ++q) { *(LAS u32x4*)(Ks + row * KST + 32 * hp + 8 * q) = zz; *(LAS u32x4*)(Vs + row * VST + 32 * hp + 8 * q) = zz; }
        }
    }
#pragma unroll
    for (int pi = 0; pi < 2; ++pi)
#pragma unroll
        for (int s2 = 0; s2 < 2; ++s2) { const u32x4 xa = qxa[pi][s2], xb = qxb[pi][s2]; const f32x4 c0 = qc[pi][s2][0], c1 = qc[pi][s2][1], s0 = qs[pi][s2][0], s1 = qs[pi][s2][1];
            const unsigned x1[4] = {xa.x, xa.y, xa.z, xa.w}, x2[4] = {xb.x, xb.y, xb.z, xb.w}; const float cc[8] = {c0[0], c0[1], c0[2], c0[3], c1[0], c1[1], c1[2], c1[3]}, sn[8] = {s0[0], s0[1], s0[2], s0[3], s1[0], s1[1], s1[2], s1[3]};
            unsigned o1[4], o2[4];
#pragma unroll
            for (int q = 0; q < 4; ++q) { const float u0 = bf2f(x1[q] & 0xffffu), u1 = bf2f(x1[q] >> 16), w0 = bf2f(x2[q] & 0xffffu), w1 = bf2f(x2[q] >> 16);
                o1[q] = pk2((u0 * cc[2 * q] - w0 * sn[2 * q]) * 0.125f, (u1 * cc[2 * q + 1] - w1 * sn[2 * q + 1]) * 0.125f);
                o2[q] = pk2((w0 * cc[2 * q] + u0 * sn[2 * q]) * 0.125f, (w1 * cc[2 * q + 1] + u1 * sn[2 * q + 1]) * 0.125f); }
            qf[pi][s2] = __builtin_bit_cast(bf16x8, (u32x4){o1[0], o1[1], o1[2], o1[3]}); qf[pi][s2 + 2] = __builtin_bit_cast(bf16x8, (u32x4){o2[0], o2[1], o2[2], o2[3]}); }
    __syncthreads();
    const float sink = ((const float*)in_ptr(8))[layer * 16 + hq];
    const int i16 = lane & 15, q4 = i16 >> 2, p4 = i16 & 3, blk = (lane >> 4) & 1;
    const LAS bf16_t* vbase = Vs + (4 * hh + q4) * VST + 16 * blk + 4 * p4;
#pragma unroll
    for (int pi = 0; pi < 2; ++pi) {
        const int p = 2 * (w >> 2) + pi, tq = 128 * n + 32 * p + r;
        f32x16 X[5];
#pragma unroll
        for (int b = 0; b < 5; ++b) {
#pragma unroll
            for (int i = 0; i < 16; ++i) X[b][i] = 0.f;
#pragma unroll
            for (int s = 0; s < 4; ++s) { const bf16x8 kf = *(const LAS bf16x8*)(Ks + (32 * (p + b) + r) * KST + 16 * s + 8 * hh); X[b] = MFMA32(kf, qf[pi][s], X[b]); } }
        float mx = -INFINITY;
#pragma unroll
        for (int b = 0; b < 5; ++b)
#pragma unroll
            for (int i = 0; i < 16; ++i) { const int cr = (i & 3) + 8 * (i >> 2) + 4 * hh; bool valid = (b == 0) ? (cr > r) : (b == 4) ? (cr <= r) : true; if (n == 0) valid = valid && (p + b >= 4);
                const float v = valid ? X[b][i] : -INFINITY; X[b][i] = v; mx = fmaxf(mx, v); }
        mx = fmaxf(mx, shx(mx, 32, lane));
        const float m = fmaxf(mx, sink), mL = m * 1.44269504088896341f;
        float sum = 0.f;
#pragma unroll
        for (int b = 0; b < 5; ++b)
#pragma unroll
            for (int i = 0; i < 16; ++i) { const float e = pg8::exp_sub(X[b][i], mL); X[b][i] = e; sum += e; }
        sum += shx(sum, 32, lane);
        const float inv = 1.f / (sum + __expf(sink - m));
        f32x16 Z[2];
#pragma unroll
        for (int et = 0; et < 2; ++et)
#pragma unroll
            for (int i = 0; i < 16; ++i) Z[et][i] = 0.f;
#pragma unroll
        for (int b = 0; b < 5; ++b)
#pragma unroll
            for (int s2 = 0; s2 < 2; ++s2) {
                u32x4 pw;
                pw.x = pk2(X[b][8 * s2 + 0] * inv, X[b][8 * s2 + 1] * inv); pw.y = pk2(X[b][8 * s2 + 2] * inv, X[b][8 * s2 + 3] * inv);
                pw.z = pk2(X[b][8 * s2 + 4] * inv, X[b][8 * s2 + 5] * inv); pw.w = pk2(X[b][8 * s2 + 6] * inv, X[b][8 * s2 + 7] * inv);
                const bf16x8 pa = __builtin_bit_cast(bf16x8, pw);
                const LAS bf16_t* vp = vbase + (32 * (p + b) + 16 * s2) * VST;
#pragma unroll
                for (int et = 0; et < 2; ++et) { const s16x4 lo = tr_read(vp + 32 * et), hi = tr_read(vp + 8 * VST + 32 * et);
                    const bf16x8 vb = (bf16x8){lo[0], lo[1], lo[2], lo[3], hi[0], hi[1], hi[2], hi[3]};
                    Z[et] = MFMA32(pa, vb, Z[et]); } }
        LAS bf16_t* stg = Vs + 256 * VST + w * (32 * 72);
#pragma unroll
        for (int et = 0; et < 2; ++et)
#pragma unroll
            for (int i = 0; i < 16; ++i) { const int cr = (i & 3) + 8 * (i >> 2) + 4 * hh; stg[cr * 72 + 32 * et + r] = (bf16_t)f2bf(Z[et][i]); }
        LDS_WAIT(); asm volatile("" ::: "memory");
        bf16_t* mxp = wsp<bf16_t>(F, WS_MIX) + (size_t)(128 * n + 32 * p) * D + 512 + hq * 64;
#pragma unroll
        for (int jq = 0; jq < 4; ++jq) { const int id = lane + 64 * jq, row = id >> 3, c16 = id & 7; *(u32x4*)(mxp + (size_t)row * D + 8 * c16) = *(const LAS u32x4*)(stg + row * 72 + 8 * c16); }
        LDS_WAIT(); asm volatile("" ::: "memory");
    }
    __syncthreads();
}


__device__ __forceinline__ void gla_local_mfma(Frame& F, int unit) {
    constexpr int KS = 96, VS = 160;
    const int h = unit >> 7, ck = unit & 127, t0 = ck * 64, w = F.wave, lane = F.lane, tid = F.tid;
    const bf16_t* z = wsp<bf16_t>(F, WS_Z); const float* la = wsp<float>(F, WS_LA);
    LAS float* tot = (LAS float*)F.lds; LAS bf16_t* kh = (LAS bf16_t*)(tot + 512); LAS bf16_t* vs = kh + 64 * KS;
    bf16_t kraw[8]; u32x4 vraw[2];
#pragma unroll
    for (int i = 0; i < 8; ++i) kraw[i] = z[(size_t)(t0 + 8 * w + i) * NZ + ZK + h * 64 + lane];
#pragma unroll
    for (int j = 0; j < 2; ++j) { const int idx = tid + 512 * j, t = idx >> 4, ch = idx & 15; vraw[j] = *(const u32x4*)(z + (size_t)(t0 + t) * NZ + ZV + h * 128 + ch * 8); }
    float c[8]; gla_cumsum(F, la, t0, h, tot, c);
    float total = 0.f;
#pragma unroll
    for (int j = 0; j < 8; ++j) total += tot[j * 64 + lane];
#pragma unroll
    for (int i = 0; i < 8; ++i) { const int t = 8 * w + i; kh[t * KS + lane] = (bf16_t)f2bf(bf2f(kraw[i]) * __expf(total - c[i])); }
#pragma unroll
    for (int j = 0; j < 2; ++j) { const int idx = tid + 512 * j, t = idx >> 4, ch = idx & 15; *(LAS u32x4*)(vs + t * VS + ch * 8) = vraw[j]; }
    if (w == 0) wsp<float>(F, WS_DEC)[(size_t)unit * 64 + lane] = __expf(total);
    __syncthreads();
    const int r = lane & 31, hh = lane >> 5, i16 = lane & 15, q4 = i16 >> 2, p4 = i16 & 3, blk = (lane >> 4) & 1, dt = w & 1, et = w >> 1;
    const LAS bf16_t* ka = kh + (8 * hh + q4) * KS + 32 * dt + 16 * blk + 4 * p4;
    const LAS bf16_t* va = vs + (8 * hh + q4) * VS + 32 * et + 16 * blk + 4 * p4;
    f32x16 acc;
#pragma unroll
    for (int i = 0; i < 16; ++i) acc[i] = 0.f;
#pragma unroll
    for (int s4 = 0; s4 < 4; ++s4) {
        const s16x4 al = tr_read(ka + 16 * s4 * KS), ah = tr_read(ka + (16 * s4 + 4) * KS), bl = tr_read(va + 16 * s4 * VS), bh = tr_read(va + (16 * s4 + 4) * VS);
        acc = MFMA32(((bf16x8){al[0], al[1], al[2], al[3], ah[0], ah[1], ah[2], ah[3]}), ((bf16x8){bl[0], bl[1], bl[2], bl[3], bh[0], bh[1], bh[2], bh[3]}), acc); }
    float* U = wsp<float>(F, WS_UB) + (size_t)unit * 8192 + 32 * et + r;
#pragma unroll
    for (int i = 0; i < 16; ++i) U[(32 * dt + (i & 3) + 8 * (i >> 2) + 4 * hh) * 128] = acc[i];
    __syncthreads();
}
__device__ __forceinline__ void gla_out_mfma(Frame& F, int unit, int layer) {
    constexpr int QS = 72, VS = 160;
    const int h = unit >> 7, ck = unit & 127, t0 = ck * 64, w = F.wave, lane = F.lane, tid = F.tid;
    const bf16_t* z = wsp<bf16_t>(F, WS_Z); const float* la = wsp<float>(F, WS_LA);
    LAS float* tot = (LAS float*)F.lds; LAS float* red = tot + 512;
    LAS bf16_t* qt = (LAS bf16_t*)(red + 256); LAS bf16_t* kt = qt + 64 * QS; LAS bf16_t* qe = kt + 64 * QS; LAS bf16_t* vs = qe + 64 * QS; LAS bf16_t* Ss = vs + 64 * VS;
    bf16_t qraw[8], kraw[8]; u32x4 vraw[2], sraw[2];
#pragma unroll
    for (int i = 0; i < 8; ++i) { const size_t zo = (size_t)(t0 + 8 * w + i) * NZ + h * 64 + lane; qraw[i] = z[zo + ZQ]; kraw[i] = z[zo + ZK]; }
#pragma unroll
    for (int j = 0; j < 2; ++j) { const int idx = tid + 512 * j, t = idx >> 4, ch = idx & 15;
        vraw[j] = *(const u32x4*)(z + (size_t)(t0 + t) * NZ + ZV + h * 128 + ch * 8); sraw[j] = *(const u32x4*)(wsp<bf16_t>(F, WS_SB) + (size_t)unit * 8192 + t * 128 + ch * 8); }
    const int r_ = lane & 31, hh_ = lane >> 5, tt_ = w & 1, et_ = w >> 1, tl_ = 32 * tt_ + r_;
    u32x2 grv[4]; f32x4 gnv[4];
    {   const bf16_t* zr = z + (size_t)(t0 + tl_) * NZ + ZR + h * 128 + 32 * et_ + 4 * hh_; const float* gn = (const float*)in_ptr(7) + layer * 128 + 32 * et_ + 4 * hh_;
#pragma unroll
        for (int g4 = 0; g4 < 4; ++g4) { grv[g4] = *(const u32x2*)(zr + 8 * g4); gnv[g4] = *(const f32x4*)(gn + 8 * g4); } }
    float c[8]; gla_cumsum(F, la, t0, h, tot, c);
    const float ref = tot[lane] + tot[64 + lane] + tot[128 + lane] + tot[192 + lane];
#pragma unroll
    for (int i = 0; i < 8; ++i) { const int t = 8 * w + i; const float q = bf2f(qraw[i]) * 0.125f, k = bf2f(kraw[i]);
        qt[t * QS + lane] = (bf16_t)f2bf(q * __expf(c[i] - ref)); qe[t * QS + lane] = (bf16_t)f2bf(q * __expf(c[i])); kt[t * QS + lane] = (bf16_t)f2bf(k * __expf(ref - c[i])); }
#pragma unroll
    for (int j = 0; j < 2; ++j) { const int idx = tid + 512 * j, t = idx >> 4, ch = idx & 15; *(LAS u32x4*)(vs + t * VS + ch * 8) = vraw[j]; *(LAS u32x4*)(Ss + t * VS + ch * 8) = sraw[j]; }
    __syncthreads();
    const int r = lane & 31, hh = lane >> 5, i16 = lane & 15, q4 = i16 >> 2, p4 = i16 & 3, blk = (lane >> 4) & 1, tt = w & 1, et = w >> 1;
    f32x16 Y;
#pragma unroll
    for (int i = 0; i < 16; ++i) Y[i] = 0.f;
    {   const LAS bf16_t* sa = Ss + (8 * hh + q4) * VS + 32 * et + 16 * blk + 4 * p4; const LAS bf16_t* qb = qe + (32 * tt + r) * QS + 8 * hh;
#pragma unroll
        for (int s4 = 0; s4 < 4; ++s4) { const s16x4 al = tr_read(sa + 16 * s4 * VS), ah = tr_read(sa + (16 * s4 + 4) * VS); const bf16x8 bq = *(const LAS bf16x8*)(qb + 16 * s4);
            Y = MFMA32(((bf16x8){al[0], al[1], al[2], al[3], ah[0], ah[1], ah[2], ah[3]}), bq, Y); } }
    const LAS bf16_t* va = vs + (4 * hh + q4) * VS + 32 * et + 16 * blk + 4 * p4;
#pragma unroll
    for (int st = 0; st < 2; ++st) {
        if (st <= tt) {
            f32x16 X;
#pragma unroll
            for (int i = 0; i < 16; ++i) X[i] = 0.f;
            const LAS bf16_t* ka = kt + (32 * st + r) * QS + 8 * hh; const LAS bf16_t* qb = qt + (32 * tt + r) * QS + 8 * hh;
#pragma unroll
            for (int s4 = 0; s4 < 4; ++s4) X = MFMA32(*(const LAS bf16x8*)(ka + 16 * s4), *(const LAS bf16x8*)(qb + 16 * s4), X);
            if (st == tt) {
#pragma unroll
                for (int i = 0; i < 16; ++i) { const int cr = (i & 3) + 8 * (i >> 2) + 4 * hh; X[i] = (cr <= r) ? X[i] : 0.f; } }
#pragma unroll
            for (int s2 = 0; s2 < 2; ++s2) {
                u32x4 pw; pw.x = pk2(X[8 * s2 + 0], X[8 * s2 + 1]); pw.y = pk2(X[8 * s2 + 2], X[8 * s2 + 3]); pw.z = pk2(X[8 * s2 + 4], X[8 * s2 + 5]); pw.w = pk2(X[8 * s2 + 6], X[8 * s2 + 7]);
                const LAS bf16_t* vp = va + (32 * st + 16 * s2) * VS;
                const s16x4 lo = tr_read(vp), hi = tr_read(vp + 8 * VS);
                Y = MFMA32(((bf16x8){lo[0], lo[1], lo[2], lo[3], hi[0], hi[1], hi[2], hi[3]}), __builtin_bit_cast(bf16x8, pw), Y); }
        }
    }
    float p = 0.f;
#pragma unroll
    for (int i = 0; i < 16; ++i) p += Y[i] * Y[i];
    p += shx(p, 32, lane);
    if (hh == 0) red[et * 64 + 32 * tt + r] = p;
    __syncthreads();
    const int tl = 32 * tt + r;
    const float rs = rsqrtf(((red[tl] + red[64 + tl]) + (red[128 + tl] + red[192 + tl])) * (1.f / 128.f) + EPS);
    bf16_t* mx = wsp<bf16_t>(F, WS_MIX) + (size_t)(t0 + tl) * D + h * 128 + 32 * et + 4 * hh;
#pragma unroll
    for (int g4 = 0; g4 < 4; ++g4) { const u32x2 rr = grv[g4]; const f32x4 g = gnv[g4];
        u32x2 o; o.x = pk2(Y[4 * g4 + 0] * rs * g[0] * siluf(bf2f(rr.x & 0xffffu)), Y[4 * g4 + 1] * rs * g[1] * siluf(bf2f(rr.x >> 16)));
        o.y = pk2(Y[4 * g4 + 2] * rs * g[2] * siluf(bf2f(rr.y & 0xffffu)), Y[4 * g4 + 3] * rs * g[3] * siluf(bf2f(rr.y >> 16)));
        *(u32x2*)(mx + 8 * g4) = o; }
    __syncthreads();
}

struct SCIn { u32x4 a[6], b[6], cb[4]; f32x4 w[3][2]; };
__device__ __forceinline__ void sconv_load(const Frame& F, int it, int layer, SCIn& g) {
    const bf16_t* __restrict__ z = wsp<bf16_t>(F, WS_Z); const float* wc = (const float*)in_ptr(9) + layer * 3 * 512; const int c0 = (F.tid & 63) * 8, t0 = 4 * (it >> 6);
#pragma unroll
    for (int jj = 0; jj < 3; ++jj) { g.w[jj][0] = *(const f32x4*)(wc + jj * 512 + c0); g.w[jj][1] = *(const f32x4*)(wc + jj * 512 + c0 + 4); }
#pragma unroll
    for (int r = 0; r < 6; ++r) { const int ts = t0 - 2 + r, tc = ts < 0 ? 0 : ts; g.a[r] = *(const u32x4*)(z + (size_t)tc * NZ + ZCC + c0); g.b[r] = *(const u32x4*)(z + (size_t)tc * NZ + ZCH + c0); }
#pragma unroll
    for (int k = 0; k < 4; ++k) g.cb[k] = *(const u32x4*)(z + (size_t)(t0 + k) * NZ + ZCB + c0);
}
__device__ __forceinline__ void sconv_compute(const Frame& F, int it, const SCIn& g) {
    bf16_t* __restrict__ mix = wsp<bf16_t>(F, WS_MIX); const int c0 = (F.tid & 63) * 8, t0 = 4 * (it >> 6);
    float p[6][8];
#pragma unroll
    for (int r = 0; r < 6; ++r) { const unsigned aa[4] = {g.a[r].x, g.a[r].y, g.a[r].z, g.a[r].w}, bb[4] = {g.b[r].x, g.b[r].y, g.b[r].z, g.b[r].w}; const bool ok = (t0 - 2 + r) >= 0;
#pragma unroll
        for (int q = 0; q < 4; ++q) { p[r][2 * q] = ok ? bf2f(aa[q] & 0xffffu) * bf2f(bb[q] & 0xffffu) : 0.f; p[r][2 * q + 1] = ok ? bf2f(aa[q] >> 16) * bf2f(bb[q] >> 16) : 0.f; } }
#pragma unroll
    for (int k = 0; k < 4; ++k) { float acc[8];
#pragma unroll
        for (int e = 0; e < 8; ++e) { acc[e] = g.w[0][e >> 2][e & 3] * p[k][e]; acc[e] += g.w[1][e >> 2][e & 3] * p[k + 1][e]; acc[e] += g.w[2][e >> 2][e & 3] * p[k + 2][e]; }
        const unsigned cc[4] = {g.cb[k].x, g.cb[k].y, g.cb[k].z, g.cb[k].w}; unsigned ow[4];
#pragma unroll
        for (int q = 0; q < 4; ++q) ow[q] = pk2(acc[2 * q] * bf2f(cc[q] & 0xffffu), acc[2 * q + 1] * bf2f(cc[q] >> 16));
        *(u32x4*)(mix + (size_t)(t0 + k) * D + 1536 + c0) = (u32x4){ow[0], ow[1], ow[2], ow[3]}; }
}
__device__ __forceinline__ void scan_sconv_phase(Frame& F, int layer) {
    constexpr int NIT = (T / 4) * 64; const int it0 = F.bid * 512 + F.tid, stride = F.G * 512;
    SCIn g; sconv_load(F, it0 < NIT ? it0 : 0, layer, g);
    gla_scan4(F);
    if (it0 < NIT) sconv_compute(F, it0, g);
    for (int it = it0 + stride; it < NIT; it += stride) { SCIn h; sconv_load(F, it, layer, h); sconv_compute(F, it, h); }
}
__device__ __forceinline__ void xsoftmax_phase(Frame& F) {
    const float* sc = wsp<float>(F, WS_SC); bf16_t* pb = wsp<bf16_t>(F, WS_PB);
    for (int it = F.bid * 8 + F.wave; it < T * 4; it += F.G * 8) { const f32x4 v = *((const f32x4*)(sc + (size_t)it * 256) + F.lane);
        const float m = wave_max(fmaxf(fmaxf(v[0], v[1]), fmaxf(v[2], v[3])), F.lane);
        const float e0 = __expf(v[0] - m), e1 = __expf(v[1] - m), e2 = __expf(v[2] - m), e3 = __expf(v[3] - m); const float inv = 1.f / wave_sum((e0 + e1) + (e2 + e3), F.lane);
        u32x2 o; o.x = pk2(e0 * inv, e1 * inv); o.y = pk2(e2 * inv, e3 * inv); *((u32x2*)(pb + (size_t)it * 256) + F.lane) = o; }
}
__device__ __forceinline__ void fconv_phase(Frame& F, const Args& A, int layer) {
    const bf16_t* u = wsp<bf16_t>(F, WS_U); bf16_t* ab = wsp<bf16_t>(F, WS_AB); const float* wc = (const float*)in_ptr(19) + (size_t)layer * 3 * NUP; const float* bc = (const float*)in_ptr(20) + (size_t)layer * NUP;
    for (int it = F.bid * 512 + F.tid; it < T * 704; it += F.G * 512) { const int t = it / 704, c0 = (it % 704) * 8; float g[8], v[8];
#pragma unroll
        for (int e = 0; e < 8; ++e) { g[e] = bc[c0 + e]; v[e] = bc[DFF + c0 + e]; }
#pragma unroll
        for (int jj = 0; jj < 3; ++jj) { const int ts = t - 2 + jj; if (ts < 0) continue;
            const u32x4 a = *(const u32x4*)(u + (size_t)ts * NUP + c0), b = *(const u32x4*)(u + (size_t)ts * NUP + DFF + c0); const unsigned aa[4] = {a.x, a.y, a.z, a.w}, bb[4] = {b.x, b.y, b.z, b.w};
#pragma unroll
            for (int p = 0; p < 4; ++p) { g[2 * p] += wc[jj * NUP + c0 + 2 * p] * bf2f(aa[p] & 0xffffu); g[2 * p + 1] += wc[jj * NUP + c0 + 2 * p + 1] * bf2f(aa[p] >> 16);
                v[2 * p] += wc[jj * NUP + DFF + c0 + 2 * p] * bf2f(bb[p] & 0xffffu); v[2 * p + 1] += wc[jj * NUP + DFF + c0 + 2 * p + 1] * bf2f(bb[p] >> 16); } }
        unsigned ow[4];
#pragma unroll
        for (int p = 0; p < 4; ++p) ow[p] = pk2(siluf(g[2 * p]) * v[2 * p], siluf(g[2 * p + 1]) * v[2 * p + 1]);
        *(u32x4*)(ab + (size_t)t * DFF + c0) = (u32x4){ow[0], ow[1], ow[2], ow[3]}; }
}
__device__ __forceinline__ void final_phase(Frame& F, const Args& A, float* out) {
    const bf16_t* hb = wsp<bf16_t>(F, WS_HB); const float* ss = ss_ptr(F, 12); const f32x4* gr = (const f32x4*)in_ptr(22) + F.lane;
    for (int m = F.bid * 8 + F.wave; m < T; m += F.G * 8) { const float rs = rsqrtf(wave_sum(F.lane < 32 ? ss[(size_t)m * 32 + F.lane] : 0.f, F.lane) * (1.f / D) + EPS);
        const u32x2* hr = (const u32x2*)(hb + (size_t)m * D) + F.lane; f32x4* o = (f32x4*)(out + (size_t)m * D) + F.lane;
#pragma unroll
        for (int j = 0; j < 8; ++j) { const u32x2 b = hr[64 * j]; const f32x4 g = gr[64 * j];
            __builtin_nontemporal_store((f32x4){bf2f(b.x & 0xffffu) * rs * g[0], bf2f(b.x >> 16) * rs * g[1], bf2f(b.y & 0xffffu) * rs * g[2], bf2f(b.y >> 16) * rs * g[3]}, o + 64 * j); } }
}
__device__ __forceinline__ void ffn_fixup(Frame& F, int pm, int layer) {
    const bf16_t* HT = wsp<bf16_t>(F, WS_HT); bf16_t* ab = wsp<bf16_t>(F, WS_AB);
    const float* wcv = (const float*)in_ptr(19) + (size_t)layer * 3 * NUP; const float* bcv = (const float*)in_ptr(20) + (size_t)layer * NUP;
    for (int chunk = F.tid; chunk < 704; chunk += 512) {
        const int ch = 8 * chunk, col = 256 * (ch >> 7) + (ch & 127);
        f32x4 wg[3][2], wv[3][2], bg[2], bv[2];
#pragma unroll
        for (int jj = 0; jj < 3; ++jj)
#pragma unroll
            for (int hh = 0; hh < 2; ++hh) { wg[jj][hh] = *(const f32x4*)(wcv + jj * NUP + ch + 4 * hh); wv[jj][hh] = *(const f32x4*)(wcv + jj * NUP + DFF + ch + 4 * hh); }
#pragma unroll
        for (int hh = 0; hh < 2; ++hh) { bg[hh] = *(const f32x4*)(bcv + ch + 4 * hh); bv[hh] = *(const f32x4*)(bcv + DFF + ch + 4 * hh); }
        u32x4 xg[4][4], xv[4][4];
#pragma unroll
        for (int q = 0; q < 4; ++q) { const int kb = 4 * pm + q;
#pragma unroll
            for (int rr = 0; rr < 4; ++rr) { const bool z = (rr < 2) && (kb == 0); const bf16_t* rp = HT + (size_t)(rr < 2 ? (z ? 0 : kb - 1) * 4 + 2 + rr : kb * 4 + (rr - 2)) * NUP + col;
                const u32x4 zz = (u32x4){0u, 0u, 0u, 0u}; xg[q][rr] = z ? zz : *(const u32x4*)rp; xv[q][rr] = z ? zz : *(const u32x4*)(rp + 128); } }
#pragma unroll
        for (int q = 0; q < 4; ++q) { const int kb = 4 * pm + q;
            f32x4 rg[4][2], rv[4][2];
#pragma unroll
            for (int rr = 0; rr < 4; ++rr) { const u32x4 a = xg[q][rr], b = xv[q][rr];
                rg[rr][0] = (f32x4){bf2f(a.x & 0xffffu), bf2f(a.x >> 16), bf2f(a.y & 0xffffu), bf2f(a.y >> 16)}; rg[rr][1] = (f32x4){bf2f(a.z & 0xffffu), bf2f(a.z >> 16), bf2f(a.w & 0xffffu), bf2f(a.w >> 16)};
                rv[rr][0] = (f32x4){bf2f(b.x & 0xffffu), bf2f(b.x >> 16), bf2f(b.y & 0xffffu), bf2f(b.y >> 16)}; rv[rr][1] = (f32x4){bf2f(b.z & 0xffffu), bf2f(b.z >> 16), bf2f(b.w & 0xffffu), bf2f(b.w >> 16)}; }
#pragma unroll
            for (int i = 0; i < 2; ++i) {
                unsigned ow[4];
#pragma unroll
                for (int hh = 0; hh < 2; ++hh) { const f32x4 G = bg[hh] + wg[0][hh] * rg[i][hh] + wg[1][hh] * rg[i + 1][hh] + wg[2][hh] * rg[i + 2][hh];
                    const f32x4 V = bv[hh] + wv[0][hh] * rv[i][hh] + wv[1][hh] * rv[i + 1][hh] + wv[2][hh] * rv[i + 2][hh];
                    ow[2 * hh] = pk2(pg8::silu_fast(G[0]) * V[0], pg8::silu_fast(G[1]) * V[1]); ow[2 * hh + 1] = pk2(pg8::silu_fast(G[2]) * V[2], pg8::silu_fast(G[3]) * V[3]); }
                *(u32x4*)(ab + (size_t)(64 * kb + i) * DFF + ch) = (u32x4){ow[0], ow[1], ow[2], ow[3]}; } }
    }
}
__device__ __forceinline__ void fill_rstd_table(Frame& F, const float* ssp, int pm) {
    LAS float* rtab = (LAS float*)(__builtin_amdgcn_groupstaticsize() + MISC_OFF + 1024);
    if (pm >= 0) { const int row = F.tid >> 1, hf = F.tid & 1; const f32x4* p = (const f32x4*)(ssp + ((size_t)pm * 256 + row) * 32 + 16 * hf);
        const f32x4 a = p[0], b = p[1], c = p[2], d = p[3];
        float sacc = (((a[0] + a[1]) + (a[2] + a[3])) + ((b[0] + b[1]) + (b[2] + b[3]))) + (((c[0] + c[1]) + (c[2] + c[3])) + ((d[0] + d[1]) + (d[2] + d[3])));
        sacc += shx(sacc, 1, F.lane);
        if (hf == 0) rtab[row] = rsqrtf(sacc * (1.f / D) + EPS); }
    __syncthreads();
}
__device__ __forceinline__ void frame_refresh(Frame& F) {
    int ln; asm volatile("v_mbcnt_lo_u32_b32 %0, -1, 0\n\tv_mbcnt_hi_u32_b32 %0, -1, %0" : "=v"(ln)); F.lane = ln; F.tid = (F.wave << 6) | ln; F.ws = ws_ptr();
}
constexpr int PH_PER_LAYER = 9, N_PHASES = 1 + NL * PH_PER_LAYER + 1;
__global__ void __launch_bounds__(512, 2) fwd(Args args) {
    extern __shared__ __attribute__((aligned(16))) unsigned char lds_raw[];
    Frame F; F.lds = (LAS unsigned char*)lds_raw; F.ws = args.ws;
    F.tid = threadIdx.x; F.lane = F.tid & 63; F.wave = __builtin_amdgcn_readfirstlane(F.tid >> 6); F.G = gridDim.x; F.bid = blockIdx.x;
    volatile LAS unsigned* MISC = (volatile LAS unsigned*)(F.lds + MISC_OFF);
    if (F.tid < 64) MISC[F.tid] = 0u;
    __syncthreads();
    XcdBarrier bar; bar.bar = (unsigned*)(args.ws + WS_CTL) + CW_BAR; bar.x = 0; bar.st = nullptr;
#if MK_ONE_LAUNCH
    bar = xcd_barrier_post((unsigned*)(args.ws + WS_CTL) + CW_BAR, MISC + 8);
#define SEAM() xcd_barrier(bar)
#else
#define SEAM() do {} while (0)
#endif
    const int lo = args.ph_lo, hi = args.ph_hi;
#define IN(k) (lo <= (k) && (k) < hi && (frame_refresh(F), true))
    const int cid = (int)blockIdx.x;

    if (IN(0)) { p_prologue(F, args); SEAM(); }
    for (int l = 0; l < NL; ++l) {
        const int p0 = 1 + l * PH_PER_LAYER;
        if (IN(p0 + 0)) {
            pg8::TileOrder S; S.init(wsp<bf16_t>(F, WS_HB), wsp<bf16_t>(F, WS_WIN + l * SZ_WIN), T, NZ, D, D, F.G, cid);
            pg8::EpiScaleBf16 E{wsp<bf16_t>(F, WS_Z), NZ, ss_ptr(F, 3 * l + 0), ZG / 256, wsp<float>(F, WS_LA), (const float*)in_ptr(6) + l * 256};
            pg8::gemm_phase<pg8::EpiScaleBf16, pg8::TileOrder, true>(F.lds, pg8::Gemm{D, D, D}, S, E, F.tid);
            if (l == 0) { KVOrder S2{F.ws, F.G, (cid + F.G - 64) % F.G}; pg8::EpiPlain E2; pg8::gemm_phase<pg8::EpiPlain, KVOrder, true>(F.lds, pg8::Gemm{D, D, D}, S2, E2, F.tid); }
            { const int first = (l == 0) ? 128 : 64; convert_slot(F, l, NA_HEAD, CV_T, false, cid - first, F.G - first); }
            SEAM(); }
        if (IN(p0 + 1)) {
            for (int u = cid; u < 512; u += F.G) gla_local_mfma(F, u);
            if (l == 0) { FoldOrder S2{F.ws, F.G, cid}; pg8::EpiPlain E2; pg8::gemm_phase<pg8::EpiPlain, FoldOrder, true>(F.lds, pg8::Gemm{512, D, D}, S2, E2, F.tid); }
            SEAM(); }
        if (IN(p0 + 2)) {
            scan_sconv_phase(F, l);
            for (int u = cid; u < 256; u += F.G) swa_unit_mfma(F, u, l);
            SEAM(); }
        if (IN(p0 + 3)) { for (int u = cid; u < 512; u += F.G) gla_out_mfma(F, u, l); SEAM(); }
        if (IN(p0 + 4)) {
            pg8::TileOrder S; S.init(wsp<bf16_t>(F, WS_MIX), wsp<bf16_t>(F, WS_WOUT + l * SZ_W22), T, D, D, D, F.G, cid);
            pg8::EpiRes E{wsp<bf16_t>(F, WS_HB), ss_ptr(F, 3 * l + 1)};
            pg8::gemm_phase<pg8::EpiRes, pg8::TileOrder, true>(F.lds, pg8::Gemm{D, D, D}, S, E, F.tid); SEAM(); }
        if (IN(p0 + 5)) {
            pg8::TileOrder S; S.init(wsp<bf16_t>(F, WS_HB), wsp<bf16_t>(F, WS_WST + l * SZ_WS), T, NSC, D, D, F.G, cid);
            pg8::EpiSoftmax E{wsp<bf16_t>(F, WS_PB), ss_ptr(F, 3 * l + 1)};
            pg8::gemm_phase<pg8::EpiSoftmax, pg8::TileOrder, false>(F.lds, pg8::Gemm{D, D, D}, S, E, F.tid);
            convert_slot(F, l, CV_T, NA, false, cid - 128, F.G - 128);
            SEAM(); }
        if (IN(p0 + 6)) {
            pg8::TileOrder S; S.init(wsp<bf16_t>(F, WS_PB), wsp<bf16_t>(F, WS_VWT + l * SZ_WS), T, D, NSC, NSC, F.G, cid);
            pg8::EpiRes E{wsp<bf16_t>(F, WS_HB), ss_ptr(F, 3 * l + 2)};
            pg8::gemm_phase<pg8::EpiRes, pg8::TileOrder, true>(F.lds, pg8::Gemm{NSC, NSC, NSC}, S, E, F.tid); SEAM(); }
        if (IN(p0 + 7)) {
            pg8::TileOrder S; S.init(wsp<bf16_t>(F, WS_HB), wsp<bf16_t>(F, WS_WUP + l * SZ_WUP), T, NUP, D, D, F.G, cid);
            pg8::EpiUpConv E{wsp<bf16_t>(F, WS_AB), wsp<bf16_t>(F, WS_HT), ss_ptr(F, 3 * l + 2), (const float*)in_ptr(19) + (size_t)l * 3 * NUP, (const float*)in_ptr(20) + (size_t)l * NUP};
            pg8::gemm_phase<pg8::EpiUpConv, pg8::TileOrder, true>(F.lds, pg8::Gemm{D, D, D}, S, E, F.tid);
            if (l + 1 < NL) convert_slot(F, l + 1, 0, NA_HEAD, true, cid - 128, F.G - 128);
            SEAM(); }
        if (IN(p0 + 8)) {
            pg8::TileOrder S; S.init(wsp<bf16_t>(F, WS_AB), wsp<bf16_t>(F, WS_WDN + l * SZ_WDN), T, D, DFF, DFF, F.G, cid);
            { pg8::Unit u0; for (int i = 0; S.next(i, u0); ++i) ffn_fixup(F, u0.pm, l); VM_WAIT(); __syncthreads(); }
            pg8::EpiRes E{wsp<bf16_t>(F, WS_HB), ss_ptr(F, 3 * l + 3)};
            pg8::gemm_phase<pg8::EpiRes, pg8::TileOrder, true>(F.lds, pg8::Gemm{DFF, DFF, DFF}, S, E, F.tid); SEAM(); }
    }
    if (IN(N_PHASES - 1)) final_phase(F, args, args.out);
#undef IN
#undef SEAM
}

extern "C" void kernel_launch(void* const* d_in, const int* in_sizes, int n_in, void* d_out, int out_size, void* d_ws, size_t ws_size, hipStream_t stream) {
    static int grid = 0;
    if (grid == 0) {
        if (n_in != 23 || ws_size < WS_END) { fprintf(stderr, "kernel_launch: expected 23 inputs and >= %zu bytes of workspace (got %d, %zu)\n", (size_t)WS_END, n_in, ws_size); grid = -1; return; }
        int dev = 0, cus = 0, per_cu = 0;
        if (hipGetDevice(&dev) != hipSuccess || hipDeviceGetAttribute(&cus, hipDeviceAttributeMultiprocessorCount, dev) != hipSuccess) { grid = -1; return; }
        if (hipFuncSetAttribute((const void*)fwd, hipFuncAttributeMaxDynamicSharedMemorySize, LDS_BYTES) != hipSuccess) { fprintf(stderr, "kernel_launch: hipFuncSetAttribute failed\n"); grid = -1; return; }
        if (hipOccupancyMaxActiveBlocksPerMultiprocessor(&per_cu, (const void*)fwd, 512, LDS_BYTES) != hipSuccess || per_cu < 1) { fprintf(stderr, "kernel_launch: occupancy query says %d\n", per_cu); }
        (void)hipGetLastError();
        grid = cus;
    }
    if (grid < 0) return;
    (void)hipMemsetAsync((char*)d_ws + WS_CTL, 0, 65536, stream);
    Args a{};
    for (int i = 0; i < 23; ++i) a.in[i] = d_in[i];
    a.out = (float*)d_out; a.ws = (unsigned char*)d_ws;
#if MK_ONE_LAUNCH
    a.ph_lo = 0; a.ph_hi = N_PHASES;
    hipLaunchKernelGGL(fwd, dim3(grid), dim3(512), LDS_BYTES, stream, a);
#else
    for (int p = 0; p < N_PHASES; ++p) { a.ph_lo = p; a.ph_hi = p + 1; hipLaunchKernelGGL(fwd, dim3(grid), dim3(512), LDS_BYTES, stream, a); }
#endif
}
```

```cpp
#include <hip/hip_runtime.h>
#include <cstdio>
#include <cstdint>

#define LAS __attribute__((address_space(3)))
#define GAS __attribute__((address_space(1)))
typedef unsigned short bf16_t;
typedef short bf16x8 __attribute__((ext_vector_type(8)));
typedef float f32x4 __attribute__((ext_vector_type(4)));
typedef float f32x2 __attribute__((ext_vector_type(2)));
typedef unsigned u32x4 __attribute__((ext_vector_type(4)));
typedef unsigned u32x2 __attribute__((ext_vector_type(2)));

#ifndef MK_ONE_LAUNCH
#define MK_ONE_LAUNCH 1
#endif

constexpr int T = 8192, D = 2048, NL = 4, NMEM = 256, NZ = 4608, DFF = 5632, NUP = 11264, NSC = 1024, NIN = 4368;
constexpr float EPS = 1e-6f;
constexpr int ZQ = 0, ZK = 256, ZV = 512, ZR = 1024, ZG = 1536, ZSQ = 1792, ZSK = 2816, ZSV = 2944, ZCB = 3072, ZCC = 3584, ZCH = 4096;

constexpr size_t MiB = 1u << 20;
constexpr size_t WS_CTL = 0, CTL_BYTES = 2 * MiB;
constexpr size_t SZ_WIN = (size_t)NZ * D * 2, SZ_W22 = (size_t)D * D * 2, SZ_WUP = (size_t)NUP * D * 2, SZ_WDN = (size_t)D * DFF * 2;
constexpr size_t SZ_WS = (size_t)NSC * D * 2, SZ_MEM = (size_t)NMEM * D * 2;
constexpr size_t WS_WIN = WS_CTL + CTL_BYTES;
constexpr size_t WS_WOUT = WS_WIN + NL * SZ_WIN;
constexpr size_t WS_WQP = WS_WOUT + NL * SZ_W22;
constexpr size_t WS_WK = WS_WQP + NL * SZ_W22;
constexpr size_t WS_WV = WS_WK + NL * SZ_W22;
constexpr size_t WS_WO = WS_WV + NL * SZ_W22;
constexpr size_t WS_WUP = WS_WO + NL * SZ_W22;
constexpr size_t WS_WDN = WS_WUP + NL * SZ_WUP;
constexpr size_t WS_WST = WS_WDN + NL * SZ_WDN;
constexpr size_t WS_VWT = WS_WST + NL * SZ_WS;
constexpr size_t WS_MEMN = WS_VWT + NL * SZ_WS;
constexpr size_t WS_KMEM = WS_MEMN + NL * SZ_MEM;
constexpr size_t WS_VMEM = WS_KMEM + NL * SZ_MEM;
constexpr size_t WS_ROPE = WS_VMEM + NL * SZ_MEM;
constexpr size_t WS_H = WS_ROPE + 2 * MiB;
constexpr size_t WS_HB = WS_H + (size_t)T * D * 4;
constexpr size_t WS_Z = WS_HB + (size_t)T * D * 2;
constexpr size_t WS_LA = WS_Z + (size_t)T * NZ * 2;
constexpr size_t WS_MIX = WS_LA + (size_t)T * 256 * 4;
constexpr size_t WS_UB = WS_MIX + (size_t)T * D * 2;
constexpr size_t WS_DEC = WS_UB + (size_t)4 * 128 * 64 * 128 * 4;
constexpr size_t WS_SB = WS_DEC + 1 * MiB;
constexpr size_t WS_SC = WS_SB + (size_t)4 * 128 * 64 * 128 * 2;
constexpr size_t WS_PB = WS_SC + (size_t)T * NSC * 4;
constexpr size_t WS_U = WS_PB + (size_t)T * NSC * 2;
constexpr size_t WS_HT = WS_U;
constexpr size_t WS_AB = WS_U + (size_t)T * NUP * 2;
constexpr size_t WS_SSP = WS_AB + (size_t)T * DFF * 2;
constexpr size_t WS_END = WS_SSP + (size_t)13 * T * 32 * 4;
constexpr int CW_TMO = 0, CW_BAR = 4096;

constexpr int RING_BYTES = 131072, MISC_OFF = RING_BYTES, LDS_BYTES = 147456;

__device__ __forceinline__ float bf2f(unsigned b) { return __uint_as_float(b << 16); }
typedef __bf16 bf16x2_t __attribute__((ext_vector_type(2)));
__device__ __forceinline__ unsigned pk2(float lo, float hi) { const f32x2 v = {lo, hi}; return __builtin_bit_cast(unsigned, __builtin_convertvector(v, bf16x2_t)); }
__device__ __forceinline__ unsigned f2bf(float f) { return pk2(f, 0.f) & 0xffffu; }
__device__ __forceinline__ unsigned cvt_pk_bf16(float lo, float hi) { unsigned r; asm volatile("v_cvt_pk_bf16_f32 %0, %1, %2" : "=v"(r) : "v"(lo), "v"(hi)); return r; }
__device__ __forceinline__ float shx(float v, int m, int lane) { return __builtin_bit_cast(float, __builtin_amdgcn_ds_bpermute((lane ^ m) << 2, __builtin_bit_cast(int, v))); }
__device__ __forceinline__ float wave_sum(float v, int lane) {
#pragma unroll
    for (int o = 1; o < 64; o <<= 1) v += shx(v, o, lane);
    return v;
}
__device__ __forceinline__ float wave_max(float v, int lane) {
#pragma unroll
    for (int o = 1; o < 64; o <<= 1) v = fmaxf(v, shx(v, o, lane));
    return v;
}
__device__ __forceinline__ float siluf(float x) { return x / (1.f + __expf(-x)); }
__device__ __forceinline__ float logsigf(float x) { return fminf(x, 0.f) - __logf(1.f + __expf(-fabsf(x))); }
__device__ __forceinline__ void st16_wt(void* p, u32x4 v) { *(u32x4*)p = v; }
#define LDS_WAIT() asm volatile("s_waitcnt lgkmcnt(0)" ::: "memory")
#define VM_WAIT() asm volatile("s_waitcnt vmcnt(0)" ::: "memory")

namespace pg8 {
constexpr int BM = 256, BK = 64, HALF = 128, HTB = HALF * BK * 2, STAGE_BYTES = 8 * HTB, NXCD = 8, WGM = 4;
__host__ __device__ __forceinline__ int lds_byte(int r, int c) { const int st = (r >> 4) * 2 + (c >> 5), rr = r & 15, cc = c & 31, ob = rr * 64 + cc * 2; return st * 1024 + (ob ^ (((ob >> 9) & 1) << 5)); }
__host__ __device__ __forceinline__ void stage_rc(int b, int& R, int& C) { const int st = b / 1024, sb = b % 1024, swz = sb ^ (((sb >> 9) & 1) << 5); R = (st >> 1) * 16 + swz / 64; C = (st & 1) * 32 + (swz % 64) / 2; }
__host__ __device__ __forceinline__ int perm32(int rho) { const int n = rho >> 4, i = rho & 15; return 8 * (i >> 2) + 4 * n + (i & 3); }

struct Unit { int pm, pn; const char* a; const char* b; char* o; int ldc; float sc; };
struct Gemm { int K, lda, ldb; };

struct TileOrder {
    const char* A; const char* Bt; int nM, nN, nwg, G, c; size_t ta, tb;
    __device__ __forceinline__ void init(const void* A_, const void* Bt_, int M, int N, int lda, int ldb, int G_, int c_) {
        A = (const char*)A_; Bt = (const char*)Bt_; nM = M / BM; nN = N / BM; nwg = nM * nN; G = G_; c = c_; ta = (size_t)BM * lda * 2; tb = (size_t)BM * ldb * 2; }
    __device__ __forceinline__ bool next(int i, Unit& u) const {
        const long L = (long)i * G + c; if (L >= nwg) return false;
        int wgid = (int)L; { const int q = nwg / NXCD, r = nwg % NXCD, xcd = wgid % NXCD, off = wgid / NXCD; wgid = (xcd < r ? xcd * (q + 1) : r * (q + 1) + (xcd - r) * q) + off; }
        const int nig = WGM * nN, gid = wgid / nig, fm = gid * WGM, gsz = (nM - fm) < WGM ? (nM - fm) : WGM;
        u.pm = fm + ((wgid % nig) % gsz); u.pn = (wgid % nig) / gsz;
        u.a = A + (size_t)u.pm * ta; u.b = Bt + (size_t)u.pn * tb; u.o = nullptr; u.ldc = 0; u.sc = 1.f; return true;
    }
    __device__ __forceinline__ void a_ready(const Unit&) const {}
    __device__ __forceinline__ void done(const Unit&) const {}
};

template <class Epi, class Sched, bool ALIGN_EPI>
__device__ __forceinline__ void gemm_phase(LAS unsigned char* lds, const Gemm g, const Sched& S, const Epi& E, int tid_in) {
    int tid_ = tid_in; asm volatile("" : "+v"(tid_));
    const int tid = tid_, wid = __builtin_amdgcn_readfirstlane(tid >> 6), lane = tid & 63, wr = wid >> 2, wc = wid & 3, fr = lane & 15, fq = lane >> 4;
    const int K = g.K, nt = K / BK;
    unsigned voffA[2], voffB[2];
#pragma unroll
    for (int i = 0; i < 2; ++i) { int R, C; stage_rc(tid * 16 + i * 8192, R, C); const int Rb = Epi::PERM ? ((R & ~31) + perm32(R & 31)) : R;
        const int Ra = Epi::ROWPERM ? ((R & 64) | ((R & 15) << 2) | ((R >> 4) & 3)) : R;
        voffA[i] = (unsigned)(Ra * g.lda + C) * 2u; voffB[i] = (unsigned)(Rb * g.ldb + C) * 2u; }
    const size_t kstep = (size_t)(BK * 2);
    const size_t hstepA = (size_t)HALF * g.lda * 2, hstepB = (size_t)HALF * g.ldb * 2;
    const unsigned ldsw = (unsigned)wid * 1024u;
    const int aoff = lds_byte(wr * 64 + fr, fq * 8), boff = lds_byte(wc * 32 + fr, fq * 8);
#define PG8_SA(b, h) (((b) * 2 + (h)) * HTB)
#define PG8_SB(b, h) ((4 + (b) * 2 + (h)) * HTB)
#define PG8_STAGE(bufoff, gbase, voff) do { _Pragma("unroll") for (int _i = 0; _i < 2; ++_i) \
        __builtin_amdgcn_global_load_lds((const unsigned*)((const char*)(gbase) + (voff)[_i]), (LAS unsigned*)(lds + (bufoff) + ldsw + _i * 8192), 16, 0, 0); } while (0)
#define PG8_LDA(dst, b, h) do { _Pragma("unroll") for (int m = 0; m < 4; ++m) _Pragma("unroll") for (int k = 0; k < 2; ++k) dst[m][k] = *(const LAS bf16x8*)(lds + PG8_SA(b, h) + aoff + m * 2048 + k * 1024); } while (0)
#define PG8_LDB(dst, b, h) do { _Pragma("unroll") for (int n = 0; n < 2; ++n) _Pragma("unroll") for (int k = 0; k < 2; ++k) dst[n][k] = *(const LAS bf16x8*)(lds + PG8_SB(b, h) + boff + n * 2048 + k * 1024); } while (0)
#define PG8_MMA(ai, bj, At, Bt) do { __builtin_amdgcn_s_setprio(1); _Pragma("unroll") for (int m = 0; m < 4; ++m) _Pragma("unroll") for (int n = 0; n < 2; ++n) _Pragma("unroll") for (int k = 0; k < 2; ++k) \
        acc[ai][bj][m][n] = __builtin_amdgcn_mfma_f32_16x16x32_bf16(Bt[n][k], At[m][k], acc[ai][bj][m][n], 0, 0, 0); __builtin_amdgcn_s_setprio(0); } while (0)
#define PG8_WAIT_V(n) asm volatile("s_waitcnt vmcnt(" #n ")" ::: "memory")
#define PG8_WAIT_L(n) asm volatile("s_waitcnt lgkmcnt(" #n ")" ::: "memory")
#define PG8_BAR __builtin_amdgcn_s_barrier()
#define PG8_SCHED __builtin_amdgcn_sched_barrier(0)
    Unit cur, nxt; int ui = 0;
    if (!S.next(0, cur)) return;
    f32x4 acc[2][2][4][2];
#pragma unroll
    for (int a = 0; a < 2; ++a)
#pragma unroll
        for (int b = 0; b < 2; ++b)
#pragma unroll
            for (int m = 0; m < 4; ++m)
#pragma unroll
                for (int n = 0; n < 2; ++n) acc[a][b][m][n] = (f32x4){0.f, 0.f, 0.f, 0.f};
    bf16x8 At[4][2], B0[2][2], B1[2][2];
    const char* cA = cur.a; const char* cB = cur.b;
    S.a_ready(cur);
    PG8_STAGE(PG8_SB(0, 0), cB, voffB); PG8_STAGE(PG8_SB(0, 1), cB + hstepB, voffB); PG8_STAGE(PG8_SA(0, 0), cA, voffA); PG8_STAGE(PG8_SA(0, 1), cA + hstepA, voffA);
    PG8_STAGE(PG8_SB(1, 0), cB + kstep, voffB); PG8_STAGE(PG8_SA(1, 0), cA + kstep, voffA); PG8_STAGE(PG8_SB(1, 1), cB + hstepB + kstep, voffB);
    if constexpr (Epi::PREFILL) E.prefill(tid);
    if (wr == 1) PG8_BAR;
    PG8_WAIT_V(8); PG8_BAR;
    PG8_WAIT_V(6); PG8_BAR;
    for (;;) {
        const bool has_next = S.next(ui + 1, nxt);
        const char* nA = has_next ? nxt.a : cA; const char* nB = has_next ? nxt.b : cB;
        for (int t = 0; t < nt; t += 2) {
            const bool last = (t == nt - 2);
            const char* a1 = cA + (size_t)(t + 1) * kstep;
            const char* a2 = last ? nA : cA + (size_t)(t + 2) * kstep; const char* b2 = last ? nB : cB + (size_t)(t + 2) * kstep;
            const char* a3 = a2 + kstep; const char* b3 = b2 + kstep;
            if (last && has_next) S.a_ready(nxt);
            PG8_LDB(B0, 0, 0); PG8_LDB(B1, 0, 1); PG8_SCHED; PG8_LDA(At, 0, 0); PG8_STAGE(PG8_SA(1, 1), a1 + hstepA, voffA);
            PG8_WAIT_V(8); PG8_WAIT_L(0); PG8_BAR; PG8_MMA(0, 0, At, B0); PG8_MMA(0, 1, At, B1); PG8_BAR; PG8_SCHED;
            PG8_LDA(At, 0, 1); PG8_STAGE(PG8_SB(0, 0), b2, voffB); PG8_STAGE(PG8_SB(0, 1), b2 + hstepB, voffB); PG8_STAGE(PG8_SA(0, 0), a2, voffA);
            PG8_WAIT_V(8); PG8_WAIT_L(0); PG8_BAR; PG8_MMA(1, 0, At, B0); PG8_MMA(1, 1, At, B1); PG8_BAR; PG8_SCHED;
            PG8_LDB(B0, 1, 0); PG8_LDB(B1, 1, 1); PG8_SCHED; PG8_LDA(At, 1, 0); PG8_STAGE(PG8_SA(0, 1), a2 + hstepA, voffA);
            PG8_WAIT_V(8); PG8_WAIT_L(0); PG8_BAR; PG8_MMA(0, 0, At, B0); PG8_MMA(0, 1, At, B1); PG8_BAR; PG8_SCHED;
            PG8_LDA(At, 1, 1); PG8_STAGE(PG8_SB(1, 0), b3, voffB); PG8_STAGE(PG8_SB(1, 1), b3 + hstepB, voffB); PG8_STAGE(PG8_SA(1, 0), a3, voffA);
            PG8_WAIT_V(8); PG8_WAIT_L(0); PG8_BAR; PG8_MMA(1, 0, At, B0); PG8_MMA(1, 1, At, B1); PG8_BAR; PG8_SCHED;
        }
        if constexpr (ALIGN_EPI) { if (wr == 0) PG8_BAR; }
        if constexpr (!Epi::AFTER_DRAIN) { int le; asm volatile("v_mbcnt_lo_u32_b32 %0, -1, 0\n\tv_mbcnt_hi_u32_b32 %0, -1, %0" : "=v"(le));
            E(acc, cur, wr, wc, le & 15, le >> 4); S.done(cur); }
        if (!has_next) break;
#pragma unroll
        for (int a = 0; a < 2; ++a)
#pragma unroll
            for (int b = 0; b < 2; ++b)
#pragma unroll
                for (int m = 0; m < 4; ++m)
#pragma unroll
                    for (int n = 0; n < 2; ++n) acc[a][b][m][n] = (f32x4){0.f, 0.f, 0.f, 0.f};
        cur = nxt; cA = nA; cB = nB; ++ui;
        if constexpr (ALIGN_EPI) { if (wr == 1) PG8_BAR; }
    }
    PG8_WAIT_V(0);
    if constexpr (!ALIGN_EPI) { if (wr == 0) PG8_BAR; }
    PG8_BAR;
    if constexpr (Epi::AFTER_DRAIN) { int le; asm volatile("v_mbcnt_lo_u32_b32 %0, -1, 0\n\tv_mbcnt_hi_u32_b32 %0, -1, %0" : "=v"(le)); E.fused(acc, cur, wr, wc, le & 15, le >> 4, lds, wid, le); S.done(cur); }
#undef PG8_SA
#undef PG8_SB
#undef PG8_STAGE
#undef PG8_LDA
#undef PG8_LDB
#undef PG8_MMA
#undef PG8_WAIT_V
#undef PG8_WAIT_L
#undef PG8_BAR
#undef PG8_SCHED
}


__device__ __forceinline__ float row_rstd_l(const float* ssp, int row, int fq, int lane) {
    const f32x4* p = (const f32x4*)(ssp + (size_t)row * 32 + 8 * fq); const f32x4 a = p[0], b = p[1];
    float s = ((a[0] + a[1]) + (a[2] + a[3])) + ((b[0] + b[1]) + (b[2] + b[3]));
    s += shx(s, 16, lane); s += shx(s, 32, lane);
    return rsqrtf(s * (1.f / D) + EPS);
}
__device__ __forceinline__ float row_rstd(const float* ssp, int row, int fq) { return row_rstd_l(ssp, row, fq, (row & 15) + 16 * fq); }
__device__ __forceinline__ void rstd8(const float* ssp, int row0, int fq, float (&rs)[2][4]) {
    f32x4 a[2][4], b[2][4];
#pragma unroll
    for (int ai = 0; ai < 2; ++ai)
#pragma unroll
        for (int m = 0; m < 4; ++m) { const f32x4* p = (const f32x4*)(ssp + (size_t)(row0 + ai * HALF + m * 16) * 32 + 8 * fq); a[ai][m] = p[0]; b[ai][m] = p[1]; }
#pragma unroll
    for (int ai = 0; ai < 2; ++ai)
#pragma unroll
        for (int m = 0; m < 4; ++m) rs[ai][m] = ((a[ai][m][0] + a[ai][m][1]) + (a[ai][m][2] + a[ai][m][3])) + ((b[ai][m][0] + b[ai][m][1]) + (b[ai][m][2] + b[ai][m][3]));
#pragma unroll
    for (int ai = 0; ai < 2; ++ai)
#pragma unroll
        for (int m = 0; m < 4; ++m) rs[ai][m] += shx(rs[ai][m], 16, (row0 & 15) + 16 * fq);
#pragma unroll
    for (int ai = 0; ai < 2; ++ai)
#pragma unroll
        for (int m = 0; m < 4; ++m) rs[ai][m] += shx(rs[ai][m], 32, (row0 & 15) + 16 * fq);
#pragma unroll
    for (int ai = 0; ai < 2; ++ai)
#pragma unroll
        for (int m = 0; m < 4; ++m) rs[ai][m] = rsqrtf(rs[ai][m] * (1.f / D) + EPS);
}
__device__ __forceinline__ void rstd_table_fill(const float* ssp, int tid) {
    LAS float* rtab = (LAS float*)(__builtin_amdgcn_groupstaticsize() + MISC_OFF + 1024);
    const int pm = 4 * ((int)blockIdx.x & 7) + (((int)blockIdx.x >> 3) & 3), row = tid >> 1, hf = tid & 1; const f32x4* p = (const f32x4*)(ssp + ((size_t)pm * 256 + row) * 32 + 16 * hf);
    const f32x4 a = p[0], b = p[1], c = p[2], d = p[3];
    float sacc = (((a[0] + a[1]) + (a[2] + a[3])) + ((b[0] + b[1]) + (b[2] + b[3]))) + (((c[0] + c[1]) + (c[2] + c[3])) + ((d[0] + d[1]) + (d[2] + d[3])));
    sacc += shx(sacc, 1, tid & 63);
    if (hf == 0) rtab[row] = rsqrtf(sacc * (1.f / D) + EPS);
    __syncthreads();
}
__device__ __forceinline__ void rstd8_tab(const float* ssp, const Unit& u, int wr, int fr, int fq, float (&rs)[2][4]) {
    const LAS float* rtab = (const LAS float*)(__builtin_amdgcn_groupstaticsize() + MISC_OFF + 1024);
    const int tab_pm = 4 * ((int)blockIdx.x & 7) + (((int)blockIdx.x >> 3) & 3);
    if (u.pm == tab_pm) {
#pragma unroll
        for (int ai = 0; ai < 2; ++ai)
#pragma unroll
            for (int m = 0; m < 4; ++m) rs[ai][m] = rtab[wr * 64 + fr + ai * HALF + m * 16];
    } else {
#pragma unroll
        for (int ai = 0; ai < 2; ++ai)
#pragma unroll
            for (int m = 0; m < 4; ++m) { rs[ai][m] = row_rstd(ssp, u.pm * BM + wr * 64 + fr + ai * HALF + m * 16, fq); asm volatile("" ::: "memory"); }
    }
}
__device__ __forceinline__ void rstd8_tab4(const float* ssp, const Unit& u, int wr, int fr, int fq, float (&rs)[2][4]) {
    const LAS float* rtab = (const LAS float*)(__builtin_amdgcn_groupstaticsize() + MISC_OFF + 1024);
    const int tab_pm = 4 * ((int)blockIdx.x & 7) + (((int)blockIdx.x >> 3) & 3);
    if (u.pm == tab_pm) {
#pragma unroll
        for (int ai = 0; ai < 2; ++ai) { const f32x4 q = *(const LAS f32x4*)(rtab + wr * 64 + ai * HALF + 4 * fr); rs[ai][0] = q[0]; rs[ai][1] = q[1]; rs[ai][2] = q[2]; rs[ai][3] = q[3]; }
    } else {
#pragma unroll
        for (int ai = 0; ai < 2; ++ai)
#pragma unroll
            for (int m = 0; m < 4; ++m) { rs[ai][m] = row_rstd_l(ssp, u.pm * BM + wr * 64 + ai * HALF + 4 * fr + m, fq, fr + 16 * fq); asm volatile("" ::: "memory"); }
    }
}
struct EpiScaleBf16 {
    static constexpr bool PERM = true, AFTER_DRAIN = false, PREFILL = true, ROWPERM = false;
    __device__ __forceinline__ void prefill(int tid) const { rstd_table_fill(ss, tid); }
    bf16_t* O; int ldc; const float* ss; int gate_pn; float* la; const float* bg;
    __device__ __forceinline__ void operator()(const f32x4 (&acc)[2][2][4][2], const Unit& u, int wr, int wc, int fr, int fq) const {
        const int row0 = u.pm * BM + wr * 64 + fr, cl = wc * 32 + 8 * fq;
        float rs8[2][4]; rstd8_tab(ss, u, wr, fr, fq, rs8);
        if (u.pn == gate_pn) {
#pragma unroll
            for (int ai = 0; ai < 2; ++ai)
#pragma unroll
                for (int m = 0; m < 4; ++m) { const int row = row0 + ai * HALF + m * 16; const float rs = rs8[ai][m];
#pragma unroll
                    for (int bj = 0; bj < 2; ++bj) { const int c = bj * HALF + cl; const f32x4 b0 = *(const f32x4*)(bg + c), b1 = *(const f32x4*)(bg + c + 4);
                        f32x4 v0 = acc[ai][bj][m][0] * rs + b0, v1 = acc[ai][bj][m][1] * rs + b1;
#pragma unroll
                        for (int e = 0; e < 4; ++e) { v0[e] = logsigf(v0[e]) * (1.f / 16.f); v1[e] = logsigf(v1[e]) * (1.f / 16.f); }
                        *(f32x4*)(la + (size_t)row * 256 + c) = v0; *(f32x4*)(la + (size_t)row * 256 + c + 4) = v1; } }
        } else {
#pragma unroll
            for (int ai = 0; ai < 2; ++ai)
#pragma unroll
                for (int m = 0; m < 4; ++m) { const int row = row0 + ai * HALF + m * 16; const float rs = rs8[ai][m];
                    bf16_t* rowp = O + (size_t)row * ldc + u.pn * BM + cl;
#pragma unroll
                    for (int bj = 0; bj < 2; ++bj) { const f32x4 v0 = acc[ai][bj][m][0] * rs, v1 = acc[ai][bj][m][1] * rs;
                        u32x4 w; w.x = cvt_pk_bf16(v0[0], v0[1]); w.y = cvt_pk_bf16(v0[2], v0[3]); w.z = cvt_pk_bf16(v1[0], v1[1]); w.w = cvt_pk_bf16(v1[2], v1[3]);
                        st16_wt(rowp + bj * HALF, w); } }
        }
    }
};
struct EpiPlain {
    static constexpr bool PERM = true, AFTER_DRAIN = false, PREFILL = false, ROWPERM = false;
    __device__ __forceinline__ void operator()(const f32x4 (&acc)[2][2][4][2], const Unit& u, int wr, int wc, int fr, int fq) const {
        const int row0 = u.pm * BM + wr * 64 + fr, cl = u.pn * BM + wc * 32 + 8 * fq; const float sc = u.sc; bf16_t* O = (bf16_t*)u.o;
#pragma unroll
        for (int ai = 0; ai < 2; ++ai)
#pragma unroll
            for (int m = 0; m < 4; ++m) { bf16_t* rowp = O + (size_t)(row0 + ai * HALF + m * 16) * u.ldc + cl;
#pragma unroll
                for (int bj = 0; bj < 2; ++bj) { const f32x4 v0 = acc[ai][bj][m][0] * sc, v1 = acc[ai][bj][m][1] * sc;
                    u32x4 w; w.x = cvt_pk_bf16(v0[0], v0[1]); w.y = cvt_pk_bf16(v0[2], v0[3]); w.z = cvt_pk_bf16(v1[0], v1[1]); w.w = cvt_pk_bf16(v1[2], v1[3]);
                    st16_wt(rowp + bj * HALF, w); } }
    }
};
struct EpiScaleF32 {
    static constexpr bool PERM = false, AFTER_DRAIN = false, PREFILL = false, ROWPERM = false;
    float* O; int ldc; const float* ss;
    __device__ __forceinline__ void operator()(const f32x4 (&acc)[2][2][4][2], const Unit& u, int wr, int wc, int fr, int fq) const {
        const int row0 = u.pm * BM + wr * 64 + fr, c0 = u.pn * BM + wc * 32 + 4 * fq;
#pragma unroll
        for (int ai = 0; ai < 2; ++ai)
#pragma unroll
            for (int m = 0; m < 4; ++m) { const int row = row0 + ai * HALF + m * 16; const float rs = row_rstd(ss, row, fq);
#pragma unroll
                for (int bj = 0; bj < 2; ++bj)
#pragma unroll
                    for (int n = 0; n < 2; ++n) *(f32x4*)(O + (size_t)row * ldc + c0 + bj * HALF + n * 16) = acc[ai][bj][m][n] * rs; }
    }
};
struct EpiRes {
    static constexpr bool PERM = true, AFTER_DRAIN = false, PREFILL = false, ROWPERM = false;
    bf16_t* hb; float* ssn;
    __device__ __forceinline__ void operator()(const f32x4 (&acc)[2][2][4][2], const Unit& u, int wr, int wc, int fr, int fq) const {
        const int row0 = u.pm * BM + wr * 64 + fr, c0 = u.pn * BM + wc * 32 + 8 * fq;
        u32x4 pre[2][4][2];
#pragma unroll
        for (int ai = 0; ai < 2; ++ai)
#pragma unroll
            for (int m = 0; m < 4; ++m)
#pragma unroll
                for (int bj = 0; bj < 2; ++bj) pre[ai][m][bj] = *(const u32x4*)(hb + (size_t)(row0 + ai * HALF + m * 16) * D + c0 + bj * HALF);
#pragma unroll
        for (int ai = 0; ai < 2; ++ai)
#pragma unroll
            for (int m = 0; m < 4; ++m) { const int row = row0 + ai * HALF + m * 16; const size_t off = (size_t)row * D + c0; float s = 0.f;
#pragma unroll
                for (int bj = 0; bj < 2; ++bj) { const u32x4 b = pre[ai][m][bj]; const f32x4 a0 = acc[ai][bj][m][0], a1 = acc[ai][bj][m][1];
                    const float o0 = bf2f(b.x & 0xffffu) + a0[0], o1 = bf2f(b.x >> 16) + a0[1], o2 = bf2f(b.y & 0xffffu) + a0[2], o3 = bf2f(b.y >> 16) + a0[3];
                    const float o4 = bf2f(b.z & 0xffffu) + a1[0], o5 = bf2f(b.z >> 16) + a1[1], o6 = bf2f(b.w & 0xffffu) + a1[2], o7 = bf2f(b.w >> 16) + a1[3];
                    u32x4 w; w.x = cvt_pk_bf16(o0, o1); w.y = cvt_pk_bf16(o2, o3); w.z = cvt_pk_bf16(o4, o5); w.w = cvt_pk_bf16(o6, o7); st16_wt(hb + off + bj * HALF, w);
                    s += ((o0 * o0 + o1 * o1) + (o2 * o2 + o3 * o3)) + ((o4 * o4 + o5 * o5) + (o6 * o6 + o7 * o7)); }
                s += shx(s, 16, fr + 16 * fq); s += shx(s, 32, fr + 16 * fq);
                if (fq == 0) ssn[(size_t)row * 32 + u.pn * 4 + wc] = s; }
    }
};
__device__ __forceinline__ void conv_wrap(f32x4& G0, f32x4& G1, const f32x4& u2, const f32x4& u3, const f32x4& w1, const f32x4& w0) {
    asm("s_nop 1\n\t"
        "v_fmac_f32_dpp %0, %12, %16 row_shr:1 row_mask:0xf bank_mask:0xf\n\t"
        "v_fmac_f32_dpp %1, %13, %17 row_shr:1 row_mask:0xf bank_mask:0xf\n\t"
        "v_fmac_f32_dpp %2, %14, %18 row_shr:1 row_mask:0xf bank_mask:0xf\n\t"
        "v_fmac_f32_dpp %3, %15, %19 row_shr:1 row_mask:0xf bank_mask:0xf\n\t"
        "v_fmac_f32_dpp %0, %8, %20 row_shr:1 row_mask:0xf bank_mask:0xf\n\t"
        "v_fmac_f32_dpp %1, %9, %21 row_shr:1 row_mask:0xf bank_mask:0xf\n\t"
        "v_fmac_f32_dpp %2, %10, %22 row_shr:1 row_mask:0xf bank_mask:0xf\n\t"
        "v_fmac_f32_dpp %3, %11, %23 row_shr:1 row_mask:0xf bank_mask:0xf\n\t"
        "v_fmac_f32_dpp %4, %12, %20 row_shr:1 row_mask:0xf bank_mask:0xf\n\t"
        "v_fmac_f32_dpp %5, %13, %21 row_shr:1 row_mask:0xf bank_mask:0xf\n\t"
        "v_fmac_f32_dpp %6, %14, %22 row_shr:1 row_mask:0xf bank_mask:0xf\n\t"
        "v_fmac_f32_dpp %7, %15, %23 row_shr:1 row_mask:0xf bank_mask:0xf"
        : "+v"(G0[0]), "+v"(G0[1]), "+v"(G0[2]), "+v"(G0[3]), "+v"(G1[0]), "+v"(G1[1]), "+v"(G1[2]), "+v"(G1[3])
        : "v"(u2[0]), "v"(u2[1]), "v"(u2[2]), "v"(u2[3]), "v"(u3[0]), "v"(u3[1]), "v"(u3[2]), "v"(u3[3]), "v"(w1[0]), "v"(w1[1]), "v"(w1[2]), "v"(w1[3]), "v"(w0[0]), "v"(w0[1]), "v"(w0[2]), "v"(w0[3]));
}
__device__ __forceinline__ float exp_sub(float x, float mL) { return __builtin_amdgcn_exp2f(__builtin_fmaf(x, 1.44269504088896341f, -mL)); }
__device__ __forceinline__ float silu_fast(float x) { return x * __builtin_amdgcn_rcpf(1.f + __expf(-x)); }
struct EpiUpConv {
    static constexpr bool PERM = true, AFTER_DRAIN = false, PREFILL = true, ROWPERM = true;
    __device__ __forceinline__ void prefill(int tid) const { rstd_table_fill(ss, tid); }
    bf16_t* AB; bf16_t* HT; const float* ss; const float* wcv; const float* bcv;
    __device__ __forceinline__ void operator()(const f32x4 (&acc)[2][2][4][2], const Unit& u, int wr, int wc, int fr, int fq) const {
        const int row0 = u.pm * BM + wr * 64 + 4 * fr, chl = wc * 32 + 8 * fq, ch0 = u.pn * 128 + chl;
        float rs8[2][4]; rstd8_tab4(ss, u, wr, fr, fq, rs8);
        u32x2 keep[2][4];
        u32x2 hk[2][4];
#pragma unroll
        for (int n = 0; n < 2; ++n) {
            const int ch = ch0 + 4 * n;
            const f32x4 wg0 = *(const f32x4*)(wcv + ch), wg1 = *(const f32x4*)(wcv + NUP + ch), wg2 = *(const f32x4*)(wcv + 2 * NUP + ch), bg = *(const f32x4*)(bcv + ch);
            const f32x4 wv0 = *(const f32x4*)(wcv + DFF + ch), wv1 = *(const f32x4*)(wcv + NUP + DFF + ch), wv2 = *(const f32x4*)(wcv + 2 * NUP + DFF + ch), bv = *(const f32x4*)(bcv + DFF + ch);
#pragma unroll
            for (int ai = 0; ai < 2; ++ai) {
                const int kb = u.pm * 4 + ai * 2 + wr;
                f32x4 ug[4], uv[4];
#pragma unroll
                for (int m = 0; m < 4; ++m) { ug[m] = acc[ai][0][m][n] * rs8[ai][m]; uv[m] = acc[ai][1][m][n] * rs8[ai][m]; }
                {   const bool tail = (fr == 15);
                    const f32x4 g0 = tail ? ug[2] : ug[0], g1 = tail ? ug[3] : ug[1], v0 = tail ? uv[2] : uv[0], v1 = tail ? uv[3] : uv[1];
                    u32x2 q[4]; q[0].x = cvt_pk_bf16(g0[0], g0[1]); q[0].y = cvt_pk_bf16(g0[2], g0[3]); q[1].x = cvt_pk_bf16(g1[0], g1[1]); q[1].y = cvt_pk_bf16(g1[2], g1[3]);
                    q[2].x = cvt_pk_bf16(v0[0], v0[1]); q[2].y = cvt_pk_bf16(v0[2], v0[3]); q[3].x = cvt_pk_bf16(v1[0], v1[1]); q[3].y = cvt_pk_bf16(v1[2], v1[3]);
                    if (n == 0) {
#pragma unroll
                        for (int k = 0; k < 4; ++k) hk[ai][k] = q[k];
                    } else if (fr == 0 || tail) { bf16_t* hb2 = HT + ((size_t)kb * 4 + (tail ? 2 : 0)) * NUP + u.pn * 256 + chl;
                        *(u32x4*)hb2 = (u32x4){hk[ai][0].x, hk[ai][0].y, q[0].x, q[0].y}; *(u32x4*)(hb2 + NUP) = (u32x4){hk[ai][1].x, hk[ai][1].y, q[1].x, q[1].y};
                        *(u32x4*)(hb2 + 128) = (u32x4){hk[ai][2].x, hk[ai][2].y, q[2].x, q[2].y}; *(u32x4*)(hb2 + NUP + 128) = (u32x4){hk[ai][3].x, hk[ai][3].y, q[3].x, q[3].y}; } }
                f32x4 G[4], V[4];
                G[0] = bg + wg2 * ug[0];                               V[0] = bv + wv2 * uv[0];
                G[1] = bg + wg2 * ug[1] + wg1 * ug[0];                 V[1] = bv + wv2 * uv[1] + wv1 * uv[0];
                G[2] = bg + wg2 * ug[2] + wg1 * ug[1] + wg0 * ug[0];   V[2] = bv + wv2 * uv[2] + wv1 * uv[1] + wv0 * uv[0];
                G[3] = bg + wg2 * ug[3] + wg1 * ug[2] + wg0 * ug[1];   V[3] = bv + wv2 * uv[3] + wv1 * uv[2] + wv0 * uv[1];
                conv_wrap(G[0], G[1], ug[2], ug[3], wg1, wg0); conv_wrap(V[0], V[1], uv[2], uv[3], wv1, wv0);
#pragma unroll
                for (int m = 0; m < 4; ++m) { float o[4];
#pragma unroll
                    for (int e = 0; e < 4; ++e) o[e] = silu_fast(G[m][e]) * V[m][e];
                    u32x2 w; w.x = cvt_pk_bf16(o[0], o[1]); w.y = cvt_pk_bf16(o[2], o[3]);
                    if (n == 0) keep[ai][m] = w; else st16_wt(AB + (size_t)(row0 + ai * HALF + m) * DFF + ch0, (u32x4){keep[ai][m].x, keep[ai][m].y, w.x, w.y}); }
            }
        }
    }
};
struct EpiSoftmax {
    static constexpr bool PERM = true, AFTER_DRAIN = true, PREFILL = true, ROWPERM = false;
    __device__ __forceinline__ void prefill(int tid) const { rstd_table_fill(ss, tid); }
    bf16_t* P; const float* ss;
    __device__ __forceinline__ void fused(f32x4 (&acc)[2][2][4][2], const Unit& u, int wr, int wc, int fr, int fq, LAS unsigned char* lds, int wid, int lane) const {
        LAS float* MX = (LAS float*)lds; LAS float* SM = MX + 1024;
        const int rl0 = wr * 64 + fr, row0 = u.pm * BM + rl0;
        float rs8[2][4]; rstd8_tab(ss, u, wr, fr, fq, rs8);
#pragma unroll
        for (int ai = 0; ai < 2; ++ai)
#pragma unroll
            for (int m = 0; m < 4; ++m) { const float rs = rs8[ai][m]; float mx = -INFINITY;
#pragma unroll
                for (int bj = 0; bj < 2; ++bj)
#pragma unroll
                    for (int n = 0; n < 2; ++n) { f32x4 v = acc[ai][bj][m][n] * rs; acc[ai][bj][m][n] = v; mx = fmaxf(fmaxf(mx, fmaxf(v[0], v[1])), fmaxf(v[2], v[3])); }
                mx = fmaxf(mx, shx(mx, 16, lane)); mx = fmaxf(mx, shx(mx, 32, lane));
                if (fq == 0) MX[(rl0 + ai * HALF + m * 16) * 4 + wc] = mx; }
        asm volatile("s_waitcnt lgkmcnt(0)" ::: "memory"); __builtin_amdgcn_s_barrier(); asm volatile("" ::: "memory");
#pragma unroll
        for (int ai = 0; ai < 2; ++ai)
#pragma unroll
            for (int m = 0; m < 4; ++m) { const f32x4 q = *(const LAS f32x4*)(MX + (rl0 + ai * HALF + m * 16) * 4); const float mx = fmaxf(fmaxf(q[0], q[1]), fmaxf(q[2], q[3])), mxL = mx * 1.44269504088896341f; float sm = 0.f;
#pragma unroll
                for (int bj = 0; bj < 2; ++bj)
#pragma unroll
                    for (int n = 0; n < 2; ++n) { f32x4 v = acc[ai][bj][m][n];
#pragma unroll
                        for (int e = 0; e < 4; ++e) { v[e] = exp_sub(v[e], mxL); sm += v[e]; }
                        acc[ai][bj][m][n] = v; }
                sm += shx(sm, 16, lane); sm += shx(sm, 32, lane);
                if (fq == 0) SM[(rl0 + ai * HALF + m * 16) * 4 + wc] = sm; }
        asm volatile("s_waitcnt lgkmcnt(0)" ::: "memory"); __builtin_amdgcn_s_barrier(); asm volatile("" ::: "memory");
        const int cl = u.pn * BM + wc * 32 + 8 * fq;
#pragma unroll
        for (int ai = 0; ai < 2; ++ai)
#pragma unroll
            for (int m = 0; m < 4; ++m) { const f32x4 q = *(const LAS f32x4*)(SM + (rl0 + ai * HALF + m * 16) * 4); const float inv = 1.f / ((q[0] + q[1]) + (q[2] + q[3]));
                bf16_t* rowp = P + (size_t)(row0 + ai * HALF + m * 16) * NSC + cl;
#pragma unroll
                for (int bj = 0; bj < 2; ++bj) { const f32x4 v0 = acc[ai][bj][m][0] * inv, v1 = acc[ai][bj][m][1] * inv;
                    u32x4 w; w.x = cvt_pk_bf16(v0[0], v0[1]); w.y = cvt_pk_bf16(v0[2], v0[3]); w.z = cvt_pk_bf16(v1[0], v1[1]); w.w = cvt_pk_bf16(v1[2], v1[3]);
                    st16_wt(rowp + bj * HALF, w); } }
    }
};
}

#define XB_TMO      128
#define XB_XCNT(j)  (256  + 64 * (j))
#define XB_XSUB(j)  (1280 + 64 * (j))
#define XB_XGEN(j)  (2304 + 64 * (j))
#define XB_TOP      3328
#define XB_TOPGEN   3392
#define XCD_BAR_WORDS 3456
#define XB_SPIN_CAP (1u << 18)
__device__ __forceinline__ unsigned xb_ld(unsigned* p)              { return __hip_atomic_load(p, __ATOMIC_RELAXED, __HIP_MEMORY_SCOPE_AGENT); }
__device__ __forceinline__ unsigned xb_add(unsigned* p, unsigned v) { return __hip_atomic_fetch_add(p, v, __ATOMIC_RELAXED, __HIP_MEMORY_SCOPE_AGENT); }
__device__ __forceinline__ unsigned xb_xcc_id() { return (unsigned)__builtin_amdgcn_s_getreg((3 << 11) | 20) & 0xFu; }
#define XB_SPIN(cond, bar) do { unsigned _sp = 0; while (cond) { __builtin_amdgcn_s_sleep(1); \
    if ((++_sp & 255u) == 0u) { if (xb_ld(&(bar)[XB_TMO])) break; if (_sp > XB_SPIN_CAP) { atomicAdd(&(bar)[XB_TMO], 1u); break; } } } } while (0)
struct XcdBarrier { unsigned* bar; unsigned x; volatile LAS unsigned* st; };
__device__ __forceinline__ XcdBarrier xcd_barrier_post(unsigned* bar, volatile LAS unsigned* st) {
    XcdBarrier b; b.bar = bar; b.x = xb_xcc_id(); b.st = st;
    if (threadIdx.x == 0) (void)xb_add(&bar[XB_XCNT(b.x)], 1u);
    return b;
}
__device__ __forceinline__ void xcd_barrier_complete(unsigned* bar, unsigned x, unsigned& nloc, unsigned& nx) {
    const unsigned G = gridDim.x * gridDim.y * gridDim.z;
    unsigned sum, cnt, mine, sp = 0u;
    for (;;) {
        sum = 0u; cnt = 0u; mine = 0u;
#pragma unroll
        for (unsigned j = 0; j < 16; ++j) { const unsigned c = xb_ld(&bar[XB_XCNT(j)]); sum += c; cnt += (c > 0u) ? 1u : 0u; mine = (j == x) ? c : mine; }
        if (sum == G) break;
        __builtin_amdgcn_s_sleep(1);
        if ((++sp & 255u) == 0u) { if (xb_ld(&bar[XB_TMO])) break; if (sp > XB_SPIN_CAP) { atomicAdd(&bar[XB_TMO], 1u); break; } }
    }
    nloc = mine > 0u ? mine : 1u; nx = cnt > 0u ? cnt : 1u;
}
__device__ __forceinline__ void xcd_barrier(const XcdBarrier& b) {
    asm volatile("s_waitcnt vmcnt(0)" ::: "memory");
    __syncthreads();
    if (threadIdx.x == 0) {
        unsigned* bar = b.bar;
        __builtin_amdgcn_s_waitcnt(0);
        unsigned nloc = b.st[0], nx = b.st[1];
        if (nloc == 0u) { xcd_barrier_complete(bar, b.x, nloc, nx); b.st[0] = nloc; b.st[1] = nx; }
        const unsigned old = xb_add(&bar[XB_XSUB(b.x)], 1u);
        const unsigned gen = old / nloc;
        if (old + 1u == (gen + 1u) * nloc) {
            __builtin_amdgcn_fence(__ATOMIC_RELEASE, "agent");
            asm volatile("s_waitcnt vmcnt(0)" ::: "memory");
            const unsigned og = xb_add(&bar[XB_TOP], 1u);
            const unsigned tg = og / nx;
            if (og + 1u == (tg + 1u) * nx) xb_add(&bar[XB_TOPGEN], 1u);
            else XB_SPIN(xb_ld(&bar[XB_TOPGEN]) == tg, bar);
            __builtin_amdgcn_fence(__ATOMIC_ACQUIRE, "agent");
            xb_add(&bar[XB_XGEN(b.x)], 1u);
            asm volatile("s_waitcnt vmcnt(0)" ::: "memory");
        } else {
            XB_SPIN(xb_ld(&bar[XB_XGEN(b.x)]) == gen, bar);
            __builtin_amdgcn_fence(__ATOMIC_ACQUIRE, "agent");
            asm volatile("s_waitcnt vmcnt(0)" ::: "memory");
        }
    }
    __syncthreads();
}

struct Args { const void* in[23]; float* out; unsigned char* ws; int ph_lo, ph_hi; };
struct Frame {
    LAS unsigned char* lds; unsigned char* ws;
    int tid, lane, wave, G, bid;
};
__device__ __forceinline__ const void* in_ptr(int k) {
    const __attribute__((address_space(4))) char* kp = (const __attribute__((address_space(4))) char*)__builtin_amdgcn_kernarg_segment_ptr();
    asm volatile("" : "+s"(kp));
    return *(const void* const __attribute__((address_space(4)))*)(kp + 8 * k);
}
__device__ __forceinline__ unsigned char* ws_ptr() {
    const __attribute__((address_space(4))) char* kp = (const __attribute__((address_space(4))) char*)__builtin_amdgcn_kernarg_segment_ptr();
    asm volatile("" : "+s"(kp));
    return *(unsigned char* const __attribute__((address_space(4)))*)(kp + 8 * 24);
}
template <class Tp> __device__ __forceinline__ Tp* wsp(const Frame& F, size_t off) { return (Tp*)(F.ws + off); }
__device__ __forceinline__ float* ss_ptr(const Frame& F, int idx) { return (float*)(F.ws + WS_SSP) + (size_t)idx * T * 32; }

struct BlkDesc { const float* src; bf16_t* dst; const float* g; int ldw, K; };
constexpr int NA_IN = 32 * 68, NA_22 = 32 * 32, NA_UP = 32 * 176, NA_DN = 88 * 32, NA = NA_IN + NA_22 + NA_UP + NA_DN, NB = 3 * NA_22;
constexpr int NA_HEAD = NA_IN + NA_22, CV_T = NA_HEAD + 5100;
__device__ __forceinline__ BlkDesc desc_a(const Frame& F, int l, int r) {
    BlkDesc d;
    if (r < NA_IN) {
        const int kb = r / 68, nb = r % 68, sc0 = nb < 24 ? 64 * nb : 1552 + 64 * (nb - 24), dr0 = nb < 24 ? 64 * nb : 1792 + 64 * (nb - 24);
        d.src = (const float*)in_ptr(4) + (size_t)l * D * NIN + (size_t)(64 * kb) * NIN + sc0; d.dst = wsp<bf16_t>(F, WS_WIN + l * SZ_WIN) + (size_t)dr0 * D + 64 * kb; d.g = (const float*)in_ptr(3) + l * D + 64 * kb; d.ldw = NIN; d.K = D; return d; }
    r -= NA_IN;
    if (r < NA_22) { const int kb = r / 32, nb = r % 32;
        d.src = (const float*)in_ptr(10) + (size_t)l * D * D + (size_t)(64 * kb) * D + 64 * nb; d.dst = wsp<bf16_t>(F, WS_WOUT + l * SZ_W22) + (size_t)(64 * nb) * D + 64 * kb; d.g = nullptr; d.ldw = D; d.K = D; return d; }
    r -= NA_22;
    if (r < NA_UP) { const int kb = r / 176, nb = r % 176, c = 64 * nb, bj = c >= DFF ? 1 : 0, ch = c - DFF * bj, dr0 = 256 * (ch >> 7) + 128 * bj + (ch & 127);
        d.src = (const float*)in_ptr(18) + (size_t)l * D * NUP + (size_t)(64 * kb) * NUP + c; d.dst = wsp<bf16_t>(F, WS_WUP + l * SZ_WUP) + (size_t)dr0 * D + 64 * kb; d.g = (const float*)in_ptr(17) + l * D + 64 * kb; d.ldw = NUP; d.K = D; return d; }
    r -= NA_UP;
    { const int kb = r / 32, nb = r % 32;
        d.src = (const float*)in_ptr(21) + (size_t)l * DFF * D + (size_t)(64 * kb) * D + 64 * nb; d.dst = wsp<bf16_t>(F, WS_WDN + l * SZ_WDN) + (size_t)(64 * nb) * DFF + 64 * kb; d.g = nullptr; d.ldw = D; d.K = DFF; return d; }
}
__device__ __forceinline__ BlkDesc desc_b(const Frame& F, int l, int r) {
    BlkDesc d; const int w = r / NA_22, q = r % NA_22, kb = q / 32, nb = q % 32;
    d.src = (const float*)(w == 0 ? in_ptr(14) : w == 1 ? in_ptr(15) : in_ptr(16)) + (size_t)l * D * D + (size_t)(64 * kb) * D + 64 * nb;
    d.dst = wsp<bf16_t>(F, (w == 0 ? WS_WK : w == 1 ? WS_WV : WS_WO) + l * SZ_W22) + (size_t)(64 * nb) * D + 64 * kb; d.g = nullptr; d.ldw = D; d.K = D; return d;
}
__device__ __forceinline__ void blk_load(const BlkDesc& d, f32x4 (&v)[16], int lane) {
    const float* p = d.src + (size_t)(lane >> 4) * d.ldw + 4 * (lane & 15);
#pragma unroll
    for (int i = 0; i < 16; ++i) v[i] = __builtin_nontemporal_load((const f32x4*)(p + (size_t)(4 * i) * d.ldw));
}
__device__ __forceinline__ void blk_to_lds(const BlkDesc& d, const f32x4 (&v)[16], LAS float* scr, int lane) {
    const int kr = lane >> 4, cg = lane & 15;
#pragma unroll
    for (int i = 0; i < 16; ++i) { const int k = 4 * i + kr; f32x4 x = v[i]; if (d.g) x = x * d.g[k]; *(LAS f32x4*)(scr + k * 64 + ((cg ^ (k >> 3)) << 2)) = x; }
    LDS_WAIT(); asm volatile("" ::: "memory");
}
template <bool NTS> __device__ __forceinline__ void blk_store(const BlkDesc& d, LAS float* scr, int lane) {
    const int n0 = lane >> 3, c = lane & 7;
#pragma unroll
    for (int j = 0; j < 8; ++j) { const int n = n0 + 8 * j; const LAS float* sp = scr + (8 * c) * 64 + ((((n >> 2) ^ c) << 2) | (n & 3));
        u32x4 o; o.x = pk2(sp[0 * 64], sp[1 * 64]); o.y = pk2(sp[2 * 64], sp[3 * 64]); o.z = pk2(sp[4 * 64], sp[5 * 64]); o.w = pk2(sp[6 * 64], sp[7 * 64]);
        if constexpr (NTS) __builtin_nontemporal_store(o, (u32x4*)(d.dst + (size_t)n * d.K + 8 * c)); else *(u32x4*)(d.dst + (size_t)n * d.K + 8 * c) = o; }
    LDS_WAIT(); asm volatile("" ::: "memory");
}
template <bool TYPE_B, bool NTS = false, int SLP = 0> __device__ __forceinline__ void convert_blocks(const Frame& F, int l, int lo, int hi, int wv, int nw) {
    LAS float* scr = (LAS float*)(F.lds + F.wave * 16384); const int lane = F.lane;
    int it = lo + wv; if (it >= hi) return;
    f32x4 v[16]; BlkDesc d = TYPE_B ? desc_b(F, l, it) : desc_a(F, l, it); blk_load(d, v, lane);
    for (;;) {
        blk_to_lds(d, v, scr, lane);
        const int itn = it + nw; const bool hn = itn < hi; BlkDesc dn = d;
        if (hn) { dn = TYPE_B ? desc_b(F, l, itn) : desc_a(F, l, itn); blk_load(dn, v, lane); }
        blk_store<NTS>(d, scr, lane);
        if (!hn) break;
        if constexpr (SLP > 0) __builtin_amdgcn_s_sleep(SLP);
        it = itn; d = dn;
    }
}
__device__ __forceinline__ void fold_gate_item(const Frame& F, int l, int item) {
    LAS float* scr = (LAS float*)(F.lds + F.wave * 16384);
    const int kb = item >> 2, cq = item & 3, lane = F.lane, k = 64 * kb + lane; const float* wrow = (const float*)in_ptr(4) + ((size_t)l * D + k) * NIN + 1536;
    {   const float* wg = (const float*)in_ptr(5) + (size_t)l * 16 * 256 + (lane >> 2) * 256 + 64 * cq + 16 * (lane & 3); LAS float* dp = scr + (lane >> 2) * 64 + 16 * (lane & 3);
#pragma unroll
        for (int q = 0; q < 4; ++q) *(LAS f32x4*)(dp + 4 * q) = *(const f32x4*)(wg + 4 * q); }
    const f32x4 l0 = *(const f32x4*)wrow, l1 = *(const f32x4*)(wrow + 4), l2 = *(const f32x4*)(wrow + 8), l3 = *(const f32x4*)(wrow + 12);
    const float lr[16] = {l0[0], l0[1], l0[2], l0[3], l1[0], l1[1], l1[2], l1[3], l2[0], l2[1], l2[2], l2[3], l3[0], l3[1], l3[2], l3[3]};
    const float gk = ((const float*)in_ptr(3))[l * D + k]; bf16_t* WT = wsp<bf16_t>(F, WS_WIN + l * SZ_WIN) + (size_t)(1536 + 64 * cq) * D + k;
    LDS_WAIT(); asm volatile("" ::: "memory");
#pragma unroll 1
    for (int cc = 0; cc < 4; ++cc) { float a[16];
#pragma unroll
        for (int j = 0; j < 16; ++j) a[j] = 0.f;
#pragma unroll
        for (int r = 0; r < 16; ++r) { const LAS f32x4* wp = (const LAS f32x4*)(scr + r * 64 + 16 * cc); const f32x4 w0 = wp[0], w1 = wp[1], w2 = wp[2], w3 = wp[3];
            a[0] += lr[r] * w0[0]; a[1] += lr[r] * w0[1]; a[2] += lr[r] * w0[2]; a[3] += lr[r] * w0[3]; a[4] += lr[r] * w1[0]; a[5] += lr[r] * w1[1]; a[6] += lr[r] * w1[2]; a[7] += lr[r] * w1[3];
            a[8] += lr[r] * w2[0]; a[9] += lr[r] * w2[1]; a[10] += lr[r] * w2[2]; a[11] += lr[r] * w2[3]; a[12] += lr[r] * w3[0]; a[13] += lr[r] * w3[1]; a[14] += lr[r] * w3[2]; a[15] += lr[r] * w3[3];
            asm volatile("" ::: "memory"); }
#pragma unroll
        for (int j = 0; j < 16; ++j) WT[(size_t)(16 * cc + j) * D] = (bf16_t)f2bf(a[j] * gk); }
    LDS_WAIT(); asm volatile("" ::: "memory");
}
__device__ __forceinline__ void convert_slot(const Frame& F, int l, int lo, int hi, bool fold, int rank, int nr) {
    if (rank < 0 || rank >= nr) return;
    convert_blocks<false, false, 127>(F, l, lo, hi, rank * 8 + F.wave, nr * 8);
    if (fold) for (int it = rank * 8 + F.wave; it < 128; it += nr * 8) fold_gate_item(F, l, it);
}
__device__ __forceinline__ void sincos_acc(float ang, float& c, float& s) {
    const double a = (double)ang; const double k = rint(a * 0.63661977236758134308);
    double r = fma(-k, 1.57079632679489655800, a); r = fma(-k, 6.12323399573676603587e-17, r);
    const float x = (float)r, x2 = x * x;
    const float sp = x + x * x2 * (-1.6666654611e-1f + x2 * (8.3321608736e-3f + x2 * (-1.9515295891e-4f)));
    const float cp = 1.f - 0.5f * x2 + x2 * x2 * (4.166664568298827e-2f + x2 * (-1.388731625493765e-3f + x2 * 2.443315711809948e-5f));
    const int q = ((int)k) & 3;
    c = (q == 0) ? cp : (q == 1) ? -sp : (q == 2) ? -cp : sp;
    s = (q == 0) ? sp : (q == 1) ? cp : (q == 2) ? -sp : -cp;
}
__device__ __forceinline__ void p_prologue(Frame& F, const Args& A) {
    const int gw = F.bid * 8 + F.wave, NGW = F.G * 8, lane = F.lane;
    const float* x = (const float*)in_ptr(0); const float* mem = (const float*)in_ptr(1); const int* pos = (const int*)in_ptr(2);
    convert_blocks<false, false>(F, 0, 0, NA_HEAD, gw, NGW);
    for (int l = 0; l < NL; ++l) convert_blocks<true, true>(F, l, 0, NB, gw, NGW);
    for (int it = gw; it < NL * D; it += NGW) { const int l = it / D, k = it % D; const float g = ((const float*)in_ptr(11))[l * D + k];
        const f32x4* src = (const f32x4*)((const float*)in_ptr(13) + ((size_t)l * D + k) * D) + lane; u32x2* dst = (u32x2*)(wsp<bf16_t>(F, WS_WQP + l * SZ_W22) + (size_t)k * D) + lane;
#pragma unroll
        for (int j = 0; j < 8; ++j) { const f32x4 v = __builtin_nontemporal_load(src + 64 * j) * g; u32x2 o; o.x = pk2(v[0], v[1]); o.y = pk2(v[2], v[3]); __builtin_nontemporal_store(o, dst + 64 * j); } }
    for (int it = gw; it < 128; it += NGW) fold_gate_item(F, 0, it);
    { float* ss0 = ss_ptr(F, 0); bf16_t* hb = wsp<bf16_t>(F, WS_HB);
      for (int m = gw; m < T; m += NGW) { const f32x4* xr = (const f32x4*)(x + (size_t)m * D) + lane; u32x2* o = (u32x2*)(hb + (size_t)m * D) + lane; float s = 0.f;
#pragma unroll
          for (int j = 0; j < 8; ++j) { const f32x4 v = __builtin_nontemporal_load(xr + 64 * j); s += (v[0] * v[0] + v[1] * v[1]) + (v[2] * v[2] + v[3] * v[3]); u32x2 w; w.x = pk2(v[0], v[1]); w.y = pk2(v[2], v[3]); o[64 * j] = w; }
          s = wave_sum(s, lane); if (lane < 32) ss0[(size_t)m * 32 + lane] = (lane == 0) ? s : 0.f; } }
    for (int it = gw; it < NL * NMEM; it += NGW) { const int l = it / NMEM, m = it % NMEM; const f32x4* xr = (const f32x4*)(mem + (size_t)m * D) + lane; const f32x4* gr = (const f32x4*)((const float*)in_ptr(12) + l * D) + lane;
        f32x4 v[8]; float s = 0.f;
#pragma unroll
        for (int j = 0; j < 8; ++j) { v[j] = xr[64 * j]; s += (v[j][0] * v[j][0] + v[j][1] * v[j][1]) + (v[j][2] * v[j][2] + v[j][3] * v[j][3]); }
        const float rs = rsqrtf(wave_sum(s, lane) * (1.f / D) + EPS); u32x2* o = (u32x2*)(wsp<bf16_t>(F, WS_MEMN + l * SZ_MEM) + (size_t)m * D) + lane;
#pragma unroll
        for (int j = 0; j < 8; ++j) { const f32x4 g = gr[64 * j]; u32x2 w; w.x = pk2(v[j][0] * rs * g[0], v[j][1] * rs * g[1]); w.y = pk2(v[j][2] * rs * g[2], v[j][3] * rs * g[3]); o[64 * j] = w; } }
    { float* ct = wsp<float>(F, WS_ROPE); float* st = ct + T * 32;
      for (int i = F.bid * 512 + F.tid; i < T * 32; i += F.G * 512) { const int t = i >> 5, j = i & 31; const float inv = 1.0f / powf(10000.0f, (float)(2 * j) / 64.0f); const float ang = (float)pos[t] * inv;
          float c, s; sincos_acc(ang, c, s); ct[i] = c; st[i] = s; } }
}

struct KVOrder {
    unsigned char* ws; int G, c;
    __device__ __forceinline__ bool next(int i, pg8::Unit& u) const {
        const int L = i * G + c; if (L >= 64) return false;
        const int b = L >> 3, pn = L & 7, l = b >> 1, kv = b & 1;
        u.pm = 0; u.pn = pn; u.a = (const char*)(ws + WS_MEMN + l * SZ_MEM); u.b = (const char*)(ws + (kv ? WS_WV : WS_WK) + l * SZ_W22 + (size_t)pn * 256 * D * 2);
        u.o = (char*)(ws + (kv ? WS_VMEM : WS_KMEM) + l * SZ_MEM); u.ldc = D; u.sc = 1.f; return true; }
    __device__ __forceinline__ void a_ready(const pg8::Unit&) const {}
    __device__ __forceinline__ void done(const pg8::Unit&) const {}
};
struct FoldOrder {
    unsigned char* ws; int G, c;
    __device__ __forceinline__ bool next(int i, pg8::Unit& u) const {
        int L = i * G + c; if (L >= 256) return false;
        if (L < 128) { const int b = L >> 3, pn = L & 7, l = b >> 2, hd = b & 3;
            u.pm = 0; u.pn = pn; u.a = (const char*)(ws + WS_KMEM + l * SZ_MEM + 512 * hd * 2); u.b = (const char*)(ws + WS_WQP + l * SZ_W22 + 512 * hd * 2 + (size_t)pn * 256 * D * 2);
            u.o = (char*)(ws + WS_WST + l * SZ_WS + (size_t)256 * hd * D * 2); u.ldc = D; u.sc = 0.044194173824159216f; }
        else { L -= 128; const int b = L >> 3, pm = L & 7, l = b >> 2, hd = b & 3;
            u.pm = pm; u.pn = 0; u.a = (const char*)(ws + WS_WO + l * SZ_W22 + 512 * hd * 2 + (size_t)pm * 256 * D * 2); u.b = (const char*)(ws + WS_VMEM + l * SZ_MEM + 512 * hd * 2);
            u.o = (char*)(ws + WS_VWT + l * SZ_WS + 256 * hd * 2); u.ldc = NSC; u.sc = 1.f; }
        return true; }
    __device__ __forceinline__ void a_ready(const pg8::Unit&) const {}
    __device__ __forceinline__ void done(const pg8::Unit&) const {}
};

__device__ __forceinline__ void gla_cumsum(const Frame& F, const float* la, int t0, int h, LAS float* tot, float (&c)[8]) {
    const int w = F.wave, d = F.lane; float run = 0.f;
#pragma unroll
    for (int i = 0; i < 8; ++i) { run += la[(size_t)(t0 + 8 * w + i) * 256 + h * 64 + d]; c[i] = run; }
    tot[w * 64 + d] = run;
    __syncthreads();
    float off = 0.f;
#pragma unroll
    for (int j = 0; j < 8; ++j) off += (j < w) ? tot[j * 64 + d] : 0.f;
#pragma unroll
    for (int i = 0; i < 8; ++i) c[i] += off;
}
__device__ __forceinline__ void gla_local(Frame& F, int unit) {
    const int h = unit >> 7, ck = unit & 127, t0 = ck * 64, w = F.wave, lane = F.lane, tid = F.tid;
    const bf16_t* z = wsp<bf16_t>(F, WS_Z); const float* la = wsp<float>(F, WS_LA);
    LAS float* tot = (LAS float*)F.lds; LAS float* khat = tot + 512; LAS float* vt = khat + 64 * 64;
    float c[8]; gla_cumsum(F, la, t0, h, tot, c);
    float total = 0.f;
#pragma unroll
    for (int j = 0; j < 8; ++j) total += tot[j * 64 + lane];
#pragma unroll
    for (int i = 0; i < 8; ++i) { const int t = 8 * w + i; const float k = bf2f(z[(size_t)(t0 + t) * NZ + ZK + h * 64 + lane]); khat[t * 64 + lane] = k * __expf(total - c[i]); }
#pragma unroll
    for (int j = 0; j < 2; ++j) { const int idx = tid + 512 * j, t = idx >> 4, ch = idx & 15; const u32x4 r = *(const u32x4*)(z + (size_t)(t0 + t) * NZ + ZV + h * 128 + ch * 8);
        LAS float* p = vt + t * 128 + ch * 8;
        p[0] = bf2f(r.x & 0xffffu); p[1] = bf2f(r.x >> 16); p[2] = bf2f(r.y & 0xffffu); p[3] = bf2f(r.y >> 16); p[4] = bf2f(r.z & 0xffffu); p[5] = bf2f(r.z >> 16); p[6] = bf2f(r.w & 0xffffu); p[7] = bf2f(r.w >> 16); }
    if (w == 0) wsp<float>(F, WS_DEC)[(size_t)unit * 64 + lane] = __expf(total);
    __syncthreads();
    const int e = tid & 127, dg = tid >> 7;
    float acc[16];
#pragma unroll
    for (int j = 0; j < 16; ++j) acc[j] = 0.f;
    for (int t = 0; t < 64; ++t) { const float v = vt[t * 128 + e];
#pragma unroll
        for (int j = 0; j < 16; ++j) acc[j] += v * khat[t * 64 + 16 * dg + j]; }
    float* U = wsp<float>(F, WS_UB) + (size_t)unit * 8192;
#pragma unroll
    for (int j = 0; j < 16; ++j) U[(16 * dg + j) * 128 + e] = acc[j];
    __syncthreads();
}
__device__ __forceinline__ void gla_scan4(Frame& F) {
    LAS f32x2* AB = (LAS f32x2*)F.lds;
    const int per = (4 * 8192 + F.G - 1) / F.G, seg = F.wave >> 1, el = ((F.wave & 1) << 6) | F.lane;
    for (int e0 = 0; e0 < per; e0 += 128) {
        const int e = e0 + el, gid = F.bid * per + e; const bool act = (e < per) && (gid < 4 * 8192);
        const int gidc = act ? gid : 0, h = gidc >> 13, rem = gidc & 8191, d = rem >> 7;
        const float* __restrict__ U = wsp<float>(F, WS_UB) + (size_t)h * 128 * 8192 + rem + (size_t)(32 * seg) * 8192; const float* __restrict__ dec = wsp<float>(F, WS_DEC) + (size_t)h * 128 * 64 + d + (32 * seg) * 64;
        bf16_t* __restrict__ Sb = wsp<bf16_t>(F, WS_SB) + (size_t)h * 128 * 8192 + rem + (size_t)(32 * seg) * 8192;
        float u[32], dd[32];
#pragma unroll
        for (int i = 0; i < 32; ++i) { u[i] = U[(size_t)i * 8192]; dd[i] = dec[i * 64]; }
        float S = 0.f, P = 1.f;
#pragma unroll
        for (int i = 0; i < 32; ++i) { const float un = u[i], dn = dd[i]; u[i] = S; dd[i] = P; S = S * dn + un; P = P * dn; }
        AB[seg * 128 + el] = (f32x2){P, S};
        __syncthreads();
        float Sin = 0.f;
#pragma unroll
        for (int j = 0; j < 3; ++j) { if (j < seg) { const f32x2 ab = AB[j * 128 + el]; Sin = Sin * ab.x + ab.y; } }
        if ((e0 + el < per) && (F.bid * per + e0 + el < 4 * 8192)) {
#pragma unroll
            for (int i = 0; i < 32; ++i) Sb[(size_t)i * 8192] = (bf16_t)f2bf(u[i] + dd[i] * Sin); }
        __syncthreads();
    }
}
__device__ __forceinline__ void gla_scan(Frame& F) {
    const int per = (4 * 8192 + F.G - 1) / F.G;
    for (int e = F.tid; e < per; e += 128) { const int gid = F.bid * per + e; if (gid >= 4 * 8192) break;
        const int h = gid >> 13, rem = gid & 8191, d = rem >> 7;
        const float* __restrict__ U = wsp<float>(F, WS_UB) + (size_t)h * 128 * 8192 + rem; const float* __restrict__ dec = wsp<float>(F, WS_DEC) + (size_t)h * 128 * 64 + d; bf16_t* __restrict__ Sb = wsp<bf16_t>(F, WS_SB) + (size_t)h * 128 * 8192 + rem;
        float S = 0.f;
#pragma unroll 1
        for (int b = 0; b < 4; ++b) { float u[32], dd[32];
#pragma unroll
            for (int i = 0; i < 32; ++i) { u[i] = U[(size_t)(32 * b + i) * 8192]; dd[i] = dec[(32 * b + i) * 64]; }
#pragma unroll
            for (int i = 0; i < 32; ++i) { Sb[(size_t)(32 * b + i) * 8192] = (bf16_t)f2bf(S); S = S * dd[i] + u[i]; } }
    }
}
__device__ __forceinline__ void gla_out(Frame& F, const Args& A, int unit, int layer) {
    const int h = unit >> 7, ck = unit & 127, t0 = ck * 64, w = F.wave, lane = F.lane, tid = F.tid;
    const bf16_t* z = wsp<bf16_t>(F, WS_Z); const float* la = wsp<float>(F, WS_LA);
    LAS float* tot = (LAS float*)F.lds; LAS float* qtT = tot + 512; LAS float* qeT = qtT + 64 * 65; LAS float* attT = qeT + 64 * 65; LAS float* ktl = attT + 64 * 65;
    LAS float* red = ktl + 64 * 64; LAS bf16_t* vs = (LAS bf16_t*)(red + 512); LAS bf16_t* Ss = vs + 64 * 128;
    float c[8]; gla_cumsum(F, la, t0, h, tot, c);
    const float ref = tot[lane] + tot[64 + lane] + tot[128 + lane] + tot[192 + lane];
#pragma unroll
    for (int i = 0; i < 8; ++i) { const int t = 8 * w + i; const size_t zo = (size_t)(t0 + t) * NZ + h * 64 + lane;
        const float q = bf2f(z[zo + ZQ]) * 0.125f, k = bf2f(z[zo + ZK]);
        qtT[lane * 65 + t] = q * __expf(c[i] - ref); qeT[lane * 65 + t] = q * __expf(c[i]); ktl[t * 64 + lane] = k * __expf(ref - c[i]); }
#pragma unroll
    for (int j = 0; j < 2; ++j) { const int idx = tid + 512 * j, t = idx >> 4, ch = idx & 15;
        *(LAS u32x4*)(vs + t * 128 + ch * 8) = *(const u32x4*)(z + (size_t)(t0 + t) * NZ + ZV + h * 128 + ch * 8);
        *(LAS u32x4*)(Ss + t * 128 + ch * 8) = *(const u32x4*)(wsp<bf16_t>(F, WS_SB) + (size_t)unit * 8192 + t * 128 + ch * 8); }
    __syncthreads();
    {
        float a[8];
#pragma unroll
        for (int j = 0; j < 8; ++j) a[j] = 0.f;
        for (int d = 0; d < 64; ++d) { const float q = qtT[d * 65 + lane];
#pragma unroll
            for (int j = 0; j < 8; ++j) a[j] += q * ktl[(8 * w + j) * 64 + d]; }
#pragma unroll
        for (int j = 0; j < 8; ++j) attT[(8 * w + j) * 65 + lane] = (8 * w + j <= lane) ? a[j] : 0.f;
    }
    __syncthreads();
    float o[16];
#pragma unroll
    for (int j = 0; j < 16; ++j) o[j] = 0.f;
    for (int s = 0; s < 64; ++s) { const float a = attT[s * 65 + lane]; const u32x4 v0 = *(const LAS u32x4*)(vs + s * 128 + 16 * w), v1 = *(const LAS u32x4*)(vs + s * 128 + 16 * w + 8);
        o[0] += a * bf2f(v0.x & 0xffffu); o[1] += a * bf2f(v0.x >> 16); o[2] += a * bf2f(v0.y & 0xffffu); o[3] += a * bf2f(v0.y >> 16);
        o[4] += a * bf2f(v0.z & 0xffffu); o[5] += a * bf2f(v0.z >> 16); o[6] += a * bf2f(v0.w & 0xffffu); o[7] += a * bf2f(v0.w >> 16);
        o[8] += a * bf2f(v1.x & 0xffffu); o[9] += a * bf2f(v1.x >> 16); o[10] += a * bf2f(v1.y & 0xffffu); o[11] += a * bf2f(v1.y >> 16);
        o[12] += a * bf2f(v1.z & 0xffffu); o[13] += a * bf2f(v1.z >> 16); o[14] += a * bf2f(v1.w & 0xffffu); o[15] += a * bf2f(v1.w >> 16); }
    for (int d = 0; d < 64; ++d) { const float a = qeT[d * 65 + lane]; const u32x4 v0 = *(const LAS u32x4*)(Ss + d * 128 + 16 * w), v1 = *(const LAS u32x4*)(Ss + d * 128 + 16 * w + 8);
        o[0] += a * bf2f(v0.x & 0xffffu); o[1] += a * bf2f(v0.x >> 16); o[2] += a * bf2f(v0.y & 0xffffu); o[3] += a * bf2f(v0.y >> 16);
        o[4] += a * bf2f(v0.z & 0xffffu); o[5] += a * bf2f(v0.z >> 16); o[6] += a * bf2f(v0.w & 0xffffu); o[7] += a * bf2f(v0.w >> 16);
        o[8] += a * bf2f(v1.x & 0xffffu); o[9] += a * bf2f(v1.x >> 16); o[10] += a * bf2f(v1.y & 0xffffu); o[11] += a * bf2f(v1.y >> 16);
        o[12] += a * bf2f(v1.z & 0xffffu); o[13] += a * bf2f(v1.z >> 16); o[14] += a * bf2f(v1.w & 0xffffu); o[15] += a * bf2f(v1.w >> 16); }
    float p = 0.f;
#pragma unroll
    for (int j = 0; j < 16; ++j) p += o[j] * o[j];
    red[w * 64 + lane] = p;
    __syncthreads();
    float sq = 0.f;
#pragma unroll
    for (int j = 0; j < 8; ++j) sq += red[j * 64 + lane];
    const float rs = rsqrtf(sq * (1.f / 128.f) + EPS);
    const float* gn = (const float*)in_ptr(7) + layer * 128 + 16 * w; const size_t zr = (size_t)(t0 + lane) * NZ + ZR + h * 128 + 16 * w;
    const u32x4 r0 = *(const u32x4*)(z + zr), r1 = *(const u32x4*)(z + zr + 8);
    const unsigned rr[8] = {r0.x, r0.y, r0.z, r0.w, r1.x, r1.y, r1.z, r1.w};
    unsigned ow[8];
#pragma unroll
    for (int j = 0; j < 8; ++j) { const float g0 = bf2f(rr[j] & 0xffffu), g1 = bf2f(rr[j] >> 16);
        ow[j] = pk2(o[2 * j] * rs * gn[2 * j] * siluf(g0), o[2 * j + 1] * rs * gn[2 * j + 1] * siluf(g1)); }
    bf16_t* mx = wsp<bf16_t>(F, WS_MIX) + (size_t)(t0 + lane) * D + h * 128 + 16 * w;
    *(u32x4*)mx = (u32x4){ow[0], ow[1], ow[2], ow[3]}; *(u32x4*)(mx + 8) = (u32x4){ow[4], ow[5], ow[6], ow[7]};
    __syncthreads();
}

__device__ __forceinline__ void swa_unit(Frame& F, const Args& A, int unit, int layer) {
    const int g = unit & 7, n = (unit >> 3) & 63, j = unit >> 9, hq = 8 * j + g, tid = F.tid;
    const bf16_t* z = wsp<bf16_t>(F, WS_Z); const float* ct = wsp<float>(F, WS_ROPE); const float* st = ct + T * 32;
    LAS bf16_t* Ks = (LAS bf16_t*)F.lds; LAS bf16_t* Vs = Ks + 256 * 66; LAS float* red = (LAS float*)(Vs + 256 * 66);
    LAS float* ob = (LAS float*)F.lds;
    {
        const int row = tid >> 1, hf = tid & 1, tk = 128 * n - 128 + row;
        if (tk >= 0) {
            const bf16_t* kp = z + (size_t)tk * NZ + ZSK + j * 64; const bf16_t* vp = z + (size_t)tk * NZ + ZSV + j * 64;
            const u32x4 a0 = *(const u32x4*)(kp + 16 * hf), a1 = *(const u32x4*)(kp + 16 * hf + 8), b0 = *(const u32x4*)(kp + 32 + 16 * hf), b1 = *(const u32x4*)(kp + 32 + 16 * hf + 8);
            const unsigned x1[8] = {a0.x, a0.y, a0.z, a0.w, a1.x, a1.y, a1.z, a1.w}, x2[8] = {b0.x, b0.y, b0.z, b0.w, b1.x, b1.y, b1.z, b1.w};
#pragma unroll
            for (int q = 0; q < 8; ++q) { const int i0 = 16 * hf + 2 * q; const float c0 = ct[tk * 32 + i0], s0 = st[tk * 32 + i0], c1 = ct[tk * 32 + i0 + 1], s1 = st[tk * 32 + i0 + 1];
                const float u0 = bf2f(x1[q] & 0xffffu), u1 = bf2f(x1[q] >> 16), w0 = bf2f(x2[q] & 0xffffu), w1 = bf2f(x2[q] >> 16);
                *(LAS unsigned*)(Ks + row * 66 + i0) = pk2(u0 * c0 - w0 * s0, u1 * c1 - w1 * s1);
                *(LAS unsigned*)(Ks + row * 66 + 32 + i0) = pk2(w0 * c0 + u0 * s0, w1 * c1 + u1 * s1); }
            const u32x4 v0 = *(const u32x4*)(vp + 32 * hf), v1 = *(const u32x4*)(vp + 32 * hf + 8), v2 = *(const u32x4*)(vp + 32 * hf + 16), v3 = *(const u32x4*)(vp + 32 * hf + 24);
            const unsigned vv[16] = {v0.x, v0.y, v0.z, v0.w, v1.x, v1.y, v1.z, v1.w, v2.x, v2.y, v2.z, v2.w, v3.x, v3.y, v3.z, v3.w};
#pragma unroll
            for (int q = 0; q < 16; ++q) *(LAS unsigned*)(Vs + row * 66 + 32 * hf + 2 * q) = vv[q];
        } else {
#pragma unroll
            for (int q = 0; q < 16; ++q) { *(LAS unsigned*)(Ks + row * 66 + 32 * hf + 2 * q) = 0u; *(LAS unsigned*)(Vs + row * 66 + 32 * hf + 2 * q) = 0u; }
        }
    }
    const int r = tid & 127, part = tid >> 7, tq = 128 * n + r;
    float q[64];
    {   const bf16_t* qp = z + (size_t)tq * NZ + ZSQ + hq * 64;
#pragma unroll
        for (int c8 = 0; c8 < 4; ++c8) { const u32x4 a = *(const u32x4*)(qp + 8 * c8), b = *(const u32x4*)(qp + 32 + 8 * c8); const unsigned x1[4] = {a.x, a.y, a.z, a.w}, x2[4] = {b.x, b.y, b.z, b.w};
#pragma unroll
            for (int p = 0; p < 4; ++p) { const int i0 = 8 * c8 + 2 * p; const float c0 = ct[tq * 32 + i0], s0 = st[tq * 32 + i0], c1 = ct[tq * 32 + i0 + 1], s1 = st[tq * 32 + i0 + 1];
                const float u0 = bf2f(x1[p] & 0xffffu), u1 = bf2f(x1[p] >> 16), w0 = bf2f(x2[p] & 0xffffu), w1 = bf2f(x2[p] >> 16);
                q[i0] = (u0 * c0 - w0 * s0) * 0.125f; q[i0 + 1] = (u1 * c1 - w1 * s1) * 0.125f; q[32 + i0] = (w0 * c0 + u0 * s0) * 0.125f; q[32 + i0 + 1] = (w1 * c1 + u1 * s1) * 0.125f; } }
    }
    __syncthreads();
    float s[32]; float mx = -INFINITY;
#pragma unroll
    for (int kk = 0; kk < 32; ++kk) { const int ki = r + 1 + 32 * part + kk; const LAS unsigned* kr = (const LAS unsigned*)(Ks + ki * 66); float a = 0.f;
#pragma unroll
        for (int d2 = 0; d2 < 32; ++d2) { const unsigned kw = kr[d2]; a += q[2 * d2] * bf2f(kw & 0xffffu) + q[2 * d2 + 1] * bf2f(kw >> 16); }
        const bool valid = (n > 0) || (ki >= 128); s[kk] = valid ? a : -INFINITY; mx = fmaxf(mx, s[kk]); }
    red[part * 128 + r] = mx;
    __syncthreads();
    const float sink = ((const float*)in_ptr(8))[layer * 16 + hq];
    const float m = fmaxf(fmaxf(fmaxf(red[r], red[128 + r]), fmaxf(red[256 + r], red[384 + r])), sink);
    float sum = 0.f;
#pragma unroll
    for (int kk = 0; kk < 32; ++kk) { s[kk] = __expf(s[kk] - m); sum += s[kk]; }
    red[512 + part * 128 + r] = sum;
    __syncthreads();
    const float den = red[512 + r] + red[640 + r] + red[768 + r] + red[896 + r] + __expf(sink - m), inv = 1.f / den;
    float o[64];
#pragma unroll
    for (int e = 0; e < 64; ++e) o[e] = 0.f;
#pragma unroll 4
    for (int kk = 0; kk < 32; ++kk) { const int ki = r + 1 + 32 * part + kk; const LAS unsigned* vr = (const LAS unsigned*)(Vs + ki * 66); const float p = s[kk] * inv;
#pragma unroll
        for (int d2 = 0; d2 < 32; ++d2) { const unsigned vw = vr[d2]; o[2 * d2] += p * bf2f(vw & 0xffffu); o[2 * d2 + 1] += p * bf2f(vw >> 16); } }
    for (int pp = 0; pp < 4; ++pp) {
        if (part == pp) {
#pragma unroll
            for (int e = 0; e < 64; ++e) { if (pp == 0) ob[r * 65 + e] = o[e]; else ob[r * 65 + e] += o[e]; }
        }
        __syncthreads();
    }
    {   const int row = tid >> 2, e0 = 16 * (tid & 3); unsigned ow[8];
#pragma unroll
        for (int p = 0; p < 8; ++p) ow[p] = pk2(ob[row * 65 + e0 + 2 * p], ob[row * 65 + e0 + 2 * p + 1]);
        bf16_t* mxp = wsp<bf16_t>(F, WS_MIX) + (size_t)(128 * n + row) * D + 512 + hq * 64 + e0;
        *(u32x4*)mxp = (u32x4){ow[0], ow[1], ow[2], ow[3]}; *(u32x4*)(mxp + 8) = (u32x4){ow[4], ow[5], ow[6], ow[7]}; }
    __syncthreads();
}


typedef float f32x16 __attribute__((ext_vector_type(16)));
typedef short s16x4 __attribute__((ext_vector_type(4)));
typedef short v4i16_t __attribute__((ext_vector_type(4)));
#define MFMA32(a, b, c) __builtin_amdgcn_mfma_f32_32x32x16_bf16((a), (b), (c), 0, 0, 0)
__device__ __forceinline__ s16x4 tr_read(const LAS bf16_t* p) { return __builtin_bit_cast(s16x4, __builtin_amdgcn_ds_read_tr16_b64_v4i16((LAS v4i16_t*)p)); }
__device__ __forceinline__ void swa_unit_mfma(Frame& F, int unit, int layer) {
    constexpr int KST = 72, VST = 96;
    const int hf = unit & 1, n = (unit >> 1) & 63, j = unit >> 7, tid = F.tid, lane = F.lane, w = F.wave, r = lane & 31, hh = lane >> 5;
    const bf16_t* z = wsp<bf16_t>(F, WS_Z); const float* ct = wsp<float>(F, WS_ROPE); const float* st = ct + T * 32;
    LAS bf16_t* Ks = (LAS bf16_t*)F.lds; LAS bf16_t* Vs = Ks + 256 * KST;
    const int hq = 8 * j + 4 * hf + (w & 3);
    bf16x8 qf[2][4]; u32x4 qxa[2][2], qxb[2][2]; f32x4 qc[2][2][2], qs[2][2][2];
#pragma unroll
        for (int pi = 0; pi < 2; ++pi) { const int tq = 128 * n + 32 * (2 * (w >> 2) + pi) + r; const bf16_t* qp = z + (size_t)tq * NZ + ZSQ + hq * 64;
#pragma unroll
            for (int s2 = 0; s2 < 2; ++s2) { qxa[pi][s2] = *(const u32x4*)(qp + 16 * s2 + 8 * hh); qxb[pi][s2] = *(const u32x4*)(qp + 32 + 16 * s2 + 8 * hh);
                qc[pi][s2][0] = *(const f32x4*)(ct + tq * 32 + 16 * s2 + 8 * hh); qc[pi][s2][1] = *(const f32x4*)(ct + tq * 32 + 16 * s2 + 8 * hh + 4);
                qs[pi][s2][0] = *(const f32x4*)(st + tq * 32 + 16 * s2 + 8 * hh); qs[pi][s2][1] = *(const f32x4*)(st + tq * 32 + 16 * s2 + 8 * hh + 4); } }
    {
        const int row = tid >> 1, hp = tid & 1, tk = 128 * n - 128 + row;
        if (tk >= 0) {
            const bf16_t* kp = z + (size_t)tk * NZ + ZSK + j * 64; const bf16_t* vp = z + (size_t)tk * NZ + ZSV + j * 64;
            const u32x4 a0 = *(const u32x4*)(kp + 16 * hp), a1 = *(const u32x4*)(kp + 16 * hp + 8), b0 = *(const u32x4*)(kp + 32 + 16 * hp), b1 = *(const u32x4*)(kp + 32 + 16 * hp + 8);
            const unsigned x1[8] = {a0.x, a0.y, a0.z, a0.w, a1.x, a1.y, a1.z, a1.w}, x2[8] = {b0.x, b0.y, b0.z, b0.w, b1.x, b1.y, b1.z, b1.w};
            unsigned o1[8], o2[8];
            const f32x4* cp4 = (const f32x4*)(ct + tk * 32 + 16 * hp); const f32x4* sp4 = (const f32x4*)(st + tk * 32 + 16 * hp);
            const f32x4 cA = cp4[0], cB = cp4[1], cC = cp4[2], cD = cp4[3], sA = sp4[0], sB = sp4[1], sC = sp4[2], sD = sp4[3];
            const float cc[16] = {cA[0], cA[1], cA[2], cA[3], cB[0], cB[1], cB[2], cB[3], cC[0], cC[1], cC[2], cC[3], cD[0], cD[1], cD[2], cD[3]};
            const float sn[16] = {sA[0], sA[1], sA[2], sA[3], sB[0], sB[1], sB[2], sB[3], sC[0], sC[1], sC[2], sC[3], sD[0], sD[1], sD[2], sD[3]};
#pragma unroll
            for (int q = 0; q < 8; ++q) { const float c0 = cc[2 * q], s0 = sn[2 * q], c1 = cc[2 * q + 1], s1 = sn[2 * q + 1];
                const float u0 = bf2f(x1[q] & 0xffffu), u1 = bf2f(x1[q] >> 16), w0 = bf2f(x2[q] & 0xffffu), w1 = bf2f(x2[q] >> 16);
                o1[q] = pk2(u0 * c0 - w0 * s0, u1 * c1 - w1 * s1); o2[q] = pk2(w0 * c0 + u0 * s0, w1 * c1 + u1 * s1); }
            *(LAS u32x4*)(Ks + row * KST + 16 * hp) = (u32x4){o1[0], o1[1], o1[2], o1[3]}; *(LAS u32x4*)(Ks + row * KST + 16 * hp + 8) = (u32x4){o1[4], o1[5], o1[6], o1[7]};
            *(LAS u32x4*)(Ks + row * KST + 32 + 16 * hp) = (u32x4){o2[0], o2[1], o2[2], o2[3]}; *(LAS u32x4*)(Ks + row * KST + 32 + 16 * hp + 8) = (u32x4){o2[4], o2[5], o2[6], o2[7]};
#pragma unroll
            for (int q = 0; q < 4; ++q) *(LAS u32x4*)(Vs + row * VST + 32 * hp + 8 * q) = *(const u32x4*)(vp + 32 * hp + 8 * q);
        } else {
            const u32x4 zz = (u32x4){0u, 0u, 0u, 0u};
#pragma unroll
            for (int q = 0; q < 4; ++q) { *(LAS u32x4*)(Ks + row * KST + 32 * hp + 8 * q) = zz; *(LAS u32x4*)(Vs + row * VST + 32 * hp + 8 * q) = zz; }
        }
    }
#pragma unroll
    for (int pi = 0; pi < 2; ++pi)
#pragma unroll
        for (int s2 = 0; s2 < 2; ++s2) { const u32x4 xa = qxa[pi][s2], xb = qxb[pi][s2]; const f32x4 c0 = qc[pi][s2][0], c1 = qc[pi][s2][1], s0 = qs[pi][s2][0], s1 = qs[pi][s2][1];
            const unsigned x1[4] = {xa.x, xa.y, xa.z, xa.w}, x2[4] = {xb.x, xb.y, xb.z, xb.w}; const float cc[8] = {c0[0], c0[1], c0[2], c0[3], c1[0], c1[1], c1[2], c1[3]}, sn[8] = {s0[0], s0[1], s0[2], s0[3], s1[0], s1[1], s1[2], s1[3]};
            unsigned o1[4], o2[4];
#pragma unroll
            for (int q = 0; q < 4; ++q) { const float u0 = bf2f(x1[q] & 0xffffu), u1 = bf2f(x1[q] >> 16), w0 = bf2f(x2[q] & 0xffffu), w1 = bf2f(x2[q] >> 16);
                o1[q] = pk2((u0 * cc[2 * q] - w0 * sn[2 * q]) * 0.125f, (u1 * cc[2 * q + 1] - w1 * sn[2 * q + 1]) * 0.125f);
                o2[q] = pk2((w0 * cc[2 * q] + u0 * sn[2 * q]) * 0.125f, (w1 * cc[2 * q + 1] + u1 * sn[2 * q + 1]) * 0.125f); }
            qf[pi][s2] = __builtin_bit_cast(bf16x8, (u32x4){o1[0], o1[1], o1[2], o1[3]}); qf[pi][s2 + 2] = __builtin_bit_cast(bf16x8, (u32x4){o2[0], o2[1], o2[2], o2[3]}); }
    __syncthreads();
    const float sink = ((const float*)in_ptr(8))[layer * 16 + hq];
    const int i16 = lane & 15, q4 = i16 >> 2, p4 = i16 & 3, blk = (lane >> 4) & 1;
    const LAS bf16_t* vbase = Vs + (4 * hh + q4) * VST + 16 * blk + 4 * p4;
#pragma unroll
    for (int pi = 0; pi < 2; ++pi) {
        const int p = 2 * (w >> 2) + pi, tq = 128 * n + 32 * p + r;
        f32x16 X[5];
#pragma unroll
        for (int b = 0; b < 5; ++b) {
#pragma unroll
            for (int i = 0; i < 16; ++i) X[b][i] = 0.f;
#pragma unroll
            for (int s = 0; s < 4; ++s) { const bf16x8 kf = *(const LAS bf16x8*)(Ks + (32 * (p + b) + r) * KST + 16 * s + 8 * hh); X[b] = MFMA32(kf, qf[pi][s], X[b]); } }
        float mx = -INFINITY;
#pragma unroll
        for (int b = 0; b < 5; ++b)
#pragma unroll
            for (int i = 0; i < 16; ++i) { const int cr = (i & 3) + 8 * (i >> 2) + 4 * hh; bool valid = (b == 0) ? (cr > r) : (b == 4) ? (cr <= r) : true; if (n == 0) valid = valid && (p + b >= 4);
                const float v = valid ? X[b][i] : -INFINITY; X[b][i] = v; mx = fmaxf(mx, v); }
        mx = fmaxf(mx, shx(mx, 32, lane));
        const float m = fmaxf(mx, sink), mL = m * 1.44269504088896341f;
        float sum = 0.f;
#pragma unroll
        for (int b = 0; b < 5; ++b)
#pragma unroll
            for (int i = 0; i < 16; ++i) { const float e = pg8::exp_sub(X[b][i], mL); X[b][i] = e; sum += e; }
        sum += shx(sum, 32, lane);
        const float inv = 1.f / (sum + __expf(sink - m));
        f32x16 Z[2];
#pragma unroll
        for (int et = 0; et < 2; ++et)
#pragma unroll
            for (int i = 0; i < 16; ++i) Z[et][i] = 0.f;
#pragma unroll
        for (int b = 0; b < 5; ++b)
#pragma unroll
            for (int s2 = 0; s2 < 2; ++s2) {
                u32x4 pw;
                pw.x = pk2(X[b][8 * s2 + 0] * inv, X[b][8 * s2 + 1] * inv); pw.y = pk2(X[b][8 * s2 + 2] * inv, X[b][8 * s2 + 3] * inv);
                pw.z = pk2(X[b][8 * s2 + 4] * inv, X[b][8 * s2 + 5] * inv); pw.w = pk2(X[b][8 * s2 + 6] * inv, X[b][8 * s2 + 7] * inv);
                const bf16x8 pa = __builtin_bit_cast(bf16x8, pw);
                const LAS bf16_t* vp = vbase + (32 * (p + b) + 16 * s2) * VST;
#pragma unroll
                for (int et = 0; et < 2; ++et) { const s16x4 lo = tr_read(vp + 32 * et), hi = tr_read(vp + 8 * VST + 32 * et);
                    const bf16x8 vb = (bf16x8){lo[0], lo[1], lo[2], lo[3], hi[0], hi[1], hi[2], hi[3]};
                    Z[et] = MFMA32(pa, vb, Z[et]); } }
        LAS bf16_t* stg = Vs + 256 * VST + w * (32 * 72);
#pragma unroll
        for (int et = 0; et < 2; ++et)
#pragma unroll
            for (int i = 0; i < 16; ++i) { const int cr = (i & 3) + 8 * (i >> 2) + 4 * hh; stg[cr * 72 + 32 * et + r] = (bf16_t)f2bf(Z[et][i]); }
        LDS_WAIT(); asm volatile("" ::: "memory");
        bf16_t* mxp = wsp<bf16_t>(F, WS_MIX) + (size_t)(128 * n + 32 * p) * D + 512 + hq * 64;
#pragma unroll
        for (int jq = 0; jq < 4; ++jq) { const int id = lane + 64 * jq, row = id >> 3, c16 = id & 7; *(u32x4*)(mxp + (size_t)row * D + 8 * c16) = *(const LAS u32x4*)(stg + row * 72 + 8 * c16); }
        LDS_WAIT(); asm volatile("" ::: "memory");
    }
    __syncthreads();
}


__device__ __forceinline__ void gla_local_mfma(Frame& F, int unit) {
    constexpr int KS = 96, VS = 160;
    const int h = unit >> 7, ck = unit & 127, t0 = ck * 64, w = F.wave, lane = F.lane, tid = F.tid;
    const bf16_t* z = wsp<bf16_t>(F, WS_Z); const float* la = wsp<float>(F, WS_LA);
    LAS float* tot = (LAS float*)F.lds; LAS bf16_t* kh = (LAS bf16_t*)(tot + 512); LAS bf16_t* vs = kh + 64 * KS;
    bf16_t kraw[8]; u32x4 vraw[2];
#pragma unroll
    for (int i = 0; i < 8; ++i) kraw[i] = z[(size_t)(t0 + 8 * w + i) * NZ + ZK + h * 64 + lane];
#pragma unroll
    for (int j = 0; j < 2; ++j) { const int idx = tid + 512 * j, t = idx >> 4, ch = idx & 15; vraw[j] = *(const u32x4*)(z + (size_t)(t0 + t) * NZ + ZV + h * 128 + ch * 8); }
    float c[8]; gla_cumsum(F, la, t0, h, tot, c);
    float total = 0.f;
#pragma unroll
    for (int j = 0; j < 8; ++j) total += tot[j * 64 + lane];
#pragma unroll
    for (int i = 0; i < 8; ++i) { const int t = 8 * w + i; kh[t * KS + lane] = (bf16_t)f2bf(bf2f(kraw[i]) * __expf(total - c[i])); }
#pragma unroll
    for (int j = 0; j < 2; ++j) { const int idx = tid + 512 * j, t = idx >> 4, ch = idx & 15; *(LAS u32x4*)(vs + t * VS + ch * 8) = vraw[j]; }
    if (w == 0) wsp<float>(F, WS_DEC)[(size_t)unit * 64 + lane] = __expf(total);
    __syncthreads();
    const int r = lane & 31, hh = lane >> 5, i16 = lane & 15, q4 = i16 >> 2, p4 = i16 & 3, blk = (lane >> 4) & 1, dt = w & 1, et = w >> 1;
    const LAS bf16_t* ka = kh + (8 * hh + q4) * KS + 32 * dt + 16 * blk + 4 * p4;
    const LAS bf16_t* va = vs + (8 * hh + q4) * VS + 32 * et + 16 * blk + 4 * p4;
    f32x16 acc;
#pragma unroll
    for (int i = 0; i < 16; ++i) acc[i] = 0.f;
#pragma unroll
    for (int s4 = 0; s4 < 4; ++s4) {
        const s16x4 al = tr_read(ka + 16 * s4 * KS), ah = tr_read(ka + (16 * s4 + 4) * KS), bl = tr_read(va + 16 * s4 * VS), bh = tr_read(va + (16 * s4 + 4) * VS);
        acc = MFMA32(((bf16x8){al[0], al[1], al[2], al[3], ah[0], ah[1], ah[2], ah[3]}), ((bf16x8){bl[0], bl[1], bl[2], bl[3], bh[0], bh[1], bh[2], bh[3]}), acc); }
    float* U = wsp<float>(F, WS_UB) + (size_t)unit * 8192 + 32 * et + r;
#pragma unroll
    for (int i = 0; i < 16; ++i) U[(32 * dt + (i & 3) + 8 * (i >> 2) + 4 * hh) * 128] = acc[i];
    __syncthreads();
}
__device__ __forceinline__ void gla_out_mfma(Frame& F, int unit, int layer) {
    constexpr int QS = 72, VS = 160;
    const int h = unit >> 7, ck = unit & 127, t0 = ck * 64, w = F.wave, lane = F.lane, tid = F.tid;
    const bf16_t* z = wsp<bf16_t>(F, WS_Z); const float* la = wsp<float>(F, WS_LA);
    LAS float* tot = (LAS float*)F.lds; LAS float* red = tot + 512;
    LAS bf16_t* qt = (LAS bf16_t*)(red + 256); LAS bf16_t* kt = qt + 64 * QS; LAS bf16_t* qe = kt + 64 * QS; LAS bf16_t* vs = qe + 64 * QS; LAS bf16_t* Ss = vs + 64 * VS;
    bf16_t qraw[8], kraw[8]; u32x4 vraw[2], sraw[2];
#pragma unroll
    for (int i = 0; i < 8; ++i) { const size_t zo = (size_t)(t0 + 8 * w + i) * NZ + h * 64 + lane; qraw[i] = z[zo + ZQ]; kraw[i] = z[zo + ZK]; }
#pragma unroll
    for (int j = 0; j < 2; ++j) { const int idx = tid + 512 * j, t = idx >> 4, ch = idx & 15;
        vraw[j] = *(const u32x4*)(z + (size_t)(t0 + t) * NZ + ZV + h * 128 + ch * 8); sraw[j] = *(const u32x4*)(wsp<bf16_t>(F, WS_SB) + (size_t)unit * 8192 + t * 128 + ch * 8); }
    const int r_ = lane & 31, hh_ = lane >> 5, tt_ = w & 1, et_ = w >> 1, tl_ = 32 * tt_ + r_;
    u32x2 grv[4]; f32x4 gnv[4];
    {   const bf16_t* zr = z + (size_t)(t0 + tl_) * NZ + ZR + h * 128 + 32 * et_ + 4 * hh_; const float* gn = (const float*)in_ptr(7) + layer * 128 + 32 * et_ + 4 * hh_;
#pragma unroll
        for (int g4 = 0; g4 < 4; ++g4) { grv[g4] = *(const u32x2*)(zr + 8 * g4); gnv[g4] = *(const f32x4*)(gn + 8 * g4); } }
    float c[8]; gla_cumsum(F, la, t0, h, tot, c);
    const float ref = tot[lane] + tot[64 + lane] + tot[128 + lane] + tot[192 + lane];
#pragma unroll
    for (int i = 0; i < 8; ++i) { const int t = 8 * w + i; const float q = bf2f(qraw[i]) * 0.125f, k = bf2f(kraw[i]);
        qt[t * QS + lane] = (bf16_t)f2bf(q * __expf(c[i] - ref)); qe[t * QS + lane] = (bf16_t)f2bf(q * __expf(c[i])); kt[t * QS + lane] = (bf16_t)f2bf(k * __expf(ref - c[i])); }
#pragma unroll
    for (int j = 0; j < 2; ++j) { const int idx = tid + 512 * j, t = idx >> 4, ch = idx & 15; *(LAS u32x4*)(vs + t * VS + ch * 8) = vraw[j]; *(LAS u32x4*)(Ss + t * VS + ch * 8) = sraw[j]; }
    __syncthreads();
    const int r = lane & 31, hh = lane >> 5, i16 = lane & 15, q4 = i16 >> 2, p4 = i16 & 3, blk = (lane >> 4) & 1, tt = w & 1, et = w >> 1;
    f32x16 Y;
#pragma unroll
    for (int i = 0; i < 16; ++i) Y[i] = 0.f;
    {   const LAS bf16_t* sa = Ss + (8 * hh + q4) * VS + 32 * et + 16 * blk + 4 * p4; const LAS bf16_t* qb = qe + (32 * tt + r) * QS + 8 * hh;
#pragma unroll
        for (int s4 = 0; s4 < 4; ++s4) { const s16x4 al = tr_read(sa + 16 * s4 * VS), ah = tr_read(sa + (16 * s4 + 4) * VS); const bf16x8 bq = *(const LAS bf16x8*)(qb + 16 * s4);
            Y = MFMA32(((bf16x8){al[0], al[1], al[2], al[3], ah[0], ah[1], ah[2], ah[3]}), bq, Y); } }
    const LAS bf16_t* va = vs + (4 * hh + q4) * VS + 32 * et + 16 * blk + 4 * p4;
#pragma unroll
    for (int st = 0; st < 2; ++st) {
        if (st <= tt) {
            f32x16 X;
#pragma unroll
            for (int i = 0; i < 16; ++i) X[i] = 0.f;
            const LAS bf16_t* ka = kt + (32 * st + r) * QS + 8 * hh; const LAS bf16_t* qb = qt + (32 * tt + r) * QS + 8 * hh;
#pragma unroll
            for (int s4 = 0; s4 < 4; ++s4) X = MFMA32(*(const LAS bf16x8*)(ka + 16 * s4), *(const LAS bf16x8*)(qb + 16 * s4), X);
            if (st == tt) {
#pragma unroll
                for (int i = 0; i < 16; ++i) { const int cr = (i & 3) + 8 * (i >> 2) + 4 * hh; X[i] = (cr <= r) ? X[i] : 0.f; } }
#pragma unroll
            for (int s2 = 0; s2 < 2; ++s2) {
                u32x4 pw; pw.x = pk2(X[8 * s2 + 0], X[8 * s2 + 1]); pw.y = pk2(X[8 * s2 + 2], X[8 * s2 + 3]); pw.z = pk2(X[8 * s2 + 4], X[8 * s2 + 5]); pw.w = pk2(X[8 * s2 + 6], X[8 * s2 + 7]);
                const LAS bf16_t* vp = va + (32 * st + 16 * s2) * VS;
                const s16x4 lo = tr_read(vp), hi = tr_read(vp + 8 * VS);
                Y = MFMA32(((bf16x8){lo[0], lo[1], lo[2], lo[3], hi[0], hi[1], hi[2], hi[3]}), __builtin_bit_cast(bf16x8, pw), Y); }
        }
    }
    float p = 0.f;
#pragma unroll
    for (int i = 0; i < 16; ++i) p += Y[i] * Y[i];
    p += shx(p, 32, lane);
    if (hh == 0) red[et * 64 + 32 * tt + r] = p;
    __syncthreads();
    const int tl = 32 * tt + r;
    const float rs = rsqrtf(((red[tl] + red[64 + tl]) + (red[128 + tl] + red[192 + tl])) * (1.f / 128.f) + EPS);
    bf16_t* mx = wsp<bf16_t>(F, WS_MIX) + (size_t)(t0 + tl) * D + h * 128 + 32 * et + 4 * hh;
#pragma unroll
    for (int g4 = 0; g4 < 4; ++g4) { const u32x2 rr = grv[g4]; const f32x4 g = gnv[g4];
        u32x2 o; o.x = pk2(Y[4 * g4 + 0] * rs * g[0] * siluf(bf2f(rr.x & 0xffffu)), Y[4 * g4 + 1] * rs * g[1] * siluf(bf2f(rr.x >> 16)));
        o.y = pk2(Y[4 * g4 + 2] * rs * g[2] * siluf(bf2f(rr.y & 0xffffu)), Y[4 * g4 + 3] * rs * g[3] * siluf(bf2f(rr.y >> 16)));
        *(u32x2*)(mx + 8 * g4) = o; }
    __syncthreads();
}

struct SCIn { u32x4 a[6], b[6], cb[4]; f32x4 w[3][2]; };
__device__ __forceinline__ void sconv_load(const Frame& F, int it, int layer, SCIn& g) {
    const bf16_t* __restrict__ z = wsp<bf16_t>(F, WS_Z); const float* wc = (const float*)in_ptr(9) + layer * 3 * 512; const int c0 = (F.tid & 63) * 8, t0 = 4 * (it >> 6);
#pragma unroll
    for (int jj = 0; jj < 3; ++jj) { g.w[jj][0] = *(const f32x4*)(wc + jj * 512 + c0); g.w[jj][1] = *(const f32x4*)(wc + jj * 512 + c0 + 4); }
#pragma unroll
    for (int r = 0; r < 6; ++r) { const int ts = t0 - 2 + r, tc = ts < 0 ? 0 : ts; g.a[r] = *(const u32x4*)(z + (size_t)tc * NZ + ZCC + c0); g.b[r] = *(const u32x4*)(z + (size_t)tc * NZ + ZCH + c0); }
#pragma unroll
    for (int k = 0; k < 4; ++k) g.cb[k] = *(const u32x4*)(z + (size_t)(t0 + k) * NZ + ZCB + c0);
}
__device__ __forceinline__ void sconv_compute(const Frame& F, int it, const SCIn& g) {
    bf16_t* __restrict__ mix = wsp<bf16_t>(F, WS_MIX); const int c0 = (F.tid & 63) * 8, t0 = 4 * (it >> 6);
    float p[6][8];
#pragma unroll
    for (int r = 0; r < 6; ++r) { const unsigned aa[4] = {g.a[r].x, g.a[r].y, g.a[r].z, g.a[r].w}, bb[4] = {g.b[r].x, g.b[r].y, g.b[r].z, g.b[r].w}; const bool ok = (t0 - 2 + r) >= 0;
#pragma unroll
        for (int q = 0; q < 4; ++q) { p[r][2 * q] = ok ? bf2f(aa[q] & 0xffffu) * bf2f(bb[q] & 0xffffu) : 0.f; p[r][2 * q + 1] = ok ? bf2f(aa[q] >> 16) * bf2f(bb[q] >> 16) : 0.f; } }
#pragma unroll
    for (int k = 0; k < 4; ++k) { float acc[8];
#pragma unroll
        for (int e = 0; e < 8; ++e) { acc[e] = g.w[0][e >> 2][e & 3] * p[k][e]; acc[e] += g.w[1][e >> 2][e & 3] * p[k + 1][e]; acc[e] += g.w[2][e >> 2][e & 3] * p[k + 2][e]; }
        const unsigned cc[4] = {g.cb[k].x, g.cb[k].y, g.cb[k].z, g.cb[k].w}; unsigned ow[4];
#pragma unroll
        for (int q = 0; q < 4; ++q) ow[q] = pk2(acc[2 * q] * bf2f(cc[q] & 0xffffu), acc[2 * q + 1] * bf2f(cc[q] >> 16));
        *(u32x4*)(mix + (size_t)(t0 + k) * D + 1536 + c0) = (u32x4){ow[0], ow[1], ow[2], ow[3]}; }
}
__device__ __forceinline__ void scan_sconv_phase(Frame& F, int layer) {
    constexpr int NIT = (T / 4) * 64; const int it0 = F.bid * 512 + F.tid, stride = F.G * 512;
    SCIn g; sconv_load(F, it0 < NIT ? it0 : 0, layer, g);
    gla_scan4(F);
    if (it0 < NIT) sconv_compute(F, it0, g);
    for (int it = it0 + stride; it < NIT; it += stride) { SCIn h; sconv_load(F, it, layer, h); sconv_compute(F, it, h); }
}
__device__ __forceinline__ void xsoftmax_phase(Frame& F) {
    const float* sc = wsp<float>(F, WS_SC); bf16_t* pb = wsp<bf16_t>(F, WS_PB);
    for (int it = F.bid * 8 + F.wave; it < T * 4; it += F.G * 8) { const f32x4 v = *((const f32x4*)(sc + (size_t)it * 256) + F.lane);
        const float m = wave_max(fmaxf(fmaxf(v[0], v[1]), fmaxf(v[2], v[3])), F.lane);
        const float e0 = __expf(v[0] - m), e1 = __expf(v[1] - m), e2 = __expf(v[2] - m), e3 = __expf(v[3] - m); const float inv = 1.f / wave_sum((e0 + e1) + (e2 + e3), F.lane);
        u32x2 o; o.x = pk2(e0 * inv, e1 * inv); o.y = pk2(e2 * inv, e3 * inv); *((u32x2*)(pb + (size_t)it * 256) + F.lane) = o; }
}
__device__ __forceinline__ void fconv_phase(Frame& F, const Args& A, int layer) {
    const bf16_t* u = wsp<bf16_t>(F, WS_U); bf16_t* ab = wsp<bf16_t>(F, WS_AB); const float* wc = (const float*)in_ptr(19) + (size_t)layer * 3 * NUP; const float* bc = (const float*)in_ptr(20) + (size_t)layer * NUP;
    for (int it = F.bid * 512 + F.tid; it < T * 704; it += F.G * 512) { const int t = it / 704, c0 = (it % 704) * 8; float g[8], v[8];
#pragma unroll
        for (int e = 0; e < 8; ++e) { g[e] = bc[c0 + e]; v[e] = bc[DFF + c0 + e]; }
#pragma unroll
        for (int jj = 0; jj < 3; ++jj) { const int ts = t - 2 + jj; if (ts < 0) continue;
            const u32x4 a = *(const u32x4*)(u + (size_t)ts * NUP + c0), b = *(const u32x4*)(u + (size_t)ts * NUP + DFF + c0); const unsigned aa[4] = {a.x, a.y, a.z, a.w}, bb[4] = {b.x, b.y, b.z, b.w};
#pragma unroll
            for (int p = 0; p < 4; ++p) { g[2 * p] += wc[jj * NUP + c0 + 2 * p] * bf2f(aa[p] & 0xffffu); g[2 * p + 1] += wc[jj * NUP + c0 + 2 * p + 1] * bf2f(aa[p] >> 16);
                v[2 * p] += wc[jj * NUP + DFF + c0 + 2 * p] * bf2f(bb[p] & 0xffffu); v[2 * p + 1] += wc[jj * NUP + DFF + c0 + 2 * p + 1] * bf2f(bb[p] >> 16); } }
        unsigned ow[4];
#pragma unroll
        for (int p = 0; p < 4; ++p) ow[p] = pk2(siluf(g[2 * p]) * v[2 * p], siluf(g[2 * p + 1]) * v[2 * p + 1]);
        *(u32x4*)(ab + (size_t)t * DFF + c0) = (u32x4){ow[0], ow[1], ow[2], ow[3]}; }
}
__device__ __forceinline__ void final_phase(Frame& F, const Args& A, float* out) {
    const bf16_t* hb = wsp<bf16_t>(F, WS_HB); const float* ss = ss_ptr(F, 12); const f32x4* gr = (const f32x4*)in_ptr(22) + F.lane;
    for (int m = F.bid * 8 + F.wave; m < T; m += F.G * 8) { const float rs = rsqrtf(wave_sum(F.lane < 32 ? ss[(size_t)m * 32 + F.lane] : 0.f, F.lane) * (1.f / D) + EPS);
        const u32x2* hr = (const u32x2*)(hb + (size_t)m * D) + F.lane; f32x4* o = (f32x4*)(out + (size_t)m * D) + F.lane;
#pragma unroll
        for (int j = 0; j < 8; ++j) { const u32x2 b = hr[64 * j]; const f32x4 g = gr[64 * j];
            __builtin_nontemporal_store((f32x4){bf2f(b.x & 0xffffu) * rs * g[0], bf2f(b.x >> 16) * rs * g[1], bf2f(b.y & 0xffffu) * rs * g[2], bf2f(b.y >> 16) * rs * g[3]}, o + 64 * j); } }
}
__device__ __forceinline__ void ffn_fixup(Frame& F, int pm, int layer) {
    const bf16_t* HT = wsp<bf16_t>(F, WS_HT); bf16_t* ab = wsp<bf16_t>(F, WS_AB);
    const float* wcv = (const float*)in_ptr(19) + (size_t)layer * 3 * NUP; const float* bcv = (const float*)in_ptr(20) + (size_t)layer * NUP;
    for (int chunk = F.tid; chunk < 704; chunk += 512) {
        const int ch = 8 * chunk, col = 256 * (ch >> 7) + (ch & 127);
        f32x4 wg[3][2], wv[3][2], bg[2], bv[2];
#pragma unroll
        for (int jj = 0; jj < 3; ++jj)
#pragma unroll
            for (int hh = 0; hh < 2; ++hh) { wg[jj][hh] = *(const f32x4*)(wcv + jj * NUP + ch + 4 * hh); wv[jj][hh] = *(const f32x4*)(wcv + jj * NUP + DFF + ch + 4 * hh); }
#pragma unroll
        for (int hh = 0; hh < 2; ++hh) { bg[hh] = *(const f32x4*)(bcv + ch + 4 * hh); bv[hh] = *(const f32x4*)(bcv + DFF + ch + 4 * hh); }
        u32x4 xg[4][4], xv[4][4];
#pragma unroll
        for (int q = 0; q < 4; ++q) { const int kb = 4 * pm + q;
#pragma unroll
            for (int rr = 0; rr < 4; ++rr) { const bool z = (rr < 2) && (kb == 0); const bf16_t* rp = HT + (size_t)(rr < 2 ? (z ? 0 : kb - 1) * 4 + 2 + rr : kb * 4 + (rr - 2)) * NUP + col;
                const u32x4 zz = (u32x4){0u, 0u, 0u, 0u}; xg[q][rr] = z ? zz : *(const u32x4*)rp; xv[q][rr] = z ? zz : *(const u32x4*)(rp + 128); } }
#pragma unroll
        for (int q = 0; q < 4; ++q) { const int kb = 4 * pm + q;
            f32x4 rg[4][2], rv[4][2];
#pragma unroll
            for (int rr = 0; rr < 4; ++rr) { const u32x4 a = xg[q][rr], b = xv[q][rr];
                rg[rr][0] = (f32x4){bf2f(a.x & 0xffffu), bf2f(a.x >> 16), bf2f(a.y & 0xffffu), bf2f(a.y >> 16)}; rg[rr][1] = (f32x4){bf2f(a.z & 0xffffu), bf2f(a.z >> 16), bf2f(a.w & 0xffffu), bf2f(a.w >> 16)};
                rv[rr][0] = (f32x4){bf2f(b.x & 0xffffu), bf2f(b.x >> 16), bf2f(b.y & 0xffffu), bf2f(b.y >> 16)}; rv[rr][1] = (f32x4){bf2f(b.z & 0xffffu), bf2f(b.z >> 16), bf2f(b.w & 0xffffu), bf2f(b.w >> 16)}; }
#pragma unroll
            for (int i = 0; i < 2; ++i) {
                unsigned ow[4];
#pragma unroll
                for (int hh = 0; hh < 2; ++hh) { const f32x4 G = bg[hh] + wg[0][hh] * rg[i][hh] + wg[1][hh] * rg[i + 1][hh] + wg[2][hh] * rg[i + 2][hh];
                    const f32x4 V = bv[hh] + wv[0][hh] * rv[i][hh] + wv[1][hh] * rv[i + 1][hh] + wv[2][hh] * rv[i + 2][hh];
                    ow[2 * hh] = pk2(pg8::silu_fast(G[0]) * V[0], pg8::silu_fast(G[1]) * V[1]); ow[2 * hh + 1] = pk2(pg8::silu_fast(G[2]) * V[2], pg8::silu_fast(G[3]) * V[3]); }
                *(u32x4*)(ab + (size_t)(64 * kb + i) * DFF + ch) = (u32x4){ow[0], ow[1], ow[2], ow[3]}; } }
    }
}
__device__ __forceinline__ void fill_rstd_table(Frame& F, const float* ssp, int pm) {
    LAS float* rtab = (LAS float*)(__builtin_amdgcn_groupstaticsize() + MISC_OFF + 1024);
    if (pm >= 0) { const int row = F.tid >> 1, hf = F.tid & 1; const f32x4* p = (const f32x4*)(ssp + ((size_t)pm * 256 + row) * 32 + 16 * hf);
        const f32x4 a = p[0], b = p[1], c = p[2], d = p[3];
        float sacc = (((a[0] + a[1]) + (a[2] + a[3])) + ((b[0] + b[1]) + (b[2] + b[3]))) + (((c[0] + c[1]) + (c[2] + c[3])) + ((d[0] + d[1]) + (d[2] + d[3])));
        sacc += shx(sacc, 1, F.lane);
        if (hf == 0) rtab[row] = rsqrtf(sacc * (1.f / D) + EPS); }
    __syncthreads();
}
__device__ __forceinline__ void frame_refresh(Frame& F) {
    int ln; asm volatile("v_mbcnt_lo_u32_b32 %0, -1, 0\n\tv_mbcnt_hi_u32_b32 %0, -1, %0" : "=v"(ln)); F.lane = ln; F.tid = (F.wave << 6) | ln; F.ws = ws_ptr();
}
constexpr int PH_PER_LAYER = 9, N_PHASES = 1 + NL * PH_PER_LAYER + 1;
__global__ void __launch_bounds__(512, 2) fwd(Args args) {
    extern __shared__ __attribute__((aligned(16))) unsigned char lds_raw[];
    Frame F; F.lds = (LAS unsigned char*)lds_raw; F.ws = args.ws;
    F.tid = threadIdx.x; F.lane = F.tid & 63; F.wave = __builtin_amdgcn_readfirstlane(F.tid >> 6); F.G = gridDim.x; F.bid = blockIdx.x;
    volatile LAS unsigned* MISC = (volatile LAS unsigned*)(F.lds + MISC_OFF);
    if (F.tid < 64) MISC[F.tid] = 0u;
    __syncthreads();
    XcdBarrier bar; bar.bar = (unsigned*)(args.ws + WS_CTL) + CW_BAR; bar.x = 0; bar.st = nullptr;
#if MK_ONE_LAUNCH
    bar = xcd_barrier_post((unsigned*)(args.ws + WS_CTL) + CW_BAR, MISC + 8);
#define SEAM() xcd_barrier(bar)
#else
#define SEAM() do {} while (0)
#endif
    const int lo = args.ph_lo, hi = args.ph_hi;
#define IN(k) (lo <= (k) && (k) < hi && (frame_refresh(F), true))
    const int cid = (int)blockIdx.x;

    if (IN(0)) { p_prologue(F, args); SEAM(); }
    for (int l = 0; l < NL; ++l) {
        const int p0 = 1 + l * PH_PER_LAYER;
        if (IN(p0 + 0)) {
            pg8::TileOrder S; S.init(wsp<bf16_t>(F, WS_HB), wsp<bf16_t>(F, WS_WIN + l * SZ_WIN), T, NZ, D, D, F.G, cid);
            pg8::EpiScaleBf16 E{wsp<bf16_t>(F, WS_Z), NZ, ss_ptr(F, 3 * l + 0), ZG / 256, wsp<float>(F, WS_LA), (const float*)in_ptr(6) + l * 256};
            pg8::gemm_phase<pg8::EpiScaleBf16, pg8::TileOrder, true>(F.lds, pg8::Gemm{D, D, D}, S, E, F.tid);
            if (l == 0) { KVOrder S2{F.ws, F.G, (cid + F.G - 64) % F.G}; pg8::EpiPlain E2; pg8::gemm_phase<pg8::EpiPlain, KVOrder, true>(F.lds, pg8::Gemm{D, D, D}, S2, E2, F.tid); }
            { const int first = (l == 0) ? 128 : 64; convert_slot(F, l, NA_HEAD, CV_T, false, cid - first, F.G - first); }
            SEAM(); }
        if (IN(p0 + 1)) {
            for (int u = cid; u < 512; u += F.G) gla_local_mfma(F, u);
            if (l == 0) { FoldOrder S2{F.ws, F.G, cid}; pg8::EpiPlain E2; pg8::gemm_phase<pg8::EpiPlain, FoldOrder, true>(F.lds, pg8::Gemm{512, D, D}, S2, E2, F.tid); }
            SEAM(); }
        if (IN(p0 + 2)) {
            scan_sconv_phase(F, l);
            for (int u = cid; u < 256; u += F.G) swa_unit_mfma(F, u, l);
            SEAM(); }
        if (IN(p0 + 3)) { for (int u = cid; u < 512; u += F.G) gla_out_mfma(F, u, l); SEAM(); }
        if (IN(p0 + 4)) {
            pg8::TileOrder S; S.init(wsp<bf16_t>(F, WS_MIX), wsp<bf16_t>(F, WS_WOUT + l * SZ_W22), T, D, D, D, F.G, cid);
            pg8::EpiRes E{wsp<bf16_t>(F, WS_HB), ss_ptr(F, 3 * l + 1)};
            pg8::gemm_phase<pg8::EpiRes, pg8::TileOrder, true>(F.lds, pg8::Gemm{D, D, D}, S, E, F.tid); SEAM(); }
        if (IN(p0 + 5)) {
            pg8::TileOrder S; S.init(wsp<bf16_t>(F, WS_HB), wsp<bf16_t>(F, WS_WST + l * SZ_WS), T, NSC, D, D, F.G, cid);
            pg8::EpiSoftmax E{wsp<bf16_t>(F, WS_PB), ss_ptr(F, 3 * l + 1)};
            pg8::gemm_phase<pg8::EpiSoftmax, pg8::TileOrder, false>(F.lds, pg8::Gemm{D, D, D}, S, E, F.tid);
            convert_slot(F, l, CV_T, NA, false, cid - 128, F.G - 128);
            SEAM(); }
        if (IN(p0 + 6)) {
            pg8::TileOrder S; S.init(wsp<bf16_t>(F, WS_PB), wsp<bf16_t>(F, WS_VWT + l * SZ_WS), T, D, NSC, NSC, F.G, cid);
            pg8::EpiRes E{wsp<bf16_t>(F, WS_HB), ss_ptr(F, 3 * l + 2)};
            pg8::gemm_phase<pg8::EpiRes, pg8::TileOrder, true>(F.lds, pg8::Gemm{NSC, NSC, NSC}, S, E, F.tid); SEAM(); }
        if (IN(p0 + 7)) {
            pg8::TileOrder S; S.init(wsp<bf16_t>(F, WS_HB), wsp<bf16_t>(F, WS_WUP + l * SZ_WUP), T, NUP, D, D, F.G, cid);
            pg8::EpiUpConv E{wsp<bf16_t>(F, WS_AB), wsp<bf16_t>(F, WS_HT), ss_ptr(F, 3 * l + 2), (const float*)in_ptr(19) + (size_t)l * 3 * NUP, (const float*)in_ptr(20) + (size_t)l * NUP};
            pg8::gemm_phase<pg8::EpiUpConv, pg8::TileOrder, true>(F.lds, pg8::Gemm{D, D, D}, S, E, F.tid);
            if (l + 1 < NL) convert_slot(F, l + 1, 0, NA_HEAD, true, cid - 128, F.G - 128);
            SEAM(); }
        if (IN(p0 + 8)) {
            pg8::TileOrder S; S.init(wsp<bf16_t>(F, WS_AB), wsp<bf16_t>(F, WS_WDN + l * SZ_WDN), T, D, DFF, DFF, F.G, cid);
            { pg8::Unit u0; for (int i = 0; S.next(i, u0); ++i) ffn_fixup(F, u0.pm, l); VM_WAIT(); __syncthreads(); }
            pg8::EpiRes E{wsp<bf16_t>(F, WS_HB), ss_ptr(F, 3 * l + 3)};
            pg8::gemm_phase<pg8::EpiRes, pg8::TileOrder, true>(F.lds, pg8::Gemm{DFF, DFF, DFF}, S, E, F.tid); SEAM(); }
    }
    if (IN(N_PHASES - 1)) final_phase(F, args, args.out);
#undef IN
#undef SEAM
}

extern "C" void kernel_launch(void* const* d_in, const int* in_sizes, int n_in, void* d_out, int out_size, void* d_ws, size_t ws_size, hipStream_t stream) {
    static int grid = 0;
    if (grid == 0) {
        if (n_in != 23 || ws_size < WS_END) { fprintf(stderr, "kernel_launch: expected 23 inputs and >= %zu bytes of workspace (got %d, %zu)\n", (size_t)WS_END, n_in, ws_size); grid = -1; return; }
        int dev = 0, cus = 0, per_cu = 0;
        if (hipGetDevice(&dev) != hipSuccess || hipDeviceGetAttribute(&cus, hipDeviceAttributeMultiprocessorCount, dev) != hipSuccess) { grid = -1; return; }
        if (hipFuncSetAttribute((const void*)fwd, hipFuncAttributeMaxDynamicSharedMemorySize, LDS_BYTES) != hipSuccess) { fprintf(stderr, "kernel_launch: hipFuncSetAttribute failed\n"); grid = -1; return; }
        if (hipOccupancyMaxActiveBlocksPerMultiprocessor(&per_cu, (const void*)fwd, 512, LDS_BYTES) != hipSuccess || per_cu < 1) { fprintf(stderr, "kernel_launch: occupancy query says %d\n", per_cu); }
        (void)hipGetLastError();
        grid = cus;
    }
    if (grid < 0) return;
    (void)hipMemsetAsync((char*)d_ws + WS_CTL, 0, 65536, stream);
    Args a{};
    for (int i = 0; i < 23; ++i) a.in[i] = d_in[i];
    a.out = (float*)d_out; a.ws = (unsigned char*)d_ws;
#if MK_ONE_LAUNCH
    a.ph_lo = 0; a.ph_hi = N_PHASES;
    hipLaunchKernelGGL(fwd, dim3(grid), dim3(512), LDS_BYTES, stream, a);
#else
    for (int p = 0; p < N_PHASES; ++p) { a.ph_lo = p; a.ph_hi = p + 1; hipLaunchKernelGGL(fwd, dim3(grid), dim3(512), LDS_BYTES, stream, a); }
#endif
}
```
